# Optimizing an MI355X kernel written in HIP

```python
import math
import jax, jax.numpy as jnp
from jax import lax
import numpy as np

D_MODEL = 1024
BATCH = 16
SEQ = 4096
DEPTH = 4

EPS = 1e-6
D_FF = 2816

RET_HEADS = 4
RET_DK = 128
RET_DV = 256
RET_QK = RET_HEADS * RET_DK
RET_V = RET_HEADS * RET_DV
RET_CHUNK = 128
ROPE_BASE = 10000.0

DIL_CONFIGS = ((128, 1), (512, 4), (2048, 16))
DIL_HEADS_PER_GROUP = 4
DIL_HEADS = DIL_HEADS_PER_GROUP * len(DIL_CONFIGS)
DIL_DH = 128
DIL_WIDTH = DIL_HEADS * DIL_DH
DIL_OUT = DIL_HEADS_PER_GROUP * DIL_DH
N_BUCKETS = 32
MAX_DISTANCE = 1024
NEG = -1e30

IN_SIZES = (RET_QK, RET_QK, RET_V, RET_V, DIL_WIDTH, DIL_WIDTH, DIL_WIDTH, D_MODEL, D_MODEL)
IN_WIDTH = sum(IN_SIZES)
IN_SPLITS = tuple(int(s) for s in np.cumsum(IN_SIZES)[:-1])

kernel_name = "hybrid_retention_dilated_macaron_encoder"


def rmsnorm(x, g):
    x32 = x.astype(jnp.float32)
    r = lax.rsqrt(jnp.mean(x32 * x32, axis=-1, keepdims=True) + EPS)
    return (x32 * r * g).astype(x.dtype)


def swiglu(h, w_gate, w_up, w_down):
    return (jax.nn.silu(h @ w_gate) * (h @ w_up)) @ w_down


def rope(t, pos):
    half = t.shape[-1] // 2
    inv = ROPE_BASE ** (-jnp.arange(half, dtype=jnp.float32) / half)
    ang = pos[:, None] * inv[None, :]
    cos, sin = jnp.cos(ang), jnp.sin(ang)
    t1, t2 = t[..., :half], t[..., half:]
    return jnp.concatenate([t1 * cos - t2 * sin, t1 * sin + t2 * cos], axis=-1)


def _retention_dir(q, k, v, log_gamma, strict):
    B, H, S, dk = q.shape
    dv = v.shape[-1]
    C = RET_CHUNK
    N = S // C
    qc = q.reshape(B, H, N, C, dk)
    kc = k.reshape(B, H, N, C, dk)
    vc = v.reshape(B, H, N, C, dv)
    idx = jnp.arange(C, dtype=jnp.float32)
    diff = idx[:, None] - idx[None, :]
    mask = (diff > 0) if strict else (diff >= 0)
    lg = log_gamma[:, None, None]
    dmat = jnp.where(mask[None], jnp.exp(lg * jnp.maximum(diff, 0.0)[None]), 0.0)
    scores = jnp.einsum('bhncd,bhnjd->bhncj', qc, kc) * dmat[None, :, None]
    o_inner = jnp.einsum('bhncj,bhnje->bhnce', scores, vc)
    q_decay = jnp.exp(log_gamma[:, None] * (idx + 1.0)[None])
    k_decay = jnp.exp(log_gamma[:, None] * (C - 1.0 - idx)[None])
    chunk_decay = jnp.exp(log_gamma * C)

    def step(state, xs):
        qn, kn, vn = xs
        cross = jnp.einsum('bhcd,bhde->bhce', qn * q_decay[None, :, :, None], state)
        state = state * chunk_decay[None, :, None, None] + jnp.einsum(
            'bhcd,bhce->bhde', kn * k_decay[None, :, :, None], vn)
        return state, cross

    xs = (jnp.moveaxis(qc, 2, 0), jnp.moveaxis(kc, 2, 0), jnp.moveaxis(vc, 2, 0))
    state0 = jnp.zeros((B, H, dk, dv), jnp.float32)
    _, cross = lax.scan(step, state0, xs)
    out = o_inner + jnp.moveaxis(cross, 0, 2)
    return out.reshape(B, H, S, dv)


def retention(q, k, v, g, decay_exp, norm_g):
    B, S, _ = q.shape
    dtype = q.dtype
    pos = jnp.arange(S, dtype=jnp.float32)
    heads = lambda t, d: t.astype(jnp.float32).reshape(B, S, RET_HEADS, d).transpose(0, 2, 1, 3)
    qh = rope(heads(q, RET_DK), pos)
    kh = rope(heads(k, RET_DK), pos) * (RET_DK ** -0.5)
    vh = heads(v, RET_DV)
    log_gamma = jnp.log1p(-jnp.exp2(-decay_exp.astype(jnp.float32)))
    fwd = _retention_dir(qh, kh, vh, log_gamma[0], strict=False)
    flip = lambda t: jnp.flip(t, axis=2)
    bwd = flip(_retention_dir(flip(qh), flip(kh), flip(vh), log_gamma[1], strict=True))
    o = fwd + bwd
    o = o * lax.rsqrt(jnp.mean(o * o, axis=-1, keepdims=True) + EPS)
    o = o.transpose(0, 2, 1, 3).reshape(B, S, RET_V) * norm_g
    return (jax.nn.silu(g.astype(jnp.float32)) * o).astype(dtype)


def t5_bucket(rel):
    nb = N_BUCKETS // 2
    max_exact = nb // 2
    ret = jnp.where(rel > 0, nb, 0)
    n = jnp.abs(rel)
    nf = jnp.maximum(n, 1).astype(jnp.float32)
    large = max_exact + (jnp.log(nf / max_exact) / math.log(MAX_DISTANCE / max_exact)
                         * (nb - max_exact)).astype(jnp.int32)
    large = jnp.minimum(large, nb - 1)
    return ret + jnp.where(n < max_exact, n, large)


def _dilated_group(q, k, v, bias, d, R):
    B, Hg, S, dh = q.shape
    L = S // d
    nb = -(-L // R)
    Lp = nb * R

    def by_residue(t):
        t = t.reshape(B, Hg, L, d, dh).transpose(0, 1, 3, 2, 4)
        return jnp.pad(t, ((0, 0), (0, 0), (0, 0), (0, Lp - L), (0, 0)))

    def windows(t):
        t = jnp.pad(by_residue(t), ((0, 0), (0, 0), (0, 0), (R, R), (0, 0)))
        t = t.reshape(B, Hg, d, nb + 2, R, dh)
        return jnp.concatenate([t[:, :, :, 0:nb], t[:, :, :, 1:nb + 1], t[:, :, :, 2:nb + 2]], axis=-2)

    qs = by_residue(q).reshape(B, Hg, d, nb, R, dh)
    kw = windows(k)
    vw = windows(v).astype(jnp.float32)
    n_i = jnp.arange(nb)[:, None, None]
    a_i = jnp.arange(R)[None, :, None]
    c_i = jnp.arange(3 * R)[None, None, :]
    j_abs = (n_i - 1) * R + c_i
    valid = (j_abs >= 0) & (j_abs < L) & (jnp.abs(c_i - R - a_i) <= R)
    s = jnp.einsum('bhrnid,bhrnjd->bhrnij', qs, kw).astype(jnp.float32) + bias[None, :, None, None]
    s = jnp.where(valid[None, None, None], s, NEG)
    m = jnp.max(s, axis=-1, keepdims=True)
    p = jnp.exp(s - m)
    den = jnp.sum(p, axis=-1)
    o = jnp.einsum('bhrnij,bhrnjd->bhrnid', p, vw) / den[..., None]
    lse = m[..., 0] + jnp.log(den)
    o = o.reshape(B, Hg, d, Lp, dh)[:, :, :, :L].transpose(0, 1, 3, 2, 4).reshape(B, Hg, S, dh)
    lse = lse.reshape(B, Hg, d, Lp)[..., :L].transpose(0, 1, 3, 2).reshape(B, Hg, S)
    return o, lse


def dilated_attention(q, k, v, q_norm, k_norm, rel_bias):
    B, S, _ = q.shape
    dtype = q.dtype
    heads = lambda t: t.reshape(B, S, DIL_HEADS, DIL_DH).transpose(0, 2, 1, 3)
    qh = rmsnorm(heads(q), q_norm) * (DIL_DH ** -0.5)
    kh = rmsnorm(heads(k), k_norm)
    vh = heads(v)
    outs, lses = [], []
    for gi, (window, d) in enumerate(DIL_CONFIGS):
        R = window // (2 * d)
        sl = slice(gi * DIL_HEADS_PER_GROUP, (gi + 1) * DIL_HEADS_PER_GROUP)
        a_i = jnp.arange(R)[:, None]
        c_i = jnp.arange(3 * R)[None, :]
        bucket = t5_bucket((c_i - R - a_i) * d)
        bias = rel_bias[bucket][..., sl].transpose(2, 0, 1).astype(jnp.float32)
        o, lse = _dilated_group(qh[:, sl], kh[:, sl], vh[:, sl], bias, d, R)
        outs.append(o)
        lses.append(lse)
    w = jax.nn.softmax(jnp.stack(lses, axis=0), axis=0)
    out = jnp.sum(w[..., None] * jnp.stack(outs, axis=0), axis=0)
    return out.transpose(0, 2, 1, 3).reshape(B, S, DIL_OUT).astype(dtype)


def setup_inputs(seed: int = 0) -> dict:
    key = jax.random.key(seed)
    ks = jax.random.split(key, 24)
    f32 = jnp.float32
    nrm = lambda k, shape, fan_in: jax.random.normal(k, shape, f32) * (fan_in ** -0.5)
    gain = lambda k, shape: 1.0 + 0.02 * jax.random.normal(k, shape, f32)
    decay_exp = (5.0 + jnp.arange(RET_HEADS, dtype=f32))[None, None, :] + \
        0.25 * jax.random.uniform(ks[9], (DEPTH, 2, RET_HEADS), f32)
    return {
        "x": jax.random.normal(ks[0], (BATCH, SEQ, D_MODEL), f32),
        "rel_bias": 0.2 * jax.random.normal(ks[1], (N_BUCKETS, DIL_HEADS), f32),
        "norm_ffn1": gain(ks[2], (DEPTH, D_MODEL)),
        "ffn1_gate": nrm(ks[3], (DEPTH, D_MODEL, D_FF), D_MODEL),
        "ffn1_up": nrm(ks[4], (DEPTH, D_MODEL, D_FF), D_MODEL),
        "ffn1_down": nrm(ks[5], (DEPTH, D_FF, D_MODEL), D_FF),
        "norm_mix": gain(ks[6], (DEPTH, D_MODEL)),
        "w_in": nrm(ks[7], (DEPTH, D_MODEL, IN_WIDTH), D_MODEL),
        "b_gate": 0.02 * jax.random.normal(ks[8], (DEPTH, 2 * D_MODEL), f32),
        "ret_decay_exp": decay_exp,
        "ret_norm": gain(ks[10], (DEPTH, RET_V)),
        "w_ret_o": nrm(ks[11], (DEPTH, RET_V, D_MODEL), RET_V),
        "dil_q_norm": gain(ks[12], (DEPTH, DIL_DH)),
        "dil_k_norm": gain(ks[13], (DEPTH, DIL_DH)),
        "w_dil_o": nrm(ks[14], (DEPTH, DIL_OUT, D_MODEL), DIL_OUT),
        "w_out": nrm(ks[15], (DEPTH, D_MODEL, D_MODEL), D_MODEL),
        "norm_ffn2": gain(ks[16], (DEPTH, D_MODEL)),
        "ffn2_gate": nrm(ks[17], (DEPTH, D_MODEL, D_FF), D_MODEL),
        "ffn2_up": nrm(ks[18], (DEPTH, D_MODEL, D_FF), D_MODEL),
        "ffn2_down": nrm(ks[19], (DEPTH, D_FF, D_MODEL), D_FF),
    }


def reference(x, rel_bias, norm_ffn1, ffn1_gate, ffn1_up, ffn1_down, norm_mix, w_in,
              b_gate, ret_decay_exp, ret_norm, w_ret_o, dil_q_norm, dil_k_norm, w_dil_o,
              w_out, norm_ffn2, ffn2_gate, ffn2_up, ffn2_down):
    for l in range(DEPTH):
        x = x + 0.5 * swiglu(rmsnorm(x, norm_ffn1[l]), ffn1_gate[l], ffn1_up[l], ffn1_down[l])
        h = rmsnorm(x, norm_mix[l])
        z = h @ w_in[l]
        rq, rk, rv, rg, dq, dk, dv, g_ret, g_dil = jnp.split(z, IN_SPLITS, axis=-1)
        y_ret = retention(rq, rk, rv, rg, ret_decay_exp[l], ret_norm[l]) @ w_ret_o[l]
        y_dil = dilated_attention(dq, dk, dv, dil_q_norm[l], dil_k_norm[l], rel_bias) @ w_dil_o[l]
        gates = jax.nn.sigmoid(jnp.concatenate([g_ret, g_dil], axis=-1) + b_gate[l])
        merged = gates[..., :D_MODEL] * y_ret + gates[..., D_MODEL:] * y_dil
        x = x + merged @ w_out[l]
        x = x + 0.5 * swiglu(rmsnorm(x, norm_ffn2[l]), ffn2_gate[l], ffn2_up[l], ffn2_down[l])
    return x
```

```cpp
#include <hip/hip_runtime.h>
#include <hip/hip_cooperative_groups.h>
#include <cstdio>
#include <cstdint>
namespace cg = cooperative_groups;

#define DI __device__ __forceinline__
#define LAS __attribute__((address_space(3)))
typedef unsigned short bf16_t;
typedef short bf16x8 __attribute__((ext_vector_type(8)));
typedef short s16x4 __attribute__((ext_vector_type(4)));
typedef float f32x4 __attribute__((ext_vector_type(4)));
typedef unsigned u32x4 __attribute__((ext_vector_type(4)));
typedef unsigned u32x2 __attribute__((ext_vector_type(2)));

constexpr int D = 1024, FF = 2816, SEQ = 4096, NBATCH = 16, NTOK = NBATCH * SEQ, DEPTH = 4, INW = 9728;
constexpr int GB = 4, GT = GB * SEQ, NGRP = NBATCH / GB;
constexpr int ZC_RQ = 0, ZC_RK = 512, ZC_RV = 1024, ZC_RG = 2048, ZC_DQ = 3072, ZC_DK = 4608, ZC_DV = 6144, ZC_GR = 7680, ZC_GD = 8704;
constexpr float EPS = 1e-6f;
constexpr int NTHREADS = 512;
constexpr int LDS_BYTES = 147456;

constexpr size_t MiB = 1u << 20;
constexpr size_t WS_ROPE = 1 * MiB;
constexpr size_t WS_BIAS = 3 * MiB;
constexpr size_t WS_SLOT = 4 * MiB;
constexpr size_t WS_W = 8 * MiB;
constexpr size_t OW_GU1 = 0, OW_D1 = OW_GU1 + (size_t)5632 * 1024 * 2, OW_IN = OW_D1 + (size_t)1024 * 2816 * 2, OW_RO = OW_IN + (size_t)INW * 1024 * 2,
                 OW_DO = OW_RO + (size_t)1024 * 1024 * 2, OW_OUT = OW_DO + (size_t)1024 * 512 * 2, OW_GU2 = OW_OUT + (size_t)1024 * 1024 * 2,
                 OW_D2 = OW_GU2 + (size_t)5632 * 1024 * 2, LW = OW_D2 + (size_t)1024 * 2816 * 2;
static_assert(LW == 57 * MiB, "layer weight bytes");
constexpr size_t WS_XB = WS_W + DEPTH * LW;
constexpr size_t WS_BIG = WS_XB + (size_t)NTOK * D * 2;
constexpr size_t WS_H = WS_BIG;
constexpr size_t WS_Z = WS_BIG;
constexpr size_t WS_KV = WS_Z + (size_t)GT * INW * 2;
constexpr size_t WS_Y1 = WS_KV;
constexpr size_t WS_MB = WS_KV + (size_t)GT * D * 4;
constexpr size_t WS_S = WS_KV + (size_t)512 * 2 * 32768 * 4;
constexpr size_t WS_R = WS_S + (size_t)512 * 2 * 32768 * 2;
constexpr size_t WS_DL = WS_R + (size_t)GT * 1024 * 2;
constexpr size_t WS_LSE = WS_DL + (size_t)GT * 512 * 2;
constexpr size_t WS_END = WS_LSE + (size_t)GT * 12 * 4;
static_assert(WS_H + (size_t)NTOK * FF * 2 <= ((size_t)1 << 30) && WS_END <= ((size_t)1 << 30), "workspace fits 1 GiB");

DI int opaque_tid() { int t = threadIdx.x; asm volatile("" : "+v"(t)); return t; }
DI int opaque_bid() { int t = blockIdx.x; asm volatile("" : "+s"(t)); return t; }
DI unsigned pk2(float lo, float hi) { unsigned r; asm("v_cvt_pk_bf16_f32 %0, %1, %2" : "=v"(r) : "v"(lo), "v"(hi)); return r; }
DI float bflo(unsigned u) { return __uint_as_float(u << 16); }
DI float bfhi(unsigned u) { return __uint_as_float(u & 0xffff0000u); }
DI float fexp2(float x) { return __builtin_amdgcn_exp2f(x); }
DI float frcp(float x) { return __builtin_amdgcn_rcpf(x); }
DI float fsigmoid(float x) { return frcp(1.0f + fexp2(-1.44269504f * x)); }
DI float fsilu(float x) { return x * fsigmoid(x); }
DI bf16x8 as_frag(u32x4 v) { return __builtin_bit_cast(bf16x8, v); }
DI f32x4 mfma16(bf16x8 a, bf16x8 b, f32x4 c) { return __builtin_amdgcn_mfma_f32_16x16x32_bf16(a, b, c, 0, 0, 0); }
DI bf16x8 tr_frag(unsigned a0, unsigned a1) {
    s16x4 lo, hi;
    asm volatile("ds_read_b64_tr_b16 %0, %2\n\tds_read_b64_tr_b16 %1, %3\n\ts_waitcnt lgkmcnt(0)" : "=&v"(lo), "=&v"(hi) : "v"(a0), "v"(a1) : "memory");
    bf16x8 r; r[0] = lo[0]; r[1] = lo[1]; r[2] = lo[2]; r[3] = lo[3]; r[4] = hi[0]; r[5] = hi[1]; r[6] = hi[2]; r[7] = hi[3]; return r;
}
DI void tr8(unsigned a0, unsigned a1, bf16x8 (&out)[8]) {
    s16x4 l0, l1, l2, l3, l4, l5, l6, l7, h0, h1, h2, h3, h4, h5, h6, h7;
    asm volatile(
        "ds_read_b64_tr_b16 %0, %16\n\tds_read_b64_tr_b16 %8, %17\n\t"
        "ds_read_b64_tr_b16 %1, %16 offset:32\n\tds_read_b64_tr_b16 %9, %17 offset:32\n\t"
        "ds_read_b64_tr_b16 %2, %16 offset:64\n\tds_read_b64_tr_b16 %10, %17 offset:64\n\t"
        "ds_read_b64_tr_b16 %3, %16 offset:96\n\tds_read_b64_tr_b16 %11, %17 offset:96\n\t"
        "ds_read_b64_tr_b16 %4, %16 offset:128\n\tds_read_b64_tr_b16 %12, %17 offset:128\n\t"
        "ds_read_b64_tr_b16 %5, %16 offset:160\n\tds_read_b64_tr_b16 %13, %17 offset:160\n\t"
        "ds_read_b64_tr_b16 %6, %16 offset:192\n\tds_read_b64_tr_b16 %14, %17 offset:192\n\t"
        "ds_read_b64_tr_b16 %7, %16 offset:224\n\tds_read_b64_tr_b16 %15, %17 offset:224\n\t"
        "s_waitcnt lgkmcnt(0)"
        : "=&v"(l0), "=&v"(l1), "=&v"(l2), "=&v"(l3), "=&v"(l4), "=&v"(l5), "=&v"(l6), "=&v"(l7),
          "=&v"(h0), "=&v"(h1), "=&v"(h2), "=&v"(h3), "=&v"(h4), "=&v"(h5), "=&v"(h6), "=&v"(h7)
        : "v"(a0), "v"(a1) : "memory");
#define TR8_PACK(i, lo, hi) out[i][0] = lo[0]; out[i][1] = lo[1]; out[i][2] = lo[2]; out[i][3] = lo[3]; out[i][4] = hi[0]; out[i][5] = hi[1]; out[i][6] = hi[2]; out[i][7] = hi[3];
    TR8_PACK(0, l0, h0) TR8_PACK(1, l1, h1) TR8_PACK(2, l2, h2) TR8_PACK(3, l3, h3) TR8_PACK(4, l4, h4) TR8_PACK(5, l5, h5) TR8_PACK(6, l6, h6) TR8_PACK(7, l7, h7)
#undef TR8_PACK
}
DI float row_scale(const float* slots, int row, int fq) {
    const f32x4 s = *(const f32x4*)(slots + (size_t)row * 16 + 4 * fq);
    float t = (s[0] + s[1]) + (s[2] + s[3]);
    t += __shfl_xor(t, 16); t += __shfl_xor(t, 32);
    return __builtin_amdgcn_rsqf(t * (1.0f / D) + EPS);
}

namespace pg8 {
constexpr int BM = 256, BK = 64, HALF = 128, HTB = HALF * BK * 2, STAGE_BYTES = 8 * HTB, NXCD = 8, WGM = 8;
__host__ __device__ __forceinline__ int lds_byte(int r, int c) { const int st = (r >> 4) * 2 + (c >> 5), rr = r & 15, cc = c & 31, ob = rr * 64 + cc * 2; return st * 1024 + (ob ^ (((ob >> 9) & 1) << 5)); }
__host__ __device__ __forceinline__ void stage_rc(int b, int& R, int& C) { const int st = b / 1024, sb = b % 1024, swz = sb ^ (((sb >> 9) & 1) << 5); R = (st >> 1) * 16 + swz / 64; C = (st & 1) * 32 + (swz % 64) / 2; }
__host__ __device__ __forceinline__ int perm32(int rho) { const int n = rho >> 4, i = rho & 15; return 8 * (i >> 2) + 4 * n + (i & 3); }
struct Unit { int pm, pn; };
struct Gemm { const bf16_t* A; const bf16_t* Bt; int M, N, K; };
struct StaticOrder {
    int nM, nN, nwg, G, c;
    DI void init(int M, int N, int G_, int c_) { nM = M / BM; nN = N / BM; nwg = nM * nN; G = G_; c = c_; }
    DI bool next(int i, Unit& u) const {
        const long L = (long)i * G + c; if (L >= nwg) return false;
        int wgid = (int)L; { const int q = nwg / NXCD, r = nwg % NXCD, xcd = wgid % NXCD, off = wgid / NXCD; wgid = (xcd < r ? xcd * (q + 1) : r * (q + 1) + (xcd - r) * q) + off; }
        const int nig = WGM * nN, gid = wgid / nig, fm = gid * WGM, gsz = (nM - fm) < WGM ? (nM - fm) : WGM;
        u.pm = fm + ((wgid % nig) % gsz); u.pn = (wgid % nig) / gsz; return true;
    }
};
template <class Epi>
DI void gemm_phase(LAS unsigned char* lds, const Gemm g, const StaticOrder& S, const Epi& E) {
    const int tid = opaque_tid(), wid = __builtin_amdgcn_readfirstlane(tid >> 6), lane = tid & 63, wr = wid >> 2, wc = wid & 3, fr = lane & 15, fq = lane >> 4;
    const int K = g.K, nt = K / BK;
    unsigned voffA[2], voffB[2];
#pragma unroll
    for (int i = 0; i < 2; ++i) { int R, C; stage_rc(tid * 16 + i * 8192, R, C); const int Rb = Epi::PERM ? ((R & ~31) + perm32(R & 31)) : R;
        voffA[i] = (unsigned)(R * K + C) * 2u; voffB[i] = (unsigned)(Rb * K + C) * 2u; }
    const size_t kstep = (size_t)(BK * 2);
    const size_t hstep = (size_t)HALF * K * 2;
    const size_t tstep = 2 * hstep;
    const unsigned ldsw = (unsigned)wid * 1024u;
    const int aoff = lds_byte(wr * 64 + fr, fq * 8), boff = lds_byte(wc * 32 + fr, fq * 8);
#define PG8_SA(b, h) (((b) * 2 + (h)) * HTB)
#define PG8_SB(b, h) ((4 + (b) * 2 + (h)) * HTB)
#define PG8_STAGE(bufoff, gbase, voff) do { _Pragma("unroll") for (int _i = 0; _i < 2; ++_i) \
        __builtin_amdgcn_global_load_lds((const unsigned*)((const char*)(gbase) + (voff)[_i]), (LAS unsigned*)(lds + (bufoff) + ldsw + _i * 8192), 16, 0, 0); } while (0)
#define PG8_LDA(dst, b, h) do { _Pragma("unroll") for (int m = 0; m < 4; ++m) _Pragma("unroll") for (int k = 0; k < 2; ++k) dst[m][k] = *(const LAS bf16x8*)(lds + PG8_SA(b, h) + aoff + m * 2048 + k * 1024); } while (0)
#define PG8_LDB(dst, b, h) do { _Pragma("unroll") for (int n = 0; n < 2; ++n) _Pragma("unroll") for (int k = 0; k < 2; ++k) dst[n][k] = *(const LAS bf16x8*)(lds + PG8_SB(b, h) + boff + n * 2048 + k * 1024); } while (0)
#define PG8_MMA(ai, bj, At, Bt) do { __builtin_amdgcn_s_setprio(1); _Pragma("unroll") for (int m = 0; m < 4; ++m) _Pragma("unroll") for (int n = 0; n < 2; ++n) _Pragma("unroll") for (int k = 0; k < 2; ++k) \
        acc[ai][bj][m][n] = __builtin_amdgcn_mfma_f32_16x16x32_bf16(Bt[n][k], At[m][k], acc[ai][bj][m][n], 0, 0, 0); __builtin_amdgcn_s_setprio(0); } while (0)
#define PG8_WAIT_V(n) asm volatile("s_waitcnt vmcnt(" #n ")" ::: "memory")
#define PG8_WAIT_L(n) asm volatile("s_waitcnt lgkmcnt(" #n ")" ::: "memory")
#define PG8_BAR __builtin_amdgcn_s_barrier()
#define PG8_SCHED __builtin_amdgcn_sched_barrier(0)
    Unit cur, nxt; int ui = 0;
    if (!S.next(0, cur)) return;
    f32x4 acc[2][2][4][2];
#pragma unroll
    for (int a = 0; a < 2; ++a)
#pragma unroll
        for (int b = 0; b < 2; ++b)
#pragma unroll
            for (int m = 0; m < 4; ++m)
#pragma unroll
                for (int n = 0; n < 2; ++n) acc[a][b][m][n] = (f32x4){0.f, 0.f, 0.f, 0.f};
    bf16x8 At[4][2], B0[2][2], B1[2][2];
    const char* cA = (const char*)g.A + (size_t)cur.pm * tstep; const char* cB = (const char*)g.Bt + (size_t)cur.pn * tstep;
    PG8_STAGE(PG8_SB(0, 0), cB, voffB); PG8_STAGE(PG8_SB(0, 1), cB + hstep, voffB); PG8_STAGE(PG8_SA(0, 0), cA, voffA); PG8_STAGE(PG8_SA(0, 1), cA + hstep, voffA);
    if (wr == 1) PG8_BAR;
    PG8_WAIT_V(2); PG8_BAR;
    PG8_STAGE(PG8_SB(1, 0), cB + kstep, voffB); PG8_STAGE(PG8_SA(1, 0), cA + kstep, voffA); PG8_STAGE(PG8_SB(1, 1), cB + hstep + kstep, voffB);
    PG8_WAIT_V(6); PG8_BAR;
    for (;;) {
        const bool has_next = S.next(ui + 1, nxt);
        const char* nA = has_next ? (const char*)g.A + (size_t)nxt.pm * tstep : cA; const char* nB = has_next ? (const char*)g.Bt + (size_t)nxt.pn * tstep : cB;
        for (int t = 0; t < nt; t += 2) {
            const bool last = (t == nt - 2);
            const char* a1 = cA + (size_t)(t + 1) * kstep;
            const char* a2 = last ? nA : cA + (size_t)(t + 2) * kstep; const char* b2 = last ? nB : cB + (size_t)(t + 2) * kstep;
            const char* a3 = a2 + kstep; const char* b3 = b2 + kstep;
            PG8_LDB(B0, 0, 0); PG8_LDB(B1, 0, 1); PG8_SCHED; PG8_LDA(At, 0, 0); PG8_STAGE(PG8_SA(1, 1), a1 + hstep, voffA);
            PG8_WAIT_V(8); PG8_WAIT_L(0); PG8_BAR; PG8_MMA(0, 0, At, B0); PG8_MMA(0, 1, At, B1); PG8_BAR; PG8_SCHED;
            PG8_LDA(At, 0, 1); PG8_STAGE(PG8_SB(0, 0), b2, voffB); PG8_STAGE(PG8_SB(0, 1), b2 + hstep, voffB); PG8_STAGE(PG8_SA(0, 0), a2, voffA);
            PG8_WAIT_V(8); PG8_WAIT_L(0); PG8_BAR; PG8_MMA(1, 0, At, B0); PG8_MMA(1, 1, At, B1); PG8_BAR; PG8_SCHED;
            PG8_LDB(B0, 1, 0); PG8_LDB(B1, 1, 1); PG8_SCHED; PG8_LDA(At, 1, 0); PG8_STAGE(PG8_SA(0, 1), a2 + hstep, voffA);
            PG8_WAIT_V(8); PG8_WAIT_L(0); PG8_BAR; PG8_MMA(0, 0, At, B0); PG8_MMA(0, 1, At, B1); PG8_BAR; PG8_SCHED;
            PG8_LDA(At, 1, 1); PG8_STAGE(PG8_SB(1, 0), b3, voffB); PG8_STAGE(PG8_SB(1, 1), b3 + hstep, voffB); PG8_STAGE(PG8_SA(1, 0), a3, voffA);
            PG8_WAIT_V(8); PG8_WAIT_L(0); PG8_BAR; PG8_MMA(1, 0, At, B0); PG8_MMA(1, 1, At, B1); PG8_BAR; PG8_SCHED;
        }
        if (wr == 0) PG8_BAR;
        E(acc, cur, wr, wc, fr, fq);
        if (!has_next) break;
#pragma unroll
        for (int a = 0; a < 2; ++a)
#pragma unroll
            for (int b = 0; b < 2; ++b)
#pragma unroll
                for (int m = 0; m < 4; ++m)
#pragma unroll
                    for (int n = 0; n < 2; ++n) acc[a][b][m][n] = (f32x4){0.f, 0.f, 0.f, 0.f};
        cur = nxt; cA = nA; cB = nB; ++ui;
        if (wr == 1) PG8_BAR;
    }
    PG8_WAIT_V(0);
    PG8_BAR;
#undef PG8_SA
#undef PG8_SB
#undef PG8_STAGE
#undef PG8_LDA
#undef PG8_LDB
#undef PG8_MMA
#undef PG8_WAIT_V
#undef PG8_WAIT_L
#undef PG8_BAR
#undef PG8_SCHED
}

struct EpiSwiGLU {
    static constexpr bool PERM = true;
    bf16_t* H; const float* slots;
    DI void operator()(const f32x4 (&acc)[2][2][4][2], const Unit& u, int wr, int wc, int fr, int fq) const {
        const int col0 = u.pn * 128 + wc * 32 + 8 * fq;
        const int rowb = u.pm * BM + wr * 64 + fr;
        f32x4 sl[2][4];
#pragma unroll
        for (int ai = 0; ai < 2; ++ai)
#pragma unroll
            for (int m = 0; m < 4; ++m) sl[ai][m] = *(const f32x4*)(slots + (size_t)(rowb + ai * HALF + m * 16) * 16 + 4 * fq);
        asm volatile("" ::: "memory");
#pragma unroll
        for (int ai = 0; ai < 2; ++ai)
#pragma unroll
            for (int m = 0; m < 4; ++m) {
                const int row = rowb + ai * HALF + m * 16;
                float t = (sl[ai][m][0] + sl[ai][m][1]) + (sl[ai][m][2] + sl[ai][m][3]);
                t += __shfl_xor(t, 16); t += __shfl_xor(t, 32);
                const float rs = __builtin_amdgcn_rsqf(t * (1.0f / D) + EPS);
                float h[8];
#pragma unroll
                for (int n = 0; n < 2; ++n)
#pragma unroll
                    for (int j = 0; j < 4; ++j) { const float gv = acc[ai][0][m][n][j] * rs, uv = acc[ai][1][m][n][j] * rs; h[n * 4 + j] = fsilu(gv) * uv; }
                u32x4 w; w.x = pk2(h[0], h[1]); w.y = pk2(h[2], h[3]); w.z = pk2(h[4], h[5]); w.w = pk2(h[6], h[7]);
                *(u32x4*)(H + (size_t)row * FF + col0) = w;
            }
    }
};
struct EpiRes {
    static constexpr bool PERM = false;
    float* x; bf16_t* xb; float* slots; float s;
    DI void operator()(const f32x4 (&acc)[2][2][4][2], const Unit& u, int wr, int wc, int fr, int fq) const {
        const int col0 = u.pn * BM + wc * 32 + 4 * fq;
#pragma unroll
        for (int ai = 0; ai < 2; ++ai) {
            const int rowa = u.pm * BM + ai * HALF + wr * 64 + fr;
            f32x4 xo[4][2][2];
#pragma unroll
            for (int m = 0; m < 4; ++m)
#pragma unroll
                for (int bj = 0; bj < 2; ++bj)
#pragma unroll
                    for (int n = 0; n < 2; ++n) xo[m][bj][n] = *(const f32x4*)(x + (size_t)(rowa + m * 16) * D + col0 + bj * HALF + n * 16);
            asm volatile("" ::: "memory");
#pragma unroll
            for (int m = 0; m < 4; ++m) {
                const int row = rowa + m * 16;
                float* xr = x + (size_t)row * D + col0; bf16_t* br = xb + (size_t)row * D + col0;
                float ss = 0.f;
#pragma unroll
                for (int bj = 0; bj < 2; ++bj)
#pragma unroll
                    for (int n = 0; n < 2; ++n) {
                        const f32x4 xn = xo[m][bj][n] + acc[ai][bj][m][n] * s;
                        *(f32x4*)(xr + bj * HALF + n * 16) = xn;
                        u32x2 w; w.x = pk2(xn[0], xn[1]); w.y = pk2(xn[2], xn[3]);
                        *(u32x2*)(br + bj * HALF + n * 16) = w;
                        ss += (xn[0] * xn[0] + xn[1] * xn[1]) + (xn[2] * xn[2] + xn[3] * xn[3]);
                    }
                ss += __shfl_xor(ss, 16); ss += __shfl_xor(ss, 32);
                if (fq == 0) slots[(size_t)row * 16 + u.pn * 4 + wc] = ss;
            }
            asm volatile("" ::: "memory");
        }
    }
};
struct EpiZ {
    static constexpr bool PERM = true;
    bf16_t* Z; const float* slots; const float* cs; const float* sn;
    DI void operator()(const f32x4 (&acc)[2][2][4][2], const Unit& u, int wr, int wc, int fr, int fq) const {
        const int col0 = u.pn * BM + wc * 32 + 8 * fq;
        const bool rope = u.pn < 4; const float ksc = (u.pn >= 2) ? 0.08838834764831845f : 1.0f;
        const int fi = 4 * (4 * wc + fq);
        const int rowb = u.pm * BM + wr * 64 + fr;
        f32x4 sl[2][4];
#pragma unroll
        for (int ai = 0; ai < 2; ++ai)
#pragma unroll
            for (int m = 0; m < 4; ++m) sl[ai][m] = *(const f32x4*)(slots + (size_t)(rowb + ai * HALF + m * 16) * 16 + 4 * fq);
        asm volatile("" ::: "memory");
#pragma unroll
        for (int ai = 0; ai < 2; ++ai) {
            f32x4 c4[4], s4[4];
#pragma unroll
            for (int m = 0; m < 4; ++m) { c4[m] = (f32x4){1.f, 1.f, 1.f, 1.f}; s4[m] = (f32x4){0.f, 0.f, 0.f, 0.f}; }
            if (rope) {
#pragma unroll
                for (int m = 0; m < 4; ++m) { const int pos = (rowb + ai * HALF + m * 16) & (SEQ - 1); c4[m] = *(const f32x4*)(cs + pos * 64 + fi); s4[m] = *(const f32x4*)(sn + pos * 64 + fi); }
            }
            asm volatile("" ::: "memory");
#pragma unroll
            for (int m = 0; m < 4; ++m) {
                const int row = rowb + ai * HALF + m * 16;
                float t = (sl[ai][m][0] + sl[ai][m][1]) + (sl[ai][m][2] + sl[ai][m][3]);
                t += __shfl_xor(t, 16); t += __shfl_xor(t, 32);
                const float rs = __builtin_amdgcn_rsqf(t * (1.0f / D) + EPS);
#pragma unroll
                for (int bj = 0; bj < 2; ++bj) {
                    f32x4 v0 = acc[ai][bj][m][0] * rs, v1 = acc[ai][bj][m][1] * rs;
                    if (rope) { const f32x4 o0 = (v0 * c4[m] - v1 * s4[m]) * ksc, o1 = (v0 * s4[m] + v1 * c4[m]) * ksc; v0 = o0; v1 = o1; }
                    u32x4 w; w.x = pk2(v0[0], v0[1]); w.y = pk2(v0[2], v0[3]); w.z = pk2(v1[0], v1[1]); w.w = pk2(v1[2], v1[3]);
                    *(u32x4*)(Z + (size_t)row * INW + col0 + bj * HALF) = w;
                }
            }
            asm volatile("" ::: "memory");
        }
    }
};
template <bool SECOND> struct EpiGate {
    static constexpr bool PERM = true;
    const bf16_t* Zg; const float* bg; float* Y1; bf16_t* Mb;
    DI void operator()(const f32x4 (&acc)[2][2][4][2], const Unit& u, int wr, int wc, int fr, int fq) const {
        const int col0 = u.pn * BM + wc * 32 + 8 * fq;
        const int rowb = u.pm * BM + wr * 64 + fr;
        f32x4 bb[2][2];
#pragma unroll
        for (int bj = 0; bj < 2; ++bj) { bb[bj][0] = *(const f32x4*)(bg + col0 + bj * HALF); bb[bj][1] = *(const f32x4*)(bg + col0 + bj * HALF + 4); }
#pragma unroll
        for (int ai = 0; ai < 2; ++ai)
#pragma unroll
            for (int mp = 0; mp < 2; ++mp) {
                u32x4 zg[2][2]; f32x4 y0[2][2], y1[2][2];
#pragma unroll
                for (int mm = 0; mm < 2; ++mm)
#pragma unroll
                    for (int bj = 0; bj < 2; ++bj) { const int row = rowb + ai * HALF + (2 * mp + mm) * 16, col = col0 + bj * HALF;
                        zg[mm][bj] = *(const u32x4*)(Zg + (size_t)row * INW + col);
                        if (SECOND) { y0[mm][bj] = *(const f32x4*)(Y1 + (size_t)row * D + col); y1[mm][bj] = *(const f32x4*)(Y1 + (size_t)row * D + col + 4); } }
                asm volatile("" ::: "memory");
#pragma unroll
                for (int mm = 0; mm < 2; ++mm)
#pragma unroll
                    for (int bj = 0; bj < 2; ++bj) { const int m = 2 * mp + mm; const int row = rowb + ai * HALF + m * 16, col = col0 + bj * HALF;
                        const u32x4 z = zg[mm][bj]; const f32x4 b0 = bb[bj][0], b1 = bb[bj][1];
                        f32x4 g0, g1;
                        g0[0] = fsigmoid(bflo(z.x) + b0[0]); g0[1] = fsigmoid(bfhi(z.x) + b0[1]); g0[2] = fsigmoid(bflo(z.y) + b0[2]); g0[3] = fsigmoid(bfhi(z.y) + b0[3]);
                        g1[0] = fsigmoid(bflo(z.z) + b1[0]); g1[1] = fsigmoid(bfhi(z.z) + b1[1]); g1[2] = fsigmoid(bflo(z.w) + b1[2]); g1[3] = fsigmoid(bfhi(z.w) + b1[3]);
                        f32x4 v0 = g0 * acc[ai][bj][m][0], v1 = g1 * acc[ai][bj][m][1];
                        if (!SECOND) { float* yp = Y1 + (size_t)row * D + col; *(f32x4*)yp = v0; *(f32x4*)(yp + 4) = v1; }
                        else { v0 += y0[mm][bj]; v1 += y1[mm][bj];
                            u32x4 w; w.x = pk2(v0[0], v0[1]); w.y = pk2(v0[2], v0[3]); w.z = pk2(v1[0], v1[1]); w.w = pk2(v1[2], v1[3]);
                            *(u32x4*)(Mb + (size_t)row * D + col) = w; } }
                asm volatile("" ::: "memory");
            }
    }
};
}

struct Args { const float* in[20]; float* out; unsigned char* ws; };
typedef void* const __attribute__((address_space(4)))* kargp_t;
DI void* karg(int i) { kargp_t p = (kargp_t)__builtin_amdgcn_kernarg_segment_ptr(); asm volatile("" : "+s"(p)); return p[i]; }
DI const float* arg_in(int i) { return (const float*)karg(i); }
DI float* arg_out() { return (float*)karg(20); }
DI unsigned char* arg_ws() { return (unsigned char*)karg(21); }
enum { I_X = 0, I_RELB, I_NF1, I_G1, I_U1, I_D1, I_NMIX, I_WIN, I_BG, I_DEC, I_RNORM, I_WRO, I_QN, I_KN, I_WDO, I_WOUT, I_NF2, I_G2, I_U2, I_D2 };

DI int sigma_rope(int p) { return ((p & 4) ? 64 : 0) + 4 * (p >> 3) + (p & 3); }
DI void conv_item(int kind, const float* src, const float* src2, int ldsrc, const float* gain, int K, int N, bf16_t* Bt, LAS float* scr, int item, int lane) {
    const int nblk = N / 32, kb = item / nblk, nb = item % nblk, k0 = 64 * kb, n0 = 32 * nb;
    const int n = n0 + (lane & 31);
    const float* sp;
    if (kind == 1) { const int tile = n >> 8, r = n & 255; sp = (r < 128 ? src : src2) + tile * 128 + (r & 127); }
    else if (kind == 2) { sp = src + (n < 1024 ? (n & ~127) + sigma_rope(n & 127) : n); }
    else sp = src + n;
    float vv[32];
#pragma unroll
    for (int i = 0; i < 32; ++i) { const int kk = 2 * i + (lane >> 5); vv[i] = sp[(size_t)(k0 + kk) * ldsrc]; }
    if (gain) {
#pragma unroll
        for (int i = 0; i < 32; ++i) { const int kk = 2 * i + (lane >> 5); vv[i] *= gain[k0 + kk]; } }
#pragma unroll
    for (int i = 0; i < 32; ++i) { const int kk = 2 * i + (lane >> 5); scr[kk * 33 + (lane & 31)] = vv[i]; }
    asm volatile("s_waitcnt lgkmcnt(0)" ::: "memory");
    const int c = lane & 7;
#pragma unroll
    for (int j = 0; j < 4; ++j) { const int nn = (lane >> 3) + 8 * j; const LAS float* s = scr + (8 * c) * 33 + nn;
        u32x4 o; o.x = pk2(s[0 * 33], s[1 * 33]); o.y = pk2(s[2 * 33], s[3 * 33]); o.z = pk2(s[4 * 33], s[5 * 33]); o.w = pk2(s[6 * 33], s[7 * 33]);
        *(u32x4*)(Bt + (size_t)(n0 + nn) * K + k0 + 8 * c) = o; }
    asm volatile("s_waitcnt lgkmcnt(0)" ::: "memory");
}
DI int t5_bucket(int rel) {
    const int n = rel < 0 ? -rel : rel; int ret = rel > 0 ? 16 : 0;
    const float nf = (float)(n < 1 ? 1 : n);
    int large = 8 + (int)(logf(nf / 8.0f) / logf(128.0f) * 8.0f);
    large = large < 15 ? large : 15;
    return ret + (n < 8 ? n : large);
}
DI void prep_phase(LAS unsigned char* lds) {
    const int tid = opaque_tid(), lane = tid & 63, wave = tid >> 6;
    const int gw = opaque_bid() * 8 + wave, NGW = gridDim.x * 8;
    const int gt = opaque_bid() * NTHREADS + tid, NGT = gridDim.x * NTHREADS;
    unsigned char* ws = arg_ws();
    {
        bf16_t* xb = (bf16_t*)(ws + WS_XB); float* slots = (float*)(ws + WS_SLOT);
        for (int row = gw; row < NTOK; row += NGW) {
            const f32x4* xr = (const f32x4*)(arg_in(I_X) + (size_t)row * D) + lane;
            f32x4* orow = (f32x4*)(arg_out() + (size_t)row * D) + lane;
            u32x2* brow = (u32x2*)(xb + (size_t)row * D) + lane;
            float ss = 0.f;
#pragma unroll
            for (int j = 0; j < 4; ++j) { const f32x4 v = xr[64 * j]; orow[64 * j] = v; u32x2 w; w.x = pk2(v[0], v[1]); w.y = pk2(v[2], v[3]); brow[64 * j] = w;
                ss += (v[0] * v[0] + v[1] * v[1]) + (v[2] * v[2] + v[3] * v[3]); }
#pragma unroll
            for (int o = 1; o < 64; o <<= 1) ss += __shfl_xor(ss, o);
            if (lane < 16) slots[(size_t)row * 16 + lane] = lane == 0 ? ss : 0.f;
        }
    }
    {
        float* cs = (float*)(ws + WS_ROPE); float* sn = cs + SEQ * 64;
        for (int i = gt; i < SEQ * 64; i += NGT) { const int pos = i >> 6, f = i & 63;
            const float inv = powf(10000.0f, -(float)f / 64.0f); const float ang = (float)pos * inv; cs[i] = cosf(ang); sn[i] = sinf(ang); }
    }
    {
        float* bt = (float*)(ws + WS_BIAS);
        for (int i = gt; i < 12 * 129; i += NGT) { const int hh = i / 129, dl = i % 129 - 64; const int gi = hh >> 2, d = gi == 0 ? 1 : (gi == 1 ? 4 : 16);
            bt[i] = arg_in(I_RELB)[t5_bucket(dl * d) * 12 + hh]; }
    }
    {
        LAS float* scr = (LAS float*)(lds + wave * 16384);
        constexpr int I_GU = 16 * 176, I_DN = 44 * 32, I_IN = 16 * 304, I_RO = 16 * 32, I_DO = 8 * 32, I_OU = 16 * 32;
        constexpr int PER_LAYER = 2 * I_GU + 2 * I_DN + I_IN + I_RO + I_DO + I_OU;
        for (int it = gw; it < DEPTH * PER_LAYER; it += NGW) {
            const int l = it / PER_LAYER; int r = it % PER_LAYER;
            unsigned char* wl = ws + WS_W + (size_t)l * LW;
            if (r < I_GU) { conv_item(1, arg_in(I_G1) + (size_t)l * D * FF, arg_in(I_U1) + (size_t)l * D * FF, FF, arg_in(I_NF1) + l * D, D, 5632, (bf16_t*)(wl + OW_GU1), scr, r, lane); continue; } r -= I_GU;
            if (r < I_GU) { conv_item(1, arg_in(I_G2) + (size_t)l * D * FF, arg_in(I_U2) + (size_t)l * D * FF, FF, arg_in(I_NF2) + l * D, D, 5632, (bf16_t*)(wl + OW_GU2), scr, r, lane); continue; } r -= I_GU;
            if (r < I_DN) { conv_item(0, arg_in(I_D1) + (size_t)l * FF * D, nullptr, D, nullptr, FF, D, (bf16_t*)(wl + OW_D1), scr, r, lane); continue; } r -= I_DN;
            if (r < I_DN) { conv_item(0, arg_in(I_D2) + (size_t)l * FF * D, nullptr, D, nullptr, FF, D, (bf16_t*)(wl + OW_D2), scr, r, lane); continue; } r -= I_DN;
            if (r < I_IN) { conv_item(2, arg_in(I_WIN) + (size_t)l * D * INW, nullptr, INW, arg_in(I_NMIX) + l * D, D, INW, (bf16_t*)(wl + OW_IN), scr, r, lane); continue; } r -= I_IN;
            if (r < I_RO) { conv_item(0, arg_in(I_WRO) + (size_t)l * D * D, nullptr, D, nullptr, D, D, (bf16_t*)(wl + OW_RO), scr, r, lane); continue; } r -= I_RO;
            if (r < I_DO) { conv_item(0, arg_in(I_WDO) + (size_t)l * 512 * D, nullptr, D, nullptr, 512, D, (bf16_t*)(wl + OW_DO), scr, r, lane); continue; } r -= I_DO;
            conv_item(0, arg_in(I_WOUT) + (size_t)l * D * D, nullptr, D, nullptr, D, D, (bf16_t*)(wl + OW_OUT), scr, r, lane);
        }
    }
}

constexpr int RV_PITCH = 528, RK_PITCH = 272;
DI void ret_kv_phase(int l, unsigned char* lds_g, LAS unsigned char* lds) {
    const int tid = opaque_tid(), lane = tid & 63, w = tid >> 6, fr = lane & 15, fq = lane >> 4;
    const unsigned lbase = (unsigned)(size_t)lds_g;
    const bf16_t* Z = (const bf16_t*)(arg_ws() + WS_Z); float* KV = (float*)(arg_ws() + WS_KV);
    constexpr int OV = 0, OKF = 128 * RV_PITCH, OKB = OKF + 128 * RK_PITCH;
    for (int item = opaque_bid(); item < GB * 4 * 32; item += gridDim.x) {
        const int n = item & 31, h = (item >> 5) & 3, bl = item >> 7;
        const size_t row0 = (size_t)bl * SEQ + n * 128;
        const float de_f = arg_in(I_DEC)[(l * 2 + 0) * 4 + h], de_b = arg_in(I_DEC)[(l * 2 + 1) * 4 + h];
        const float l2f = log1pf(-exp2f(-de_f)) * 1.44269504f, l2b = log1pf(-exp2f(-de_b)) * 1.44269504f;
#pragma unroll
        for (int i = 0; i < 8; ++i) { const int id = tid + 512 * i, r = id >> 5, ch = id & 31;
            const u32x4 v = *(const u32x4*)(Z + (row0 + r) * INW + ZC_RV + h * 256 + ch * 8);
            *(LAS u32x4*)(lds + OV + r * RV_PITCH + ch * 16) = v; }
#pragma unroll
        for (int i = 0; i < 4; ++i) { const int id = tid + 512 * i, r = id >> 4, ch = id & 15;
            const u32x4 v = *(const u32x4*)(Z + (row0 + r) * INW + ZC_RK + h * 128 + ch * 8);
            const float sf = fexp2(l2f * (float)(127 - r)), sb = fexp2(l2b * (float)r);
            u32x4 f, b;
            f.x = pk2(bflo(v.x) * sf, bfhi(v.x) * sf); f.y = pk2(bflo(v.y) * sf, bfhi(v.y) * sf); f.z = pk2(bflo(v.z) * sf, bfhi(v.z) * sf); f.w = pk2(bflo(v.w) * sf, bfhi(v.w) * sf);
            b.x = pk2(bflo(v.x) * sb, bfhi(v.x) * sb); b.y = pk2(bflo(v.y) * sb, bfhi(v.y) * sb); b.z = pk2(bflo(v.z) * sb, bfhi(v.z) * sb); b.w = pk2(bflo(v.w) * sb, bfhi(v.w) * sb);
            *(LAS u32x4*)(lds + OKF + r * RK_PITCH + ch * 16) = f; *(LAS u32x4*)(lds + OKB + r * RK_PITCH + ch * 16) = b; }
        __syncthreads();
        f32x4 acc[2][8][2];
#pragma unroll
        for (int d = 0; d < 2; ++d)
#pragma unroll
            for (int mt = 0; mt < 8; ++mt)
#pragma unroll
                for (int nt = 0; nt < 2; ++nt) acc[d][mt][nt] = (f32x4){0.f, 0.f, 0.f, 0.f};
        const int q = fr >> 2, p = fr & 3;
#pragma unroll 1
        for (int ks = 0; ks < 4; ++ks) {
            const int tr0 = 32 * ks + 8 * fq + q;
            bf16x8 Bv[2];
#pragma unroll
            for (int nt = 0; nt < 2; ++nt) { const unsigned ad = lbase + OV + tr0 * RV_PITCH + (32 * w + 16 * nt + 4 * p) * 2; Bv[nt] = tr_frag(ad, ad + 4 * RV_PITCH); }
#pragma unroll
            for (int d = 0; d < 2; ++d) { const unsigned ad = lbase + (d ? OKB : OKF) + tr0 * RK_PITCH + (4 * p) * 2; bf16x8 Ak[8]; tr8(ad, ad + 4 * RK_PITCH, Ak);
#pragma unroll
                for (int mt = 0; mt < 8; ++mt)
#pragma unroll
                    for (int nt = 0; nt < 2; ++nt) acc[d][mt][nt] = mfma16(Ak[mt], Bv[nt], acc[d][mt][nt]); }
        }
#pragma unroll
        for (int d = 0; d < 2; ++d)
#pragma unroll
            for (int nt = 0; nt < 2; ++nt)
#pragma unroll
                for (int mt = 0; mt < 8; ++mt)
                    *(f32x4*)(KV + (((size_t)item * 2 + d) * 256 + 32 * w + 16 * nt + fr) * 128 + 16 * mt + 4 * fq) = acc[d][mt][nt];
        __syncthreads();
    }
}

struct DilIt { int hh, d, L, i0; size_t rowb; };
DI DilIt dil_decode(int item) {
    DilIt it; const int blk = item & 31; it.hh = (item >> 5) % 12; const int bl = item / (32 * 12);
    const int gi = it.hh >> 2; it.d = gi == 0 ? 1 : (gi == 1 ? 4 : 16); it.L = SEQ / it.d; const int bpc = it.L / 128;
    const int r = blk / bpc, qb = blk % bpc; it.i0 = 128 * qb; it.rowb = (size_t)bl * SEQ + r; return it;
}
DI void dil_issue(const bf16_t* Z, const DilIt& it, int tid, u32x4 (&kraw)[8], u32x4 (&vraw)[8]) {
#pragma unroll
    for (int i = 0; i < 8; ++i) { const int id = tid + 512 * i, kk = id >> 4, ch = id & 15; const int j = it.i0 - 64 + kk; const bool ok = (j >= 0) && (j < it.L);
        kraw[i] = (u32x4){0u, 0u, 0u, 0u}; vraw[i] = (u32x4){0u, 0u, 0u, 0u};
        if (ok) { const bf16_t* zr = Z + (it.rowb + (size_t)j * it.d) * INW; kraw[i] = *(const u32x4*)(zr + ZC_DK + it.hh * 128 + ch * 8); vraw[i] = *(const u32x4*)(zr + ZC_DV + it.hh * 128 + ch * 8); } }
}
DI void dil_issue_q(const bf16_t* Z, const DilIt& it, int w, int fr, int fq, u32x4 (&qraw)[4]) {
    const size_t qrow = it.rowb + (size_t)(it.i0 + 16 * w + fr) * it.d;
#pragma unroll
    for (int ks = 0; ks < 4; ++ks) qraw[ks] = *(const u32x4*)(Z + qrow * INW + ZC_DQ + it.hh * 128 + 32 * ks + 8 * fq);
}
template <bool STORE = true> DI void dil_attn_phase(int l, unsigned char* lds_g, LAS unsigned char* lds) {
    const int tid = opaque_tid(), lane = tid & 63, w = tid >> 6, fr = lane & 15, fq = lane >> 4;
    const unsigned lbase = (unsigned)(size_t)lds_g;
    bf16_t* Z = (bf16_t*)(arg_ws() + WS_Z); float* LSE = (float*)(arg_ws() + WS_LSE);
    const float* bt = (const float*)(arg_ws() + WS_BIAS);
    const float* qn = arg_in(I_QN) + l * 128; const float* kn = arg_in(I_KN) + l * 128;
    constexpr int KP = 272, OK = 0, OV = 256 * KP, OB = 2 * 256 * KP, NITEM = GB * 12 * 32;
    int item = opaque_bid();
    if (item >= NITEM) return;
    u32x4 kraw[8], vraw[8];
    DilIt it = dil_decode(item);
    dil_issue(Z, it, tid, kraw, vraw);
    for (;;) {
        const int hh = it.hh, d = it.d, L = it.L, i0 = it.i0; const size_t rowb = it.rowb;
        u32x4 qraw[4]; dil_issue_q(Z, it, w, fr, fq, qraw);
#pragma unroll
        for (int i = 0; i < 8; ++i) { const int id = tid + 512 * i, kk = id >> 4, ch = id & 15;
            const u32x4 kv = kraw[i];
            float f[8] = {bflo(kv.x), bfhi(kv.x), bflo(kv.y), bfhi(kv.y), bflo(kv.z), bfhi(kv.z), bflo(kv.w), bfhi(kv.w)};
            float ss = 0.f;
#pragma unroll
            for (int e = 0; e < 8; ++e) ss += f[e] * f[e];
            ss += __shfl_xor(ss, 1); ss += __shfl_xor(ss, 2); ss += __shfl_xor(ss, 4); ss += __shfl_xor(ss, 8);
            const float rs = __builtin_amdgcn_rsqf(ss * (1.0f / 128.0f) + EPS);
            const f32x4 g0 = *(const f32x4*)(kn + ch * 8), g1 = *(const f32x4*)(kn + ch * 8 + 4);
            u32x4 ko; ko.x = pk2(f[0] * rs * g0[0], f[1] * rs * g0[1]); ko.y = pk2(f[2] * rs * g0[2], f[3] * rs * g0[3]); ko.z = pk2(f[4] * rs * g1[0], f[5] * rs * g1[1]); ko.w = pk2(f[6] * rs * g1[2], f[7] * rs * g1[3]);
            *(LAS u32x4*)(lds + OK + kk * KP + ch * 16) = ko; *(LAS u32x4*)(lds + OV + kk * KP + ch * 16) = vraw[i];
            asm volatile("" ::: "memory"); }
        if (tid < 129) *(LAS float*)(lds + OB + tid * 4) = bt[hh * 129 + tid];
        const size_t qrow = rowb + (size_t)(i0 + 16 * w + fr) * d;
        bf16x8 Qf[4];
        {
            float ss = 0.f;
#pragma unroll
            for (int ks = 0; ks < 4; ++ks) { const u32x4 v = qraw[ks];
                ss += bflo(v.x) * bflo(v.x) + bfhi(v.x) * bfhi(v.x) + bflo(v.y) * bflo(v.y) + bfhi(v.y) * bfhi(v.y) + bflo(v.z) * bflo(v.z) + bfhi(v.z) * bfhi(v.z) + bflo(v.w) * bflo(v.w) + bfhi(v.w) * bfhi(v.w); }
            ss += __shfl_xor(ss, 16); ss += __shfl_xor(ss, 32);
            const float rs = __builtin_amdgcn_rsqf(ss * (1.0f / 128.0f) + EPS) * 0.08838834764831845f;
#pragma unroll
            for (int ks = 0; ks < 4; ++ks) { const u32x4 v = qraw[ks]; const f32x4 g0 = *(const f32x4*)(qn + 32 * ks + 8 * fq), g1 = *(const f32x4*)(qn + 32 * ks + 8 * fq + 4);
                u32x4 o; o.x = pk2(bflo(v.x) * rs * g0[0], bfhi(v.x) * rs * g0[1]); o.y = pk2(bflo(v.y) * rs * g0[2], bfhi(v.y) * rs * g0[3]);
                o.z = pk2(bflo(v.z) * rs * g1[0], bfhi(v.z) * rs * g1[1]); o.w = pk2(bflo(v.w) * rs * g1[2], bfhi(v.w) * rs * g1[3]); Qf[ks] = as_frag(o); }
        }
        __syncthreads();
        const int nitem = item + (int)gridDim.x; const bool has_next = nitem < NITEM;
        f32x4 sc[9];
#pragma unroll
        for (int jt = 0; jt < 9; ++jt) { f32x4 s = (f32x4){0.f, 0.f, 0.f, 0.f};
#pragma unroll
            for (int ks = 0; ks < 4; ++ks) { const bf16x8 kf = *(const LAS bf16x8*)(lds + OK + (16 * w + 16 * jt + fr) * KP + (32 * ks + 8 * fq) * 2); s = mfma16(kf, Qf[ks], s); }
            sc[jt] = s; if (jt % 3 == 2) asm volatile("" ::: "memory"); }
        float mx = -3.0e38f;
        int dlo = 4 * fq - 64 - fr; asm volatile("" : "+v"(dlo));
#pragma unroll
        for (int jt = 0; jt < 9; ++jt)
#pragma unroll
            for (int e = 0; e < 4; ++e) { const int dl = 16 * jt + e + dlo; const int j = i0 + 16 * w + fr + dl;
                const bool ok = (dl >= -64) && (dl <= 64) && (j >= 0) && (j < L);
                const int bi = dl < -64 ? 0 : (dl > 64 ? 128 : dl + 64);
                const float v = ok ? sc[jt][e] + *(const LAS float*)(lds + OB + bi * 4) : -1.0e30f; sc[jt][e] = v; mx = fmaxf(mx, v); }
        mx = fmaxf(mx, __shfl_xor(mx, 16)); mx = fmaxf(mx, __shfl_xor(mx, 32));
        float den = 0.f;
#pragma unroll
        for (int jt = 0; jt < 9; ++jt)
#pragma unroll
            for (int e = 0; e < 4; ++e) { const float pv = fexp2((sc[jt][e] - mx) * 1.44269504f); sc[jt][e] = pv; den += pv; }
        den += __shfl_xor(den, 16); den += __shfl_xor(den, 32);
        f32x4 oc[8];
#pragma unroll
        for (int c = 0; c < 8; ++c) oc[c] = (f32x4){0.f, 0.f, 0.f, 0.f};
        const int q = fr >> 2, p = fr & 3;
#pragma unroll
        for (int kp = 0; kp < 5; ++kp) {
            u32x4 pw; pw.x = pk2(sc[2 * kp][0], sc[2 * kp][1]); pw.y = pk2(sc[2 * kp][2], sc[2 * kp][3]);
            if (kp < 4) { pw.z = pk2(sc[2 * kp + 1 > 8 ? 8 : 2 * kp + 1][0], sc[2 * kp + 1 > 8 ? 8 : 2 * kp + 1][1]); pw.w = pk2(sc[2 * kp + 1 > 8 ? 8 : 2 * kp + 1][2], sc[2 * kp + 1 > 8 ? 8 : 2 * kp + 1][3]); }
            else { pw.z = 0u; pw.w = 0u; }
            const bf16x8 Pf = as_frag(pw);
            const int ra = 16 * w + 32 * kp + 4 * fq + q, rb = kp < 4 ? ra + 16 : ra;
            bf16x8 Vf[8]; tr8(lbase + OV + ra * KP + (4 * p) * 2, lbase + OV + rb * KP + (4 * p) * 2, Vf);
#pragma unroll
            for (int c = 0; c < 8; ++c) oc[c] = mfma16(Vf[c], Pf, oc[c]);
        }
        const float rden = 1.0f / den;
        if (STORE || den == -1.0f) {
#pragma unroll
        for (int c = 0; c < 8; ++c) { u32x2 o; o.x = pk2(oc[c][0] * rden, oc[c][1] * rden); o.y = pk2(oc[c][2] * rden, oc[c][3] * rden);
            *(u32x2*)(Z + qrow * INW + ZC_DQ + hh * 128 + 16 * c + 4 * fq) = o; }
        if (fq == 0) LSE[qrow * 12 + hh] = mx + logf(den);
        }
        if (!has_next) break;
        item = nitem;
        __syncthreads();
        it = dil_decode(nitem); dil_issue(Z, it, tid, kraw, vraw);
    }
    __syncthreads();
}

DI void scan_combine_phase(int l) {
    const int gt = opaque_bid() * NTHREADS + opaque_tid(), NGT = gridDim.x * NTHREADS;
    const f32x4* KV = (const f32x4*)(arg_ws() + WS_KV); u32x2* S = (u32x2*)(arg_ws() + WS_S);
    for (int v = gt; v < GB * 4 * 2 * 8192; v += NGT) {
        const int bh = v >> 14, dir = (v >> 13) & 1, e4 = v & 8191, h = bh & 3;
        const float de = arg_in(I_DEC)[(l * 2 + dir) * 4 + h];
        const float cd = exp2f(log1pf(-exp2f(-de)) * 1.44269504f * 128.0f);
        f32x4 st = (f32x4){0.f, 0.f, 0.f, 0.f};
#pragma unroll 8
        for (int step = 0; step < 32; ++step) { const int n = dir ? 31 - step : step; const size_t idx = ((size_t)(bh * 32 + n) * 2 + dir) * 8192 + e4;
            u32x2 o; o.x = pk2(st[0], st[1]); o.y = pk2(st[2], st[3]); S[idx] = o;
            const f32x4 kv = KV[idx]; st = st * cd + kv; }
    }
    const bf16_t* Z = (const bf16_t*)(arg_ws() + WS_Z); const float* LSE = (const float*)(arg_ws() + WS_LSE); bf16_t* DL = (bf16_t*)(arg_ws() + WS_DL);
    for (int id = gt; id < GT * 64; id += NGT) {
        const int tok = id >> 6, j = (id >> 4) & 3, ch = id & 15;
        const float l0 = LSE[tok * 12 + j], l1 = LSE[tok * 12 + 4 + j], l2 = LSE[tok * 12 + 8 + j];
        const float mx = fmaxf(l0, fmaxf(l1, l2));
        float w0 = __expf(l0 - mx), w1 = __expf(l1 - mx), w2 = __expf(l2 - mx); const float rw = 1.0f / (w0 + w1 + w2); w0 *= rw; w1 *= rw; w2 *= rw;
        const bf16_t* zr = Z + (size_t)tok * INW + ZC_DQ + j * 128 + ch * 8;
        const u32x4 a0 = *(const u32x4*)zr, a1 = *(const u32x4*)(zr + 512), a2 = *(const u32x4*)(zr + 1024);
        u32x4 o;
        o.x = pk2(w0 * bflo(a0.x) + w1 * bflo(a1.x) + w2 * bflo(a2.x), w0 * bfhi(a0.x) + w1 * bfhi(a1.x) + w2 * bfhi(a2.x));
        o.y = pk2(w0 * bflo(a0.y) + w1 * bflo(a1.y) + w2 * bflo(a2.y), w0 * bfhi(a0.y) + w1 * bfhi(a1.y) + w2 * bfhi(a2.y));
        o.z = pk2(w0 * bflo(a0.z) + w1 * bflo(a1.z) + w2 * bflo(a2.z), w0 * bfhi(a0.z) + w1 * bfhi(a1.z) + w2 * bfhi(a2.z));
        o.w = pk2(w0 * bflo(a0.w) + w1 * bflo(a1.w) + w2 * bflo(a2.w), w0 * bfhi(a0.w) + w1 * bfhi(a1.w) + w2 * bfhi(a2.w));
        *(u32x4*)(DL + (size_t)tok * 512 + j * 128 + ch * 8) = o;
    }
}

DI void ret_out_phase(int l, unsigned char* lds_g, LAS unsigned char* lds) {
    const int tid = opaque_tid(), lane = tid & 63, w = tid >> 6, fr = lane & 15, fq = lane >> 4;
    const unsigned lbase = (unsigned)(size_t)lds_g;
    const bf16_t* Z = (const bf16_t*)(arg_ws() + WS_Z); const bf16_t* S = (const bf16_t*)(arg_ws() + WS_S); bf16_t* R = (bf16_t*)(arg_ws() + WS_R);
    const float* rn = arg_in(I_RNORM) + l * 1024;
    constexpr int OQ = 0, OKP = 128 * RK_PITCH, OV = 2 * 128 * RK_PITCH, OT = OV + 128 * RV_PITCH;
    for (int item = opaque_bid(); item < GB * 4 * 32; item += gridDim.x) {
        const int n = item & 31, h = (item >> 5) & 3, bl = item >> 7;
        const size_t row0 = (size_t)bl * SEQ + n * 128;
        const float de_f = arg_in(I_DEC)[(l * 2 + 0) * 4 + h], de_b = arg_in(I_DEC)[(l * 2 + 1) * 4 + h];
        const float l2f = log1pf(-exp2f(-de_f)) * 1.44269504f, l2b = log1pf(-exp2f(-de_b)) * 1.44269504f;
#pragma unroll
        for (int i = 0; i < 8; ++i) { const int id = tid + 512 * i, r = id >> 5, ch = id & 31;
            *(LAS u32x4*)(lds + OV + r * RV_PITCH + ch * 16) = *(const u32x4*)(Z + (row0 + r) * INW + ZC_RV + h * 256 + ch * 8); }
#pragma unroll
        for (int i = 0; i < 4; ++i) { const int id = tid + 512 * i, r = id >> 4, ch = id & 15;
            *(LAS u32x4*)(lds + OQ + r * RK_PITCH + ch * 16) = *(const u32x4*)(Z + (row0 + r) * INW + ZC_RQ + h * 128 + ch * 8);
            *(LAS u32x4*)(lds + OKP + r * RK_PITCH + ch * 16) = *(const u32x4*)(Z + (row0 + r) * INW + ZC_RK + h * 128 + ch * 8); }
        __syncthreads();
        {
            bf16x8 Qf[4];
#pragma unroll
            for (int ks = 0; ks < 4; ++ks) Qf[ks] = *(const LAS bf16x8*)(lds + OQ + (16 * w + fr) * RK_PITCH + (32 * ks + 8 * fq) * 2);
            u32x2 pw[8];
            const int i = 16 * w + fr;
#pragma unroll
            for (int jt = 0; jt < 8; ++jt) { f32x4 s = (f32x4){0.f, 0.f, 0.f, 0.f};
#pragma unroll
                for (int ks = 0; ks < 4; ++ks) { const bf16x8 kf = *(const LAS bf16x8*)(lds + OKP + (16 * jt + fr) * RK_PITCH + (32 * ks + 8 * fq) * 2); s = mfma16(kf, Qf[ks], s); }
                int io = i - 4 * fq; asm volatile("" : "+v"(io));
#pragma unroll
                for (int e = 0; e < 4; ++e) { const int x = io - (16 * jt + e); const float dm = fexp2(x >= 0 ? l2f * (float)x : l2b * (float)(-x)); s[e] *= dm; }
                pw[jt].x = pk2(s[0], s[1]); pw[jt].y = pk2(s[2], s[3]); asm volatile("" ::: "memory"); }
            __syncthreads();
#pragma unroll
            for (int jt = 0; jt < 8; ++jt) *(LAS u32x2*)(lds + OKP + i * RK_PITCH + (16 * jt + 4 * fq) * 2) = pw[jt];
        }
        __syncthreads();
        f32x4 O[2][8];
        {
            const int q = fr >> 2, p = fr & 3;
#pragma unroll 1
            for (int dir = 0; dir < 2; ++dir) {
                const bf16_t* Sd = S + (((size_t)item * 2 + dir) * 256 + 32 * w) * 128;
#pragma unroll
                for (int m = 0; m < 2; ++m) {
                    f32x4 T[8];
#pragma unroll
                    for (int nt = 0; nt < 8; ++nt) T[nt] = (f32x4){0.f, 0.f, 0.f, 0.f};
#pragma unroll 1
                    for (int ks = 0; ks < 4; ++ks) {
                        const bf16x8 Af = as_frag(*(const u32x4*)(Sd + (16 * m + fr) * 128 + 32 * ks + 8 * fq));
#pragma unroll
                        for (int nt = 0; nt < 8; ++nt) { const bf16x8 qf = *(const LAS bf16x8*)(lds + OQ + (16 * nt + fr) * RK_PITCH + (32 * ks + 8 * fq) * 2); T[nt] = mfma16(Af, qf, T[nt]); }
                    }
                    int fro = fr; asm volatile("" : "+v"(fro));
#pragma unroll
                    for (int nt = 0; nt < 8; ++nt) { const int i = 16 * nt + fro; const float sc = dir ? fexp2(l2b * (float)(128 - i)) : fexp2(l2f * (float)(i + 1));
                        if (dir) O[m][nt] += T[nt] * sc; else O[m][nt] = T[nt] * sc; }
                    asm volatile("" ::: "memory");
                }
            }
#pragma unroll 1
            for (int ks = 0; ks < 4; ++ks) {
                bf16x8 Vf[2];
                const int tr0 = 32 * ks + 8 * fq + q;
#pragma unroll
                for (int m = 0; m < 2; ++m) { const unsigned ad = lbase + OV + tr0 * RV_PITCH + (32 * w + 16 * m + 4 * p) * 2; Vf[m] = tr_frag(ad, ad + 4 * RV_PITCH); }
#pragma unroll
                for (int nt = 0; nt < 8; ++nt) { const bf16x8 pf = *(const LAS bf16x8*)(lds + OKP + (16 * nt + fr) * RK_PITCH + (32 * ks + 8 * fq) * 2);
#pragma unroll
                    for (int m = 0; m < 2; ++m) O[m][nt] = mfma16(Vf[m], pf, O[m][nt]); }
            }
        }
#pragma unroll
        for (int nt = 0; nt < 8; ++nt) { float ss = 0.f;
#pragma unroll
            for (int m = 0; m < 2; ++m)
#pragma unroll
                for (int e = 0; e < 4; ++e) ss += O[m][nt][e] * O[m][nt][e];
            ss += __shfl_xor(ss, 16); ss += __shfl_xor(ss, 32);
            if (fq == 0) *(LAS float*)(lds + OT + (w * 128 + 16 * nt + fr) * 4) = ss; }
        __syncthreads();
#pragma unroll
        for (int nt = 0; nt < 8; ++nt) { const int i = 16 * nt + fr; float tot = 0.f;
#pragma unroll
            for (int ww = 0; ww < 8; ++ww) tot += *(const LAS float*)(lds + OT + (ww * 128 + i) * 4);
            const float rinv = __builtin_amdgcn_rsqf(tot * (1.0f / 256.0f) + EPS);
#pragma unroll
            for (int m = 0; m < 2; ++m) { const int dv = h * 256 + 32 * w + 16 * m + 4 * fq;
                const u32x2 gz = *(const u32x2*)(Z + (row0 + i) * INW + ZC_RG + dv); const f32x4 gn = *(const f32x4*)(rn + dv);
                const float o0 = O[m][nt][0] * rinv * gn[0] * fsilu(bflo(gz.x)), o1 = O[m][nt][1] * rinv * gn[1] * fsilu(bfhi(gz.x));
                const float o2 = O[m][nt][2] * rinv * gn[2] * fsilu(bflo(gz.y)), o3 = O[m][nt][3] * rinv * gn[3] * fsilu(bfhi(gz.y));
                u32x2 o; o.x = pk2(o0, o1); o.y = pk2(o2, o3);
                *(u32x2*)(R + (row0 + i) * 1024 + dv) = o; }
            asm volatile("" ::: "memory"); }
        __syncthreads();
    }
}

#ifndef PHMASK
#define PHMASK 0xffff
#endif
#define PH(k) ((PHMASK >> (k)) & 1)

#define XB_TMO      128
#define XB_XCNT(j)  (256  + 64 * (j))
#define XB_XSUB(j)  (1280 + 64 * (j))
#define XB_XGEN(j)  (2304 + 64 * (j))
#define XB_TOP      3328
#define XB_TOPGEN   3392
#define XCD_BAR_WORDS 3456
#define XB_SPIN_CAP (1u << 22)
DI unsigned xb_ld(unsigned* p)              { return __hip_atomic_load(p, __ATOMIC_RELAXED, __HIP_MEMORY_SCOPE_AGENT); }
DI unsigned xb_add(unsigned* p, unsigned v) { return __hip_atomic_fetch_add(p, v, __ATOMIC_RELAXED, __HIP_MEMORY_SCOPE_AGENT); }
DI unsigned xb_xcc_id() { return (unsigned)__builtin_amdgcn_s_getreg((3 << 11) | 20) & 0xFu; }
#define XB_SPIN(cond, bar) do { unsigned _sp = 0; while (cond) { __builtin_amdgcn_s_sleep(1); \
    if ((++_sp & 255u) == 0u) { if (xb_ld(&(bar)[XB_TMO])) break; if (_sp > XB_SPIN_CAP) { atomicAdd(&(bar)[XB_TMO], 1u); break; } } } } while (0)
DI void xcd_barrier_complete(unsigned* bar, unsigned x, unsigned& nloc, unsigned& nx) {
    const unsigned G = gridDim.x * gridDim.y * gridDim.z;
    unsigned sum, cnt, mine, sp = 0u;
    for (;;) {
        sum = 0u; cnt = 0u; mine = 0u;
#pragma unroll
        for (unsigned j = 0; j < 16; ++j) { const unsigned c = xb_ld(&bar[XB_XCNT(j)]); sum += c; cnt += (c > 0u) ? 1u : 0u; mine = (j == x) ? c : mine; }
        if (sum == G) break;
        __builtin_amdgcn_s_sleep(1);
        if ((++sp & 255u) == 0u) { if (xb_ld(&bar[XB_TMO])) break; if (sp > XB_SPIN_CAP) { atomicAdd(&bar[XB_TMO], 1u); break; } }
    }
    nloc = mine > 0u ? mine : 1u; nx = cnt > 0u ? cnt : 1u;
}
DI void xcd_barrier(unsigned* bar, volatile LAS unsigned* st) {
    asm volatile("s_waitcnt vmcnt(0)" ::: "memory");
    __syncthreads();
    if (threadIdx.x == 0) {
        __builtin_amdgcn_s_waitcnt(0);
        const unsigned x = xb_xcc_id();
        unsigned nloc = st[0], nx = st[1];
        if (nloc == 0u) { xcd_barrier_complete(bar, x, nloc, nx); st[0] = nloc; st[1] = nx; }
        const unsigned old = xb_add(&bar[XB_XSUB(x)], 1u);
        const unsigned gen = old / nloc;
        if (old + 1u == (gen + 1u) * nloc) {
            __builtin_amdgcn_fence(__ATOMIC_RELEASE, "agent");
            asm volatile("s_waitcnt vmcnt(0)" ::: "memory");
            const unsigned og = xb_add(&bar[XB_TOP], 1u);
            const unsigned tg = og / nx;
            if (og + 1u == (tg + 1u) * nx) xb_add(&bar[XB_TOPGEN], 1u);
            else XB_SPIN(xb_ld(&bar[XB_TOPGEN]) == tg, bar);
            __builtin_amdgcn_fence(__ATOMIC_ACQUIRE, "agent");
            xb_add(&bar[XB_XGEN(x)], 1u);
            asm volatile("s_waitcnt vmcnt(0)" ::: "memory");
        } else {
            XB_SPIN(xb_ld(&bar[XB_XGEN(x)]) == gen, bar);
            __builtin_amdgcn_fence(__ATOMIC_ACQUIRE, "agent");
            asm volatile("s_waitcnt vmcnt(0)" ::: "memory");
        }
    }
    __syncthreads();
}

DI void counter_barrier(unsigned* bar, volatile LAS unsigned* st) {
    asm volatile("s_waitcnt vmcnt(0)" ::: "memory");
    __syncthreads();
    if (threadIdx.x == 0) {
        __builtin_amdgcn_s_waitcnt(0);
        const unsigned epoch = st[2] + 1u; st[2] = epoch;
        __builtin_amdgcn_fence(__ATOMIC_RELEASE, "agent");
        asm volatile("s_waitcnt vmcnt(0)" ::: "memory");
        (void)xb_add(&bar[XB_TOP], 1u);
        const unsigned target = epoch * gridDim.x;
        unsigned sp = 0u;
        while (xb_ld(&bar[XB_TOP]) < target) { __builtin_amdgcn_s_sleep(1); if (++sp > (1u << 24)) break; }
        __builtin_amdgcn_fence(__ATOMIC_ACQUIRE, "agent");
        asm volatile("s_waitcnt vmcnt(0)" ::: "memory");
    }
    __syncthreads();
}

DI void ph_win(LAS unsigned char* lds, int l, int g) {
    unsigned char* ws = arg_ws(); const size_t rb = (size_t)g * GT;
    pg8::Gemm gm{(const bf16_t*)(ws + WS_XB) + rb * D, (const bf16_t*)(ws + WS_W + (size_t)l * LW + OW_IN), GT, INW, D}; pg8::StaticOrder S; S.init(GT, INW, gridDim.x, opaque_bid());
    pg8::EpiZ E{(bf16_t*)(ws + WS_Z), (const float*)(ws + WS_SLOT) + rb * 16, (const float*)(ws + WS_ROPE), (const float*)(ws + WS_ROPE) + SEQ * 64}; pg8::gemm_phase(lds, gm, S, E);
}
DI void ph_post1(LAS unsigned char* lds, int l) {
    unsigned char* ws = arg_ws();
    pg8::Gemm gm{(const bf16_t*)(ws + WS_R), (const bf16_t*)(ws + WS_W + (size_t)l * LW + OW_RO), GT, D, D}; pg8::StaticOrder S; S.init(GT, D, gridDim.x, opaque_bid());
    pg8::EpiGate<false> E{(const bf16_t*)(ws + WS_Z) + ZC_GR, arg_in(I_BG) + l * 2048, (float*)(ws + WS_Y1), (bf16_t*)(ws + WS_MB)}; pg8::gemm_phase(lds, gm, S, E);
}
DI void ph_post2(LAS unsigned char* lds, int l) {
    unsigned char* ws = arg_ws();
    pg8::Gemm gm{(const bf16_t*)(ws + WS_DL), (const bf16_t*)(ws + WS_W + (size_t)l * LW + OW_DO), GT, D, 512}; pg8::StaticOrder S; S.init(GT, D, gridDim.x, opaque_bid());
    pg8::EpiGate<true> E{(const bf16_t*)(ws + WS_Z) + ZC_GD, arg_in(I_BG) + l * 2048 + 1024, (float*)(ws + WS_Y1), (bf16_t*)(ws + WS_MB)}; pg8::gemm_phase(lds, gm, S, E);
}
DI void ph_out(LAS unsigned char* lds, int l, int g) {
    unsigned char* ws = arg_ws(); const size_t rb = (size_t)g * GT;
    pg8::Gemm gm{(const bf16_t*)(ws + WS_MB), (const bf16_t*)(ws + WS_W + (size_t)l * LW + OW_OUT), GT, D, D}; pg8::StaticOrder S; S.init(GT, D, gridDim.x, opaque_bid());
    pg8::EpiRes E{arg_out() + rb * D, (bf16_t*)(ws + WS_XB) + rb * D, (float*)(ws + WS_SLOT) + rb * 16, 1.0f}; pg8::gemm_phase(lds, gm, S, E);
}
DI void ph_gu(LAS unsigned char* lds, int l, int half) {
    unsigned char* ws = arg_ws();
    pg8::Gemm gm{(const bf16_t*)(ws + WS_XB), (const bf16_t*)(ws + WS_W + (size_t)l * LW + (half ? OW_GU2 : OW_GU1)), NTOK, 5632, D}; pg8::StaticOrder S; S.init(NTOK, 5632, gridDim.x, opaque_bid());
    pg8::EpiSwiGLU E{(bf16_t*)(ws + WS_H), (const float*)(ws + WS_SLOT)}; pg8::gemm_phase(lds, gm, S, E);
}
DI void ph_down(LAS unsigned char* lds, int l, int half) {
    unsigned char* ws = arg_ws();
    pg8::Gemm gm{(const bf16_t*)(ws + WS_H), (const bf16_t*)(ws + WS_W + (size_t)l * LW + (half ? OW_D2 : OW_D1)), NTOK, D, FF}; pg8::StaticOrder S; S.init(NTOK, D, gridDim.x, opaque_bid());
    pg8::EpiRes E{arg_out(), (bf16_t*)(ws + WS_XB), (float*)(ws + WS_SLOT), 0.5f}; pg8::gemm_phase(lds, gm, S, E);
}

__global__ void __launch_bounds__(NTHREADS, 2) mega_fwd(Args a) {
    extern __shared__ __attribute__((aligned(16))) unsigned char lds_g[];
    LAS unsigned char* lds = (LAS unsigned char*)lds_g;
    cg::grid_group grid = cg::this_grid();
    volatile LAS unsigned* bst = (volatile LAS unsigned*)(lds + LDS_BYTES - 16);
    if (threadIdx.x < 4) bst[threadIdx.x] = 0u;
    __syncthreads();
    if (threadIdx.x == 0) (void)xb_add((unsigned*)arg_ws() + XB_XCNT(xb_xcc_id()), 1u);
#define GSYNC() counter_barrier((unsigned*)arg_ws(), bst)
    if (PH(0)) prep_phase(lds);
    grid.sync();
#pragma unroll 1
    for (int l = 0; l < DEPTH; ++l) {
#pragma unroll 1
        for (int half = 0; half < 2; ++half) {
            if (half == 1) {
#pragma unroll 1
                for (int g = 0; g < NGRP; ++g) {
                    if (PH(1)) ph_win(lds, l, g);
                    GSYNC();
                    if (PH(2)) ret_kv_phase(l, lds_g, lds);
                    if (PH(3)) dil_attn_phase(l, lds_g, lds);
                    GSYNC();
                    if (PH(4)) scan_combine_phase(l);
                    GSYNC();
                    if (PH(5)) ret_out_phase(l, lds_g, lds);
                    GSYNC();
                    if (PH(6)) ph_post1(lds, l);
                    if (PH(7)) ph_post2(lds, l);
                    GSYNC();
                    if (PH(8)) ph_out(lds, l, g);
                }
                GSYNC();
            }
            if (PH(9)) ph_gu(lds, l, half);
            GSYNC();
            if (PH(10)) ph_down(lds, l, half);
            if (l != DEPTH - 1 || half != 1) GSYNC();
        }
    }
}

extern "C" void kernel_launch(void* const* d_in, const int* in_sizes, int n_in, void* d_out, int out_size, void* d_ws, size_t ws_size, hipStream_t stream) {
    static int grid = 0;
    if (grid == 0) {
        if (n_in != 20 || out_size != NTOK * D || ws_size < WS_H + (size_t)NTOK * FF * 2 || ws_size < WS_END) { fprintf(stderr, "kernel_launch: unexpected shapes / workspace (n_in %d out %d ws %zu)\n", n_in, out_size, ws_size); grid = -1; return; }
        int dev = 0, cus = 0, per_cu = 0;
        if (hipGetDevice(&dev) != hipSuccess || hipDeviceGetAttribute(&cus, hipDeviceAttributeMultiprocessorCount, dev) != hipSuccess) { grid = -1; return; }
        if (hipFuncSetAttribute((const void*)mega_fwd, hipFuncAttributeMaxDynamicSharedMemorySize, LDS_BYTES) != hipSuccess) { fprintf(stderr, "kernel_launch: hipFuncSetAttribute failed\n"); grid = -1; return; }
        if (hipOccupancyMaxActiveBlocksPerMultiprocessor(&per_cu, (const void*)mega_fwd, NTHREADS, LDS_BYTES) != hipSuccess || per_cu < 1) { fprintf(stderr, "kernel_launch: occupancy query failed (%d)\n", per_cu); (void)hipGetLastError(); per_cu = 1; }
        grid = cus * per_cu;
    }
    if (grid < 0) return;
    if (hipMemsetAsync(d_ws, 0, 16384, stream) != hipSuccess) { fprintf(stderr, "kernel_launch: memset failed\n"); return; }
    Args a{};
    for (int i = 0; i < 20; ++i) a.in[i] = (const float*)d_in[i];
    a.out = (float*)d_out; a.ws = (unsigned char*)d_ws;
    void* args[] = {&a};
    hipError_t e = hipLaunchCooperativeKernel((const void*)mega_fwd, dim3(grid), dim3(NTHREADS), args, LDS_BYTES, stream);
    if (e != hipSuccess) fprintf(stderr, "kernel_launch: cooperative launch failed: %s (grid %d)\n", hipGetErrorString(e), grid);
}
```

```cpp
#include <hip/hip_runtime.h>
#include <hip/hip_cooperative_groups.h>
#include <cstdio>
#include <cstdint>
namespace cg = cooperative_groups;

#define DI __device__ __forceinline__
#define LAS __attribute__((address_space(3)))
typedef unsigned short bf16_t;
typedef short bf16x8 __attribute__((ext_vector_type(8)));
typedef short s16x4 __attribute__((ext_vector_type(4)));
typedef float f32x4 __attribute__((ext_vector_type(4)));
typedef unsigned u32x4 __attribute__((ext_vector_type(4)));
typedef unsigned u32x2 __attribute__((ext_vector_type(2)));

constexpr int D = 1024, FF = 2816, SEQ = 4096, NBATCH = 16, NTOK = NBATCH * SEQ, DEPTH = 4, INW = 9728;
constexpr int GB = 4, GT = GB * SEQ, NGRP = NBATCH / GB;
constexpr int ZC_RQ = 0, ZC_RK = 512, ZC_RV = 1024, ZC_RG = 2048, ZC_DQ = 3072, ZC_DK = 4608, ZC_DV = 6144, ZC_GR = 7680, ZC_GD = 8704;
constexpr float EPS = 1e-6f;
constexpr int NTHREADS = 512;
constexpr int LDS_BYTES = 147456;

constexpr size_t MiB = 1u << 20;
constexpr size_t WS_ROPE = 1 * MiB;
constexpr size_t WS_BIAS = 3 * MiB;
constexpr size_t WS_SLOT = 4 * MiB;
constexpr size_t WS_W = 8 * MiB;
constexpr size_t OW_GU1 = 0, OW_D1 = OW_GU1 + (size_t)5632 * 1024 * 2, OW_IN = OW_D1 + (size_t)1024 * 2816 * 2, OW_RO = OW_IN + (size_t)INW * 1024 * 2,
                 OW_DO = OW_RO + (size_t)1024 * 1024 * 2, OW_OUT = OW_DO + (size_t)1024 * 512 * 2, OW_GU2 = OW_OUT + (size_t)1024 * 1024 * 2,
                 OW_D2 = OW_GU2 + (size_t)5632 * 1024 * 2, LW = OW_D2 + (size_t)1024 * 2816 * 2;
static_assert(LW == 57 * MiB, "layer weight bytes");
constexpr size_t WS_XB = WS_W + DEPTH * LW;
constexpr size_t WS_BIG = WS_XB + (size_t)NTOK * D * 2;
constexpr size_t WS_H = WS_BIG;
constexpr size_t WS_Z = WS_BIG;
constexpr size_t WS_KV = WS_Z + (size_t)GT * INW * 2;
constexpr size_t WS_Y1 = WS_KV;
constexpr size_t WS_MB = WS_KV + (size_t)GT * D * 4;
constexpr size_t WS_S = WS_KV + (size_t)512 * 2 * 32768 * 4;
constexpr size_t WS_R = WS_S + (size_t)512 * 2 * 32768 * 2;
constexpr size_t WS_DL = WS_R + (size_t)GT * 1024 * 2;
constexpr size_t WS_LSE = WS_DL + (size_t)GT * 512 * 2;
constexpr size_t WS_END = WS_LSE + (size_t)GT * 12 * 4;
static_assert(WS_H + (size_t)NTOK * FF * 2 <= ((size_t)1 << 30) && WS_END <= ((size_t)1 << 30), "workspace fits 1 GiB");

DI int opaque_tid() { int t = threadIdx.x; asm volatile("" : "+v"(t)); return t; }
DI int opaque_bid() { int t = blockIdx.x; asm volatile("" : "+s"(t)); return t; }
DI unsigned pk2(float lo, float hi) { unsigned r; asm("v_cvt_pk_bf16_f32 %0, %1, %2" : "=v"(r) : "v"(lo), "v"(hi)); return r; }
DI float bflo(unsigned u) { return __uint_as_float(u << 16); }
DI float bfhi(unsigned u) { return __uint_as_float(u & 0xffff0000u); }
DI float fexp2(float x) { return __builtin_amdgcn_exp2f(x); }
DI float frcp(float x) { return __builtin_amdgcn_rcpf(x); }
DI float fsigmoid(float x) { return frcp(1.0f + fexp2(-1.44269504f * x)); }
DI float fsilu(float x) { return x * fsigmoid(x); }
DI bf16x8 as_frag(u32x4 v) { return __builtin_bit_cast(bf16x8, v); }
DI f32x4 mfma16(bf16x8 a, bf16x8 b, f32x4 c) { return __builtin_amdgcn_mfma_f32_16x16x32_bf16(a, b, c, 0, 0, 0); }
DI bf16x8 tr_frag(unsigned a0, unsigned a1) {
    s16x4 lo, hi;
    asm volatile("ds_read_b64_tr_b16 %0, %2\n\tds_read_b64_tr_b16 %1, %3\n\ts_waitcnt lgkmcnt(0)" : "=&v"(lo), "=&v"(hi) : "v"(a0), "v"(a1) : "memory");
    bf16x8 r; r[0] = lo[0]; r[1] = lo[1]; r[2] = lo[2]; r[3] = lo[3]; r[4] = hi[0]; r[5] = hi[1]; r[6] = hi[2]; r[7] = hi[3]; return r;
}
DI void tr4(unsigned a0, unsigned a1, bf16x8& o0, bf16x8& o1, bf16x8& o2, bf16x8& o3) {
    s16x4 l0, l1, l2, l3, h0, h1, h2, h3;
    asm volatile(
        "ds_read_b64_tr_b16 %0, %8\n\tds_read_b64_tr_b16 %4, %9\n\t"
        "ds_read_b64_tr_b16 %1, %8 offset:32\n\tds_read_b64_tr_b16 %5, %9 offset:32\n\t"
        "ds_read_b64_tr_b16 %2, %8 offset:64\n\tds_read_b64_tr_b16 %6, %9 offset:64\n\t"
        "ds_read_b64_tr_b16 %3, %8 offset:96\n\tds_read_b64_tr_b16 %7, %9 offset:96\n\t"
        "s_waitcnt lgkmcnt(0)"
        : "=&v"(l0), "=&v"(l1), "=&v"(l2), "=&v"(l3), "=&v"(h0), "=&v"(h1), "=&v"(h2), "=&v"(h3)
        : "v"(a0), "v"(a1) : "memory");
#define TR_PACK(o, lo, hi) o[0] = lo[0]; o[1] = lo[1]; o[2] = lo[2]; o[3] = lo[3]; o[4] = hi[0]; o[5] = hi[1]; o[6] = hi[2]; o[7] = hi[3];
    TR_PACK(o0, l0, h0) TR_PACK(o1, l1, h1) TR_PACK(o2, l2, h2) TR_PACK(o3, l3, h3)
#undef TR_PACK
}
DI void tr8(unsigned a0, unsigned a1, bf16x8 (&out)[8]) {
    tr4(a0, a1, out[0], out[1], out[2], out[3]);
    tr4(a0 + 128u, a1 + 128u, out[4], out[5], out[6], out[7]);
}
DI float row_scale(const float* slots, int row, int fq) {
    const f32x4 s = *(const f32x4*)(slots + (size_t)row * 16 + 4 * fq);
    float t = (s[0] + s[1]) + (s[2] + s[3]);
    t += __shfl_xor(t, 16); t += __shfl_xor(t, 32);
    return __builtin_amdgcn_rsqf(t * (1.0f / D) + EPS);
}

namespace pg8 {
constexpr int BM = 256, BK = 64, HALF = 128, HTB = HALF * BK * 2, STAGE_BYTES = 8 * HTB, NXCD = 8, WGM = 8;
__host__ __device__ __forceinline__ int lds_byte(int r, int c) { const int st = (r >> 4) * 2 + (c >> 5), rr = r & 15, cc = c & 31, ob = rr * 64 + cc * 2; return st * 1024 + (ob ^ (((ob >> 9) & 1) << 5)); }
__host__ __device__ __forceinline__ void stage_rc(int b, int& R, int& C) { const int st = b / 1024, sb = b % 1024, swz = sb ^ (((sb >> 9) & 1) << 5); R = (st >> 1) * 16 + swz / 64; C = (st & 1) * 32 + (swz % 64) / 2; }
__host__ __device__ __forceinline__ int perm32(int rho) { const int n = rho >> 4, i = rho & 15; return 8 * (i >> 2) + 4 * n + (i & 3); }
struct Unit { int pm, pn; };
struct Gemm { const bf16_t* A; const bf16_t* Bt; int M, N, K; };
struct StaticOrder {
    int nM, nN, nwg, G, c;
    DI void init(int M, int N, int G_, int c_) { nM = M / BM; nN = N / BM; nwg = nM * nN; G = G_; c = c_; }
    DI bool next(int i, Unit& u) const {
        const long L = (long)i * G + c; if (L >= nwg) return false;
        int wgid = (int)L; { const int q = nwg / NXCD, r = nwg % NXCD, xcd = wgid % NXCD, off = wgid / NXCD; wgid = (xcd < r ? xcd * (q + 1) : r * (q + 1) + (xcd - r) * q) + off; }
        const int nig = WGM * nN, gid = wgid / nig, fm = gid * WGM, gsz = (nM - fm) < WGM ? (nM - fm) : WGM;
        u.pm = fm + ((wgid % nig) % gsz); u.pn = (wgid % nig) / gsz; return true;
    }
};
template <class Epi>
DI void gemm_phase(LAS unsigned char* lds, const Gemm g, const StaticOrder& S, const Epi& E) {
    const int tid = opaque_tid(), wid = __builtin_amdgcn_readfirstlane(tid >> 6), lane = tid & 63, wr = wid >> 2, wc = wid & 3, fr = lane & 15, fq = lane >> 4;
    const int K = g.K, nt = K / BK;
    unsigned voffA[2], voffB[2];
#pragma unroll
    for (int i = 0; i < 2; ++i) { int R, C; stage_rc(tid * 16 + i * 8192, R, C); const int Rb = Epi::PERM ? ((R & ~31) + perm32(R & 31)) : R;
        voffA[i] = (unsigned)(R * K + C) * 2u; voffB[i] = (unsigned)(Rb * K + C) * 2u; }
    const size_t kstep = (size_t)(BK * 2);
    const size_t hstep = (size_t)HALF * K * 2;
    const size_t tstep = 2 * hstep;
    const unsigned ldsw = (unsigned)wid * 1024u;
    const int aoff = lds_byte(wr * 64 + fr, fq * 8), boff = lds_byte(wc * 32 + fr, fq * 8);
#define PG8_SA(b, h) (((b) * 2 + (h)) * HTB)
#define PG8_SB(b, h) ((4 + (b) * 2 + (h)) * HTB)
#define PG8_STAGE(bufoff, gbase, voff) do { _Pragma("unroll") for (int _i = 0; _i < 2; ++_i) \
        __builtin_amdgcn_global_load_lds((const unsigned*)((const char*)(gbase) + (voff)[_i]), (LAS unsigned*)(lds + (bufoff) + ldsw + _i * 8192), 16, 0, 0); } while (0)
#define PG8_LDA(dst, b, h) do { _Pragma("unroll") for (int m = 0; m < 4; ++m) _Pragma("unroll") for (int k = 0; k < 2; ++k) dst[m][k] = *(const LAS bf16x8*)(lds + PG8_SA(b, h) + aoff + m * 2048 + k * 1024); } while (0)
#define PG8_LDB(dst, b, h) do { _Pragma("unroll") for (int n = 0; n < 2; ++n) _Pragma("unroll") for (int k = 0; k < 2; ++k) dst[n][k] = *(const LAS bf16x8*)(lds + PG8_SB(b, h) + boff + n * 2048 + k * 1024); } while (0)
#define PG8_MMA(ai, bj, At, Bt) do { __builtin_amdgcn_s_setprio(1); _Pragma("unroll") for (int m = 0; m < 4; ++m) _Pragma("unroll") for (int n = 0; n < 2; ++n) _Pragma("unroll") for (int k = 0; k < 2; ++k) \
        acc[ai][bj][m][n] = __builtin_amdgcn_mfma_f32_16x16x32_bf16(Bt[n][k], At[m][k], acc[ai][bj][m][n], 0, 0, 0); __builtin_amdgcn_s_setprio(0); } while (0)
#define PG8_WAIT_V(n) asm volatile("s_waitcnt vmcnt(" #n ")" ::: "memory")
#define PG8_WAIT_L(n) asm volatile("s_waitcnt lgkmcnt(" #n ")" ::: "memory")
#define PG8_BAR __builtin_amdgcn_s_barrier()
#define PG8_SCHED __builtin_amdgcn_sched_barrier(0)
    Unit cur, nxt; int ui = 0;
    if (!S.next(0, cur)) return;
    f32x4 acc[2][2][4][2];
#pragma unroll
    for (int a = 0; a < 2; ++a)
#pragma unroll
        for (int b = 0; b < 2; ++b)
#pragma unroll
            for (int m = 0; m < 4; ++m)
#pragma unroll
                for (int n = 0; n < 2; ++n) acc[a][b][m][n] = (f32x4){0.f, 0.f, 0.f, 0.f};
    bf16x8 At[4][2], B0[2][2], B1[2][2];
    const char* cA = (const char*)g.A + (size_t)cur.pm * tstep; const char* cB = (const char*)g.Bt + (size_t)cur.pn * tstep;
    PG8_STAGE(PG8_SB(0, 0), cB, voffB); PG8_STAGE(PG8_SB(0, 1), cB + hstep, voffB); PG8_STAGE(PG8_SA(0, 0), cA, voffA); PG8_STAGE(PG8_SA(0, 1), cA + hstep, voffA);
    if (wr == 1) PG8_BAR;
    PG8_WAIT_V(2); PG8_BAR;
    PG8_STAGE(PG8_SB(1, 0), cB + kstep, voffB); PG8_STAGE(PG8_SA(1, 0), cA + kstep, voffA); PG8_STAGE(PG8_SB(1, 1), cB + hstep + kstep, voffB);
    PG8_WAIT_V(6); PG8_BAR;
    for (;;) {
        const bool has_next = S.next(ui + 1, nxt);
        const char* nA = has_next ? (const char*)g.A + (size_t)nxt.pm * tstep : cA; const char* nB = has_next ? (const char*)g.Bt + (size_t)nxt.pn * tstep : cB;
        for (int t = 0; t < nt; t += 2) {
            const bool last = (t == nt - 2);
            const char* a1 = cA + (size_t)(t + 1) * kstep;
            const char* a2 = last ? nA : cA + (size_t)(t + 2) * kstep; const char* b2 = last ? nB : cB + (size_t)(t + 2) * kstep;
            const char* a3 = a2 + kstep; const char* b3 = b2 + kstep;
            PG8_LDB(B0, 0, 0); PG8_LDB(B1, 0, 1); PG8_SCHED; PG8_LDA(At, 0, 0); PG8_STAGE(PG8_SA(1, 1), a1 + hstep, voffA);
            PG8_WAIT_V(8); PG8_WAIT_L(0); PG8_BAR; PG8_MMA(0, 0, At, B0); PG8_MMA(0, 1, At, B1); PG8_BAR; PG8_SCHED;
            PG8_LDA(At, 0, 1); PG8_STAGE(PG8_SB(0, 0), b2, voffB); PG8_STAGE(PG8_SB(0, 1), b2 + hstep, voffB); PG8_STAGE(PG8_SA(0, 0), a2, voffA);
            PG8_WAIT_V(8); PG8_WAIT_L(0); PG8_BAR; PG8_MMA(1, 0, At, B0); PG8_MMA(1, 1, At, B1); PG8_BAR; PG8_SCHED;
            PG8_LDB(B0, 1, 0); PG8_LDB(B1, 1, 1); PG8_SCHED; PG8_LDA(At, 1, 0); PG8_STAGE(PG8_SA(0, 1), a2 + hstep, voffA);
            PG8_WAIT_V(8); PG8_WAIT_L(0); PG8_BAR; PG8_MMA(0, 0, At, B0); PG8_MMA(0, 1, At, B1); PG8_BAR; PG8_SCHED;
            PG8_LDA(At, 1, 1); PG8_STAGE(PG8_SB(1, 0), b3, voffB); PG8_STAGE(PG8_SB(1, 1), b3 + hstep, voffB); PG8_STAGE(PG8_SA(1, 0), a3, voffA);
            PG8_WAIT_V(8); PG8_WAIT_L(0); PG8_BAR; PG8_MMA(1, 0, At, B0); PG8_MMA(1, 1, At, B1); PG8_BAR; PG8_SCHED;
        }
        if (wr == 0) PG8_BAR;
        E(acc, cur, wr, wc, fr, fq);
        if (!has_next) break;
#pragma unroll
        for (int a = 0; a < 2; ++a)
#pragma unroll
            for (int b = 0; b < 2; ++b)
#pragma unroll
                for (int m = 0; m < 4; ++m)
#pragma unroll
                    for (int n = 0; n < 2; ++n) acc[a][b][m][n] = (f32x4){0.f, 0.f, 0.f, 0.f};
        cur = nxt; cA = nA; cB = nB; ++ui;
        if (wr == 1) PG8_BAR;
    }
    PG8_WAIT_V(0);
    PG8_BAR;
#undef PG8_SA
#undef PG8_SB
#undef PG8_STAGE
#undef PG8_LDA
#undef PG8_LDB
#undef PG8_MMA
#undef PG8_WAIT_V
#undef PG8_WAIT_L
#undef PG8_BAR
#undef PG8_SCHED
}

struct EpiSwiGLU {
    static constexpr bool PERM = true;
    bf16_t* H; const float* slots;
    DI void operator()(const f32x4 (&acc)[2][2][4][2], const Unit& u, int wr, int wc, int fr, int fq) const {
        const int col0 = u.pn * 128 + wc * 32 + 8 * fq;
        const int rowb = u.pm * BM + wr * 64 + fr;
        f32x4 sl[2][4];
#pragma unroll
        for (int ai = 0; ai < 2; ++ai)
#pragma unroll
            for (int m = 0; m < 4; ++m) sl[ai][m] = *(const f32x4*)(slots + (size_t)(rowb + ai * HALF + m * 16) * 16 + 4 * fq);
        asm volatile("" ::: "memory");
#pragma unroll
        for (int ai = 0; ai < 2; ++ai)
#pragma unroll
            for (int m = 0; m < 4; ++m) {
                const int row = rowb + ai * HALF + m * 16;
                float t = (sl[ai][m][0] + sl[ai][m][1]) + (sl[ai][m][2] + sl[ai][m][3]);
                t += __shfl_xor(t, 16); t += __shfl_xor(t, 32);
                const float rs = __builtin_amdgcn_rsqf(t * (1.0f / D) + EPS);
                float h[8];
#pragma unroll
                for (int n = 0; n < 2; ++n)
#pragma unroll
                    for (int j = 0; j < 4; ++j) { const float gv = acc[ai][0][m][n][j] * rs, uv = acc[ai][1][m][n][j] * rs; h[n * 4 + j] = fsilu(gv) * uv; }
                u32x4 w; w.x = pk2(h[0], h[1]); w.y = pk2(h[2], h[3]); w.z = pk2(h[4], h[5]); w.w = pk2(h[6], h[7]);
                *(u32x4*)(H + (size_t)row * FF + col0) = w;
            }
    }
};
struct EpiRes {
    static constexpr bool PERM = false;
    float* x; bf16_t* xb; float* slots; float s;
    DI void operator()(const f32x4 (&acc)[2][2][4][2], const Unit& u, int wr, int wc, int fr, int fq) const {
        const int col0 = u.pn * BM + wc * 32 + 4 * fq;
#pragma unroll
        for (int ai = 0; ai < 2; ++ai) {
            const int rowa = u.pm * BM + ai * HALF + wr * 64 + fr;
            f32x4 xo[4][2][2];
#pragma unroll
            for (int m = 0; m < 4; ++m)
#pragma unroll
                for (int bj = 0; bj < 2; ++bj)
#pragma unroll
                    for (int n = 0; n < 2; ++n) xo[m][bj][n] = *(const f32x4*)(x + (size_t)(rowa + m * 16) * D + col0 + bj * HALF + n * 16);
            asm volatile("" ::: "memory");
#pragma unroll
            for (int m = 0; m < 4; ++m) {
                const int row = rowa + m * 16;
                float* xr = x + (size_t)row * D + col0; bf16_t* br = xb + (size_t)row * D + col0;
                float ss = 0.f;
#pragma unroll
                for (int bj = 0; bj < 2; ++bj)
#pragma unroll
                    for (int n = 0; n < 2; ++n) {
                        const f32x4 xn = xo[m][bj][n] + acc[ai][bj][m][n] * s;
                        *(f32x4*)(xr + bj * HALF + n * 16) = xn;
                        u32x2 w; w.x = pk2(xn[0], xn[1]); w.y = pk2(xn[2], xn[3]);
                        *(u32x2*)(br + bj * HALF + n * 16) = w;
                        ss += (xn[0] * xn[0] + xn[1] * xn[1]) + (xn[2] * xn[2] + xn[3] * xn[3]);
                    }
                ss += __shfl_xor(ss, 16); ss += __shfl_xor(ss, 32);
                if (fq == 0) slots[(size_t)row * 16 + u.pn * 4 + wc] = ss;
            }
            asm volatile("" ::: "memory");
        }
    }
};
struct EpiZ {
    static constexpr bool PERM = true;
    bf16_t* Z; const float* slots; const float* cs; const float* sn;
    DI void operator()(const f32x4 (&acc)[2][2][4][2], const Unit& u, int wr, int wc, int fr, int fq) const {
        const int col0 = u.pn * BM + wc * 32 + 8 * fq;
        const bool rope = u.pn < 4; const float ksc = (u.pn >= 2) ? 0.08838834764831845f : 1.0f;
        const int fi = 4 * (4 * wc + fq);
        const int rowb = u.pm * BM + wr * 64 + fr;
        f32x4 sl[2][4];
#pragma unroll
        for (int ai = 0; ai < 2; ++ai)
#pragma unroll
            for (int m = 0; m < 4; ++m) sl[ai][m] = *(const f32x4*)(slots + (size_t)(rowb + ai * HALF + m * 16) * 16 + 4 * fq);
        asm volatile("" ::: "memory");
#pragma unroll
        for (int ai = 0; ai < 2; ++ai) {
            f32x4 c4[4], s4[4];
#pragma unroll
            for (int m = 0; m < 4; ++m) { c4[m] = (f32x4){1.f, 1.f, 1.f, 1.f}; s4[m] = (f32x4){0.f, 0.f, 0.f, 0.f}; }
            if (rope) {
#pragma unroll
                for (int m = 0; m < 4; ++m) { const int pos = (rowb + ai * HALF + m * 16) & (SEQ - 1); c4[m] = *(const f32x4*)(cs + pos * 64 + fi); s4[m] = *(const f32x4*)(sn + pos * 64 + fi); }
            }
            asm volatile("" ::: "memory");
#pragma unroll
            for (int m = 0; m < 4; ++m) {
                const int row = rowb + ai * HALF + m * 16;
                float t = (sl[ai][m][0] + sl[ai][m][1]) + (sl[ai][m][2] + sl[ai][m][3]);
                t += __shfl_xor(t, 16); t += __shfl_xor(t, 32);
                const float rs = __builtin_amdgcn_rsqf(t * (1.0f / D) + EPS);
#pragma unroll
                for (int bj = 0; bj < 2; ++bj) {
                    f32x4 v0 = acc[ai][bj][m][0] * rs, v1 = acc[ai][bj][m][1] * rs;
                    if (rope) { const f32x4 o0 = (v0 * c4[m] - v1 * s4[m]) * ksc, o1 = (v0 * s4[m] + v1 * c4[m]) * ksc; v0 = o0; v1 = o1; }
                    u32x4 w; w.x = pk2(v0[0], v0[1]); w.y = pk2(v0[2], v0[3]); w.z = pk2(v1[0], v1[1]); w.w = pk2(v1[2], v1[3]);
                    *(u32x4*)(Z + (size_t)row * INW + col0 + bj * HALF) = w;
                }
            }
            asm volatile("" ::: "memory");
        }
    }
};
template <bool SECOND> struct EpiGate {
    static constexpr bool PERM = true;
    const bf16_t* Zg; const float* bg; float* Y1; bf16_t* Mb;
    DI void operator()(const f32x4 (&acc)[2][2][4][2], const Unit& u, int wr, int wc, int fr, int fq) const {
        const int col0 = u.pn * BM + wc * 32 + 8 * fq;
        const int rowb = u.pm * BM + wr * 64 + fr;
        f32x4 bb[2][2];
#pragma unroll
        for (int bj = 0; bj < 2; ++bj) { bb[bj][0] = *(const f32x4*)(bg + col0 + bj * HALF); bb[bj][1] = *(const f32x4*)(bg + col0 + bj * HALF + 4); }
#pragma unroll
        for (int ai = 0; ai < 2; ++ai)
#pragma unroll
            for (int mp = 0; mp < 2; ++mp) {
                u32x4 zg[2][2]; f32x4 y0[2][2], y1[2][2];
#pragma unroll
                for (int mm = 0; mm < 2; ++mm)
#pragma unroll
                    for (int bj = 0; bj < 2; ++bj) { const int row = rowb + ai * HALF + (2 * mp + mm) * 16, col = col0 + bj * HALF;
                        zg[mm][bj] = *(const u32x4*)(Zg + (size_t)row * INW + col);
                        if (SECOND) { y0[mm][bj] = *(const f32x4*)(Y1 + (size_t)row * D + col); y1[mm][bj] = *(const f32x4*)(Y1 + (size_t)row * D + col + 4); } }
                asm volatile("" ::: "memory");
#pragma unroll
                for (int mm = 0; mm < 2; ++mm)
#pragma unroll
                    for (int bj = 0; bj < 2; ++bj) { const int m = 2 * mp + mm; const int row = rowb + ai * HALF + m * 16, col = col0 + bj * HALF;
                        const u32x4 z = zg[mm][bj]; const f32x4 b0 = bb[bj][0], b1 = bb[bj][1];
                        f32x4 g0, g1;
                        g0[0] = fsigmoid(bflo(z.x) + b0[0]); g0[1] = fsigmoid(bfhi(z.x) + b0[1]); g0[2] = fsigmoid(bflo(z.y) + b0[2]); g0[3] = fsigmoid(bfhi(z.y) + b0[3]);
                        g1[0] = fsigmoid(bflo(z.z) + b1[0]); g1[1] = fsigmoid(bfhi(z.z) + b1[1]); g1[2] = fsigmoid(bflo(z.w) + b1[2]); g1[3] = fsigmoid(bfhi(z.w) + b1[3]);
                        f32x4 v0 = g0 * acc[ai][bj][m][0], v1 = g1 * acc[ai][bj][m][1];
                        if (!SECOND) { float* yp = Y1 + (size_t)row * D + col; *(f32x4*)yp = v0; *(f32x4*)(yp + 4) = v1; }
                        else { v0 += y0[mm][bj]; v1 += y1[mm][bj];
                            u32x4 w; w.x = pk2(v0[0], v0[1]); w.y = pk2(v0[2], v0[3]); w.z = pk2(v1[0], v1[1]); w.w = pk2(v1[2], v1[3]);
                            *(u32x4*)(Mb + (size_t)row * D + col) = w; } }
                asm volatile("" ::: "memory");
            }
    }
};
}

struct Args { const float* in[20]; float* out; unsigned char* ws; };
typedef void* const __attribute__((address_space(4)))* kargp_t;
DI void* karg(int i) { kargp_t p = (kargp_t)__builtin_amdgcn_kernarg_segment_ptr(); asm volatile("" : "+s"(p)); return p[i]; }
DI const float* arg_in(int i) { return (const float*)karg(i); }
DI float* arg_out() { return (float*)karg(20); }
DI unsigned char* arg_ws() { return (unsigned char*)karg(21); }
enum { I_X = 0, I_RELB, I_NF1, I_G1, I_U1, I_D1, I_NMIX, I_WIN, I_BG, I_DEC, I_RNORM, I_WRO, I_QN, I_KN, I_WDO, I_WOUT, I_NF2, I_G2, I_U2, I_D2 };

DI int sigma_rope(int p) { return ((p & 4) ? 64 : 0) + 4 * (p >> 3) + (p & 3); }
DI void conv_item(int kind, const float* src, const float* src2, int ldsrc, const float* gain, int K, int N, bf16_t* Bt, LAS float* scr, int item, int lane) {
    const int nblk = N / 32, kb = item / nblk, nb = item % nblk, k0 = 64 * kb, n0 = 32 * nb;
    const int n = n0 + (lane & 31);
    const float* sp;
    if (kind == 1) { const int tile = n >> 8, r = n & 255; sp = (r < 128 ? src : src2) + tile * 128 + (r & 127); }
    else if (kind == 2) { sp = src + (n < 1024 ? (n & ~127) + sigma_rope(n & 127) : n); }
    else sp = src + n;
    float vv[32];
#pragma unroll
    for (int i = 0; i < 32; ++i) { const int kk = 2 * i + (lane >> 5); vv[i] = sp[(size_t)(k0 + kk) * ldsrc]; }
    if (gain) {
#pragma unroll
        for (int i = 0; i < 32; ++i) { const int kk = 2 * i + (lane >> 5); vv[i] *= gain[k0 + kk]; } }
#pragma unroll
    for (int i = 0; i < 32; ++i) { const int kk = 2 * i + (lane >> 5); scr[kk * 33 + (lane & 31)] = vv[i]; }
    asm volatile("s_waitcnt lgkmcnt(0)" ::: "memory");
    const int c = lane & 7;
#pragma unroll
    for (int j = 0; j < 4; ++j) { const int nn = (lane >> 3) + 8 * j; const LAS float* s = scr + (8 * c) * 33 + nn;
        u32x4 o; o.x = pk2(s[0 * 33], s[1 * 33]); o.y = pk2(s[2 * 33], s[3 * 33]); o.z = pk2(s[4 * 33], s[5 * 33]); o.w = pk2(s[6 * 33], s[7 * 33]);
        *(u32x4*)(Bt + (size_t)(n0 + nn) * K + k0 + 8 * c) = o; }
    asm volatile("s_waitcnt lgkmcnt(0)" ::: "memory");
}
DI int t5_bucket(int rel) {
    const int n = rel < 0 ? -rel : rel; int ret = rel > 0 ? 16 : 0;
    const float nf = (float)(n < 1 ? 1 : n);
    int large = 8 + (int)(logf(nf / 8.0f) / logf(128.0f) * 8.0f);
    large = large < 15 ? large : 15;
    return ret + (n < 8 ? n : large);
}
DI void prep_phase(LAS unsigned char* lds) {
    const int tid = opaque_tid(), lane = tid & 63, wave = tid >> 6;
    const int gw = opaque_bid() * 8 + wave, NGW = gridDim.x * 8;
    const int gt = opaque_bid() * NTHREADS + tid, NGT = gridDim.x * NTHREADS;
    unsigned char* ws = arg_ws();
    {
        bf16_t* xb = (bf16_t*)(ws + WS_XB); float* slots = (float*)(ws + WS_SLOT);
        for (int row = gw; row < NTOK; row += NGW) {
            const f32x4* xr = (const f32x4*)(arg_in(I_X) + (size_t)row * D) + lane;
            f32x4* orow = (f32x4*)(arg_out() + (size_t)row * D) + lane;
            u32x2* brow = (u32x2*)(xb + (size_t)row * D) + lane;
            float ss = 0.f;
#pragma unroll
            for (int j = 0; j < 4; ++j) { const f32x4 v = xr[64 * j]; orow[64 * j] = v; u32x2 w; w.x = pk2(v[0], v[1]); w.y = pk2(v[2], v[3]); brow[64 * j] = w;
                ss += (v[0] * v[0] + v[1] * v[1]) + (v[2] * v[2] + v[3] * v[3]); }
#pragma unroll
            for (int o = 1; o < 64; o <<= 1) ss += __shfl_xor(ss, o);
            if (lane < 16) slots[(size_t)row * 16 + lane] = lane == 0 ? ss : 0.f;
        }
    }
    {
        float* cs = (float*)(ws + WS_ROPE); float* sn = cs + SEQ * 64;
        for (int i = gt; i < SEQ * 64; i += NGT) { const int pos = i >> 6, f = i & 63;
            const float inv = powf(10000.0f, -(float)f / 64.0f); const float ang = (float)pos * inv; cs[i] = cosf(ang); sn[i] = sinf(ang); }
    }
    {
        float* bt = (float*)(ws + WS_BIAS);
        for (int i = gt; i < 12 * 129; i += NGT) { const int hh = i / 129, dl = i % 129 - 64; const int gi = hh >> 2, d = gi == 0 ? 1 : (gi == 1 ? 4 : 16);
            bt[i] = arg_in(I_RELB)[t5_bucket(dl * d) * 12 + hh]; }
    }
    {
        LAS float* scr = (LAS float*)(lds + wave * 16384);
        constexpr int I_GU = 16 * 176, I_DN = 44 * 32, I_IN = 16 * 304, I_RO = 16 * 32, I_DO = 8 * 32, I_OU = 16 * 32;
        constexpr int PER_LAYER = 2 * I_GU + 2 * I_DN + I_IN + I_RO + I_DO + I_OU;
        for (int it = gw; it < DEPTH * PER_LAYER; it += NGW) {
            const int l = it / PER_LAYER; int r = it % PER_LAYER;
            unsigned char* wl = ws + WS_W + (size_t)l * LW;
            if (r < I_GU) { conv_item(1, arg_in(I_G1) + (size_t)l * D * FF, arg_in(I_U1) + (size_t)l * D * FF, FF, arg_in(I_NF1) + l * D, D, 5632, (bf16_t*)(wl + OW_GU1), scr, r, lane); continue; } r -= I_GU;
            if (r < I_GU) { conv_item(1, arg_in(I_G2) + (size_t)l * D * FF, arg_in(I_U2) + (size_t)l * D * FF, FF, arg_in(I_NF2) + l * D, D, 5632, (bf16_t*)(wl + OW_GU2), scr, r, lane); continue; } r -= I_GU;
            if (r < I_DN) { conv_item(0, arg_in(I_D1) + (size_t)l * FF * D, nullptr, D, nullptr, FF, D, (bf16_t*)(wl + OW_D1), scr, r, lane); continue; } r -= I_DN;
            if (r < I_DN) { conv_item(0, arg_in(I_D2) + (size_t)l * FF * D, nullptr, D, nullptr, FF, D, (bf16_t*)(wl + OW_D2), scr, r, lane); continue; } r -= I_DN;
            if (r < I_IN) { conv_item(2, arg_in(I_WIN) + (size_t)l * D * INW, nullptr, INW, arg_in(I_NMIX) + l * D, D, INW, (bf16_t*)(wl + OW_IN), scr, r, lane); continue; } r -= I_IN;
            if (r < I_RO) { conv_item(0, arg_in(I_WRO) + (size_t)l * D * D, nullptr, D, nullptr, D, D, (bf16_t*)(wl + OW_RO), scr, r, lane); continue; } r -= I_RO;
            if (r < I_DO) { conv_item(0, arg_in(I_WDO) + (size_t)l * 512 * D, nullptr, D, nullptr, 512, D, (bf16_t*)(wl + OW_DO), scr, r, lane); continue; } r -= I_DO;
            conv_item(0, arg_in(I_WOUT) + (size_t)l * D * D, nullptr, D, nullptr, D, D, (bf16_t*)(wl + OW_OUT), scr, r, lane);
        }
    }
}

constexpr int RV_PITCH = 528, RK_PITCH = 272;
DI void ret_kv_phase(int l, unsigned char* lds_g, LAS unsigned char* lds) {
    const int tid = opaque_tid(), lane = tid & 63, w = tid >> 6, fr = lane & 15, fq = lane >> 4;
    const unsigned lbase = (unsigned)(size_t)lds_g;
    const bf16_t* Z = (const bf16_t*)(arg_ws() + WS_Z); float* KV = (float*)(arg_ws() + WS_KV);
    constexpr int OV = 0, OKF = 128 * RV_PITCH, OKB = OKF + 128 * RK_PITCH;
    for (int item = opaque_bid(); item < GB * 4 * 32; item += gridDim.x) {
        const int n = item & 31, h = (item >> 5) & 3, bl = item >> 7;
        const size_t row0 = (size_t)bl * SEQ + n * 128;
        const float de_f = arg_in(I_DEC)[(l * 2 + 0) * 4 + h], de_b = arg_in(I_DEC)[(l * 2 + 1) * 4 + h];
        const float l2f = log1pf(-exp2f(-de_f)) * 1.44269504f, l2b = log1pf(-exp2f(-de_b)) * 1.44269504f;
#pragma unroll
        for (int i = 0; i < 8; ++i) { const int id = tid + 512 * i, r = id >> 5, ch = id & 31;
            const u32x4 v = *(const u32x4*)(Z + (row0 + r) * INW + ZC_RV + h * 256 + ch * 8);
            *(LAS u32x4*)(lds + OV + r * RV_PITCH + ch * 16) = v; }
#pragma unroll
        for (int i = 0; i < 4; ++i) { const int id = tid + 512 * i, r = id >> 4, ch = id & 15;
            const u32x4 v = *(const u32x4*)(Z + (row0 + r) * INW + ZC_RK + h * 128 + ch * 8);
            const float sf = fexp2(l2f * (float)(127 - r)), sb = fexp2(l2b * (float)r);
            u32x4 f, b;
            f.x = pk2(bflo(v.x) * sf, bfhi(v.x) * sf); f.y = pk2(bflo(v.y) * sf, bfhi(v.y) * sf); f.z = pk2(bflo(v.z) * sf, bfhi(v.z) * sf); f.w = pk2(bflo(v.w) * sf, bfhi(v.w) * sf);
            b.x = pk2(bflo(v.x) * sb, bfhi(v.x) * sb); b.y = pk2(bflo(v.y) * sb, bfhi(v.y) * sb); b.z = pk2(bflo(v.z) * sb, bfhi(v.z) * sb); b.w = pk2(bflo(v.w) * sb, bfhi(v.w) * sb);
            *(LAS u32x4*)(lds + OKF + r * RK_PITCH + ch * 16) = f; *(LAS u32x4*)(lds + OKB + r * RK_PITCH + ch * 16) = b; }
        __syncthreads();
        f32x4 acc[2][8][2];
#pragma unroll
        for (int d = 0; d < 2; ++d)
#pragma unroll
            for (int mt = 0; mt < 8; ++mt)
#pragma unroll
                for (int nt = 0; nt < 2; ++nt) acc[d][mt][nt] = (f32x4){0.f, 0.f, 0.f, 0.f};
        const int q = fr >> 2, p = fr & 3;
#pragma unroll 1
        for (int ks = 0; ks < 4; ++ks) {
            const int tr0 = 32 * ks + 8 * fq + q;
            bf16x8 Bv[2];
#pragma unroll
            for (int nt = 0; nt < 2; ++nt) { const unsigned ad = lbase + OV + tr0 * RV_PITCH + (32 * w + 16 * nt + 4 * p) * 2; Bv[nt] = tr_frag(ad, ad + 4 * RV_PITCH); }
#pragma unroll
            for (int d = 0; d < 2; ++d) { const unsigned ad = lbase + (d ? OKB : OKF) + tr0 * RK_PITCH + (4 * p) * 2; bf16x8 Ak[8]; tr8(ad, ad + 4 * RK_PITCH, Ak);
#pragma unroll
                for (int mt = 0; mt < 8; ++mt)
#pragma unroll
                    for (int nt = 0; nt < 2; ++nt) acc[d][mt][nt] = mfma16(Ak[mt], Bv[nt], acc[d][mt][nt]); }
        }
#pragma unroll
        for (int d = 0; d < 2; ++d)
#pragma unroll
            for (int nt = 0; nt < 2; ++nt)
#pragma unroll
                for (int mt = 0; mt < 8; ++mt)
                    *(f32x4*)(KV + (((size_t)item * 2 + d) * 256 + 32 * w + 16 * nt + fr) * 128 + 16 * mt + 4 * fq) = acc[d][mt][nt];
        __syncthreads();
    }
}

struct DilIt { int hh, d, L, i0; size_t rowb; };
DI DilIt dil_decode(int item) {
    DilIt it; const int blk = item & 31; it.hh = (item >> 5) % 12; const int bl = item / (32 * 12);
    const int gi = it.hh >> 2; it.d = gi == 0 ? 1 : (gi == 1 ? 4 : 16); it.L = SEQ / it.d; const int bpc = it.L / 128;
    const int r = blk / bpc, qb = blk % bpc; it.i0 = 128 * qb; it.rowb = (size_t)bl * SEQ + r; return it;
}
DI void dil_issue(const bf16_t* Z, const DilIt& it, int tid, u32x4 (&kraw)[8], u32x4 (&vraw)[8]) {
#pragma unroll
    for (int i = 0; i < 8; ++i) { const int id = tid + 512 * i, kk = id >> 4, ch = id & 15; const int j = it.i0 - 64 + kk; const bool ok = (j >= 0) && (j < it.L);
        kraw[i] = (u32x4){0u, 0u, 0u, 0u}; vraw[i] = (u32x4){0u, 0u, 0u, 0u};
        if (ok) { const bf16_t* zr = Z + (it.rowb + (size_t)j * it.d) * INW; kraw[i] = *(const u32x4*)(zr + ZC_DK + it.hh * 128 + ch * 8); vraw[i] = *(const u32x4*)(zr + ZC_DV + it.hh * 128 + ch * 8); } }
}
DI void dil_issue_q(const bf16_t* Z, const DilIt& it, int w, int fr, int fq, u32x4 (&qraw)[4]) {
    const size_t qrow = it.rowb + (size_t)(it.i0 + 16 * w + fr) * it.d;
#pragma unroll
    for (int ks = 0; ks < 4; ++ks) qraw[ks] = *(const u32x4*)(Z + qrow * INW + ZC_DQ + it.hh * 128 + 32 * ks + 8 * fq);
}
template <bool STORE = true> DI void dil_attn_phase(int l, unsigned char* lds_g, LAS unsigned char* lds) {
    const int tid = opaque_tid(), lane = tid & 63, w = tid >> 6, fr = lane & 15, fq = lane >> 4;
    const unsigned lbase = (unsigned)(size_t)lds_g;
    bf16_t* Z = (bf16_t*)(arg_ws() + WS_Z); float* LSE = (float*)(arg_ws() + WS_LSE);
    const float* bt = (const float*)(arg_ws() + WS_BIAS);
    const float* qn = arg_in(I_QN) + l * 128; const float* kn = arg_in(I_KN) + l * 128;
    constexpr int KP = 272, OK = 0, OV = 256 * KP, OB = 2 * 256 * KP, NITEM = GB * 12 * 32;
    int item = opaque_bid();
    if (item >= NITEM) return;
    u32x4 kraw[8], vraw[8];
    DilIt it = dil_decode(item);
    dil_issue(Z, it, tid, kraw, vraw);
    for (;;) {
        const int hh = it.hh, d = it.d, L = it.L, i0 = it.i0; const size_t rowb = it.rowb;
        u32x4 qraw[4]; dil_issue_q(Z, it, w, fr, fq, qraw);
#pragma unroll
        for (int i = 0; i < 8; ++i) { const int id = tid + 512 * i, kk = id >> 4, ch = id & 15;
            const u32x4 kv = kraw[i];
            float f[8] = {bflo(kv.x), bfhi(kv.x), bflo(kv.y), bfhi(kv.y), bflo(kv.z), bfhi(kv.z), bflo(kv.w), bfhi(kv.w)};
            float ss = 0.f;
#pragma unroll
            for (int e = 0; e < 8; ++e) ss += f[e] * f[e];
            ss += __shfl_xor(ss, 1); ss += __shfl_xor(ss, 2); ss += __shfl_xor(ss, 4); ss += __shfl_xor(ss, 8);
            const float rs = __builtin_amdgcn_rsqf(ss * (1.0f / 128.0f) + EPS);
            const f32x4 g0 = *(const f32x4*)(kn + ch * 8), g1 = *(const f32x4*)(kn + ch * 8 + 4);
            u32x4 ko; ko.x = pk2(f[0] * rs * g0[0], f[1] * rs * g0[1]); ko.y = pk2(f[2] * rs * g0[2], f[3] * rs * g0[3]); ko.z = pk2(f[4] * rs * g1[0], f[5] * rs * g1[1]); ko.w = pk2(f[6] * rs * g1[2], f[7] * rs * g1[3]);
            *(LAS u32x4*)(lds + OK + kk * KP + ch * 16) = ko; *(LAS u32x4*)(lds + OV + kk * KP + ch * 16) = vraw[i];
            asm volatile("" ::: "memory"); }
        if (tid < 129) *(LAS float*)(lds + OB + tid * 4) = bt[hh * 129 + tid];
        const size_t qrow = rowb + (size_t)(i0 + 16 * w + fr) * d;
        bf16x8 Qf[4];
        {
            float ss = 0.f;
#pragma unroll
            for (int ks = 0; ks < 4; ++ks) { const u32x4 v = qraw[ks];
                ss += bflo(v.x) * bflo(v.x) + bfhi(v.x) * bfhi(v.x) + bflo(v.y) * bflo(v.y) + bfhi(v.y) * bfhi(v.y) + bflo(v.z) * bflo(v.z) + bfhi(v.z) * bfhi(v.z) + bflo(v.w) * bflo(v.w) + bfhi(v.w) * bfhi(v.w); }
            ss += __shfl_xor(ss, 16); ss += __shfl_xor(ss, 32);
            const float rs = __builtin_amdgcn_rsqf(ss * (1.0f / 128.0f) + EPS) * 0.08838834764831845f;
#pragma unroll
            for (int ks = 0; ks < 4; ++ks) { const u32x4 v = qraw[ks]; const f32x4 g0 = *(const f32x4*)(qn + 32 * ks + 8 * fq), g1 = *(const f32x4*)(qn + 32 * ks + 8 * fq + 4);
                u32x4 o; o.x = pk2(bflo(v.x) * rs * g0[0], bfhi(v.x) * rs * g0[1]); o.y = pk2(bflo(v.y) * rs * g0[2], bfhi(v.y) * rs * g0[3]);
                o.z = pk2(bflo(v.z) * rs * g1[0], bfhi(v.z) * rs * g1[1]); o.w = pk2(bflo(v.w) * rs * g1[2], bfhi(v.w) * rs * g1[3]); Qf[ks] = as_frag(o); }
        }
        __syncthreads();
        const int nitem = item + (int)gridDim.x; const bool has_next = nitem < NITEM;
        f32x4 sc[9];
#pragma unroll
        for (int jt = 0; jt < 9; ++jt) { f32x4 s = (f32x4){0.f, 0.f, 0.f, 0.f};
#pragma unroll
            for (int ks = 0; ks < 4; ++ks) { const bf16x8 kf = *(const LAS bf16x8*)(lds + OK + (16 * w + 16 * jt + fr) * KP + (32 * ks + 8 * fq) * 2); s = mfma16(kf, Qf[ks], s); }
            sc[jt] = s; if (jt % 3 == 2) asm volatile("" ::: "memory"); }
        float mx = -3.0e38f;
        int dlo = 4 * fq - 64 - fr; asm volatile("" : "+v"(dlo));
#pragma unroll
        for (int jt = 0; jt < 9; ++jt)
#pragma unroll
            for (int e = 0; e < 4; ++e) { const int dl = 16 * jt + e + dlo; const int j = i0 + 16 * w + fr + dl;
                const bool ok = (dl >= -64) && (dl <= 64) && (j >= 0) && (j < L);
                const int bi = dl < -64 ? 0 : (dl > 64 ? 128 : dl + 64);
                const float v = ok ? sc[jt][e] + *(const LAS float*)(lds + OB + bi * 4) : -1.0e30f; sc[jt][e] = v; mx = fmaxf(mx, v); }
        mx = fmaxf(mx, __shfl_xor(mx, 16)); mx = fmaxf(mx, __shfl_xor(mx, 32));
        float den = 0.f;
#pragma unroll
        for (int jt = 0; jt < 9; ++jt)
#pragma unroll
            for (int e = 0; e < 4; ++e) { const float pv = fexp2((sc[jt][e] - mx) * 1.44269504f); sc[jt][e] = pv; den += pv; }
        den += __shfl_xor(den, 16); den += __shfl_xor(den, 32);
        f32x4 oc[8];
#pragma unroll
        for (int c = 0; c < 8; ++c) oc[c] = (f32x4){0.f, 0.f, 0.f, 0.f};
        const int q = fr >> 2, p = fr & 3;
#pragma unroll
        for (int kp = 0; kp < 5; ++kp) {
            u32x4 pw; pw.x = pk2(sc[2 * kp][0], sc[2 * kp][1]); pw.y = pk2(sc[2 * kp][2], sc[2 * kp][3]);
            if (kp < 4) { pw.z = pk2(sc[2 * kp + 1 > 8 ? 8 : 2 * kp + 1][0], sc[2 * kp + 1 > 8 ? 8 : 2 * kp + 1][1]); pw.w = pk2(sc[2 * kp + 1 > 8 ? 8 : 2 * kp + 1][2], sc[2 * kp + 1 > 8 ? 8 : 2 * kp + 1][3]); }
            else { pw.z = 0u; pw.w = 0u; }
            const bf16x8 Pf = as_frag(pw);
            const int ra = 16 * w + 32 * kp + 4 * fq + q, rb = kp < 4 ? ra + 16 : ra;
            bf16x8 Vf[8]; tr8(lbase + OV + ra * KP + (4 * p) * 2, lbase + OV + rb * KP + (4 * p) * 2, Vf);
#pragma unroll
            for (int c = 0; c < 8; ++c) oc[c] = mfma16(Vf[c], Pf, oc[c]);
        }
        const float rden = 1.0f / den;
        if (STORE || den == -1.0f) {
#pragma unroll
        for (int c = 0; c < 8; ++c) { u32x2 o; o.x = pk2(oc[c][0] * rden, oc[c][1] * rden); o.y = pk2(oc[c][2] * rden, oc[c][3] * rden);
            *(u32x2*)(Z + qrow * INW + ZC_DQ + hh * 128 + 16 * c + 4 * fq) = o; }
        if (fq == 0) LSE[qrow * 12 + hh] = mx + logf(den);
        }
        if (!has_next) break;
        item = nitem;
        __syncthreads();
        it = dil_decode(nitem); dil_issue(Z, it, tid, kraw, vraw);
    }
    __syncthreads();
}

DI void scan_combine_phase(int l) {
    const int gt = opaque_bid() * NTHREADS + opaque_tid(), NGT = gridDim.x * NTHREADS;
    const f32x4* KV = (const f32x4*)(arg_ws() + WS_KV); u32x2* S = (u32x2*)(arg_ws() + WS_S);
    for (int v = gt; v < GB * 4 * 2 * 8192; v += NGT) {
        const int bh = v >> 14, dir = (v >> 13) & 1, e4 = v & 8191, h = bh & 3;
        const float de = arg_in(I_DEC)[(l * 2 + dir) * 4 + h];
        const float cd = exp2f(log1pf(-exp2f(-de)) * 1.44269504f * 128.0f);
        f32x4 st = (f32x4){0.f, 0.f, 0.f, 0.f};
#pragma unroll 8
        for (int step = 0; step < 32; ++step) { const int n = dir ? 31 - step : step; const size_t idx = ((size_t)(bh * 32 + n) * 2 + dir) * 8192 + e4;
            u32x2 o; o.x = pk2(st[0], st[1]); o.y = pk2(st[2], st[3]); S[idx] = o;
            const f32x4 kv = KV[idx]; st = st * cd + kv; }
    }
    const bf16_t* Z = (const bf16_t*)(arg_ws() + WS_Z); const float* LSE = (const float*)(arg_ws() + WS_LSE); bf16_t* DL = (bf16_t*)(arg_ws() + WS_DL);
    for (int id = gt; id < GT * 64; id += NGT) {
        const int tok = id >> 6, j = (id >> 4) & 3, ch = id & 15;
        const float l0 = LSE[tok * 12 + j], l1 = LSE[tok * 12 + 4 + j], l2 = LSE[tok * 12 + 8 + j];
        const float mx = fmaxf(l0, fmaxf(l1, l2));
        float w0 = __expf(l0 - mx), w1 = __expf(l1 - mx), w2 = __expf(l2 - mx); const float rw = 1.0f / (w0 + w1 + w2); w0 *= rw; w1 *= rw; w2 *= rw;
        const bf16_t* zr = Z + (size_t)tok * INW + ZC_DQ + j * 128 + ch * 8;
        const u32x4 a0 = *(const u32x4*)zr, a1 = *(const u32x4*)(zr + 512), a2 = *(const u32x4*)(zr + 1024);
        u32x4 o;
        o.x = pk2(w0 * bflo(a0.x) + w1 * bflo(a1.x) + w2 * bflo(a2.x), w0 * bfhi(a0.x) + w1 * bfhi(a1.x) + w2 * bfhi(a2.x));
        o.y = pk2(w0 * bflo(a0.y) + w1 * bflo(a1.y) + w2 * bflo(a2.y), w0 * bfhi(a0.y) + w1 * bfhi(a1.y) + w2 * bfhi(a2.y));
        o.z = pk2(w0 * bflo(a0.z) + w1 * bflo(a1.z) + w2 * bflo(a2.z), w0 * bfhi(a0.z) + w1 * bfhi(a1.z) + w2 * bfhi(a2.z));
        o.w = pk2(w0 * bflo(a0.w) + w1 * bflo(a1.w) + w2 * bflo(a2.w), w0 * bfhi(a0.w) + w1 * bfhi(a1.w) + w2 * bfhi(a2.w));
        *(u32x4*)(DL + (size_t)tok * 512 + j * 128 + ch * 8) = o;
    }
}

DI void ret_out_phase(int l, unsigned char* lds_g, LAS unsigned char* lds) {
    const int tid = opaque_tid(), lane = tid & 63, w = tid >> 6, fr = lane & 15, fq = lane >> 4;
    const unsigned lbase = (unsigned)(size_t)lds_g;
    const bf16_t* Z = (const bf16_t*)(arg_ws() + WS_Z); const bf16_t* S = (const bf16_t*)(arg_ws() + WS_S); bf16_t* R = (bf16_t*)(arg_ws() + WS_R);
    const float* rn = arg_in(I_RNORM) + l * 1024;
    constexpr int OQ = 0, OKP = 128 * RK_PITCH, OV = 2 * 128 * RK_PITCH, OT = OV + 128 * RV_PITCH;
    for (int item = opaque_bid(); item < GB * 4 * 32; item += gridDim.x) {
        const int n = item & 31, h = (item >> 5) & 3, bl = item >> 7;
        const size_t row0 = (size_t)bl * SEQ + n * 128;
        const float de_f = arg_in(I_DEC)[(l * 2 + 0) * 4 + h], de_b = arg_in(I_DEC)[(l * 2 + 1) * 4 + h];
        const float l2f = log1pf(-exp2f(-de_f)) * 1.44269504f, l2b = log1pf(-exp2f(-de_b)) * 1.44269504f;
#pragma unroll
        for (int i = 0; i < 8; ++i) { const int id = tid + 512 * i, r = id >> 5, ch = id & 31;
            *(LAS u32x4*)(lds + OV + r * RV_PITCH + ch * 16) = *(const u32x4*)(Z + (row0 + r) * INW + ZC_RV + h * 256 + ch * 8); }
#pragma unroll
        for (int i = 0; i < 4; ++i) { const int id = tid + 512 * i, r = id >> 4, ch = id & 15;
            *(LAS u32x4*)(lds + OQ + r * RK_PITCH + ch * 16) = *(const u32x4*)(Z + (row0 + r) * INW + ZC_RQ + h * 128 + ch * 8);
            *(LAS u32x4*)(lds + OKP + r * RK_PITCH + ch * 16) = *(const u32x4*)(Z + (row0 + r) * INW + ZC_RK + h * 128 + ch * 8); }
        __syncthreads();
        {
            bf16x8 Qf[4];
#pragma unroll
            for (int ks = 0; ks < 4; ++ks) Qf[ks] = *(const LAS bf16x8*)(lds + OQ + (16 * w + fr) * RK_PITCH + (32 * ks + 8 * fq) * 2);
            u32x2 pw[8];
            const int i = 16 * w + fr;
#pragma unroll
            for (int jt = 0; jt < 8; ++jt) { f32x4 s = (f32x4){0.f, 0.f, 0.f, 0.f};
#pragma unroll
                for (int ks = 0; ks < 4; ++ks) { const bf16x8 kf = *(const LAS bf16x8*)(lds + OKP + (16 * jt + fr) * RK_PITCH + (32 * ks + 8 * fq) * 2); s = mfma16(kf, Qf[ks], s); }
                int io = i - 4 * fq; asm volatile("" : "+v"(io));
#pragma unroll
                for (int e = 0; e < 4; ++e) { const int x = io - (16 * jt + e); const float dm = fexp2(x >= 0 ? l2f * (float)x : l2b * (float)(-x)); s[e] *= dm; }
                pw[jt].x = pk2(s[0], s[1]); pw[jt].y = pk2(s[2], s[3]); asm volatile("" ::: "memory"); }
            __syncthreads();
#pragma unroll
            for (int jt = 0; jt < 8; ++jt) *(LAS u32x2*)(lds + OKP + i * RK_PITCH + (16 * jt + 4 * fq) * 2) = pw[jt];
        }
        __syncthreads();
        f32x4 O[2][8];
        {
            const int q = fr >> 2, p = fr & 3;
#pragma unroll 1
            for (int dir = 0; dir < 2; ++dir) {
                const bf16_t* Sd = S + (((size_t)item * 2 + dir) * 256 + 32 * w) * 128;
#pragma unroll
                for (int m = 0; m < 2; ++m) {
                    f32x4 T[8];
#pragma unroll
                    for (int nt = 0; nt < 8; ++nt) T[nt] = (f32x4){0.f, 0.f, 0.f, 0.f};
#pragma unroll 1
                    for (int ks = 0; ks < 4; ++ks) {
                        const bf16x8 Af = as_frag(*(const u32x4*)(Sd + (16 * m + fr) * 128 + 32 * ks + 8 * fq));
#pragma unroll
                        for (int nt = 0; nt < 8; ++nt) { const bf16x8 qf = *(const LAS bf16x8*)(lds + OQ + (16 * nt + fr) * RK_PITCH + (32 * ks + 8 * fq) * 2); T[nt] = mfma16(Af, qf, T[nt]); }
                    }
                    int fro = fr; asm volatile("" : "+v"(fro));
#pragma unroll
                    for (int nt = 0; nt < 8; ++nt) { const int i = 16 * nt + fro; const float sc = dir ? fexp2(l2b * (float)(128 - i)) : fexp2(l2f * (float)(i + 1));
                        if (dir) O[m][nt] += T[nt] * sc; else O[m][nt] = T[nt] * sc; }
                    asm volatile("" ::: "memory");
                }
            }
#pragma unroll 1
            for (int ks = 0; ks < 4; ++ks) {
                bf16x8 Vf[2];
                const int tr0 = 32 * ks + 8 * fq + q;
#pragma unroll
                for (int m = 0; m < 2; ++m) { const unsigned ad = lbase + OV + tr0 * RV_PITCH + (32 * w + 16 * m + 4 * p) * 2; Vf[m] = tr_frag(ad, ad + 4 * RV_PITCH); }
#pragma unroll
                for (int nt = 0; nt < 8; ++nt) { const bf16x8 pf = *(const LAS bf16x8*)(lds + OKP + (16 * nt + fr) * RK_PITCH + (32 * ks + 8 * fq) * 2);
#pragma unroll
                    for (int m = 0; m < 2; ++m) O[m][nt] = mfma16(Vf[m], pf, O[m][nt]); }
            }
        }
#pragma unroll
        for (int nt = 0; nt < 8; ++nt) { float ss = 0.f;
#pragma unroll
            for (int m = 0; m < 2; ++m)
#pragma unroll
                for (int e = 0; e < 4; ++e) ss += O[m][nt][e] * O[m][nt][e];
            ss += __shfl_xor(ss, 16); ss += __shfl_xor(ss, 32);
            if (fq == 0) *(LAS float*)(lds + OT + (w * 128 + 16 * nt + fr) * 4) = ss; }
        __syncthreads();
#pragma unroll
        for (int nt = 0; nt < 8; ++nt) { const int i = 16 * nt + fr; float tot = 0.f;
#pragma unroll
            for (int ww = 0; ww < 8; ++ww) tot += *(const LAS float*)(lds + OT + (ww * 128 + i) * 4);
            const float rinv = __builtin_amdgcn_rsqf(tot * (1.0f / 256.0f) + EPS);
#pragma unroll
            for (int m = 0; m < 2; ++m) { const int dv = h * 256 + 32 * w + 16 * m + 4 * fq;
                const u32x2 gz = *(const u32x2*)(Z + (row0 + i) * INW + ZC_RG + dv); const f32x4 gn = *(const f32x4*)(rn + dv);
                const float o0 = O[m][nt][0] * rinv * gn[0] * fsilu(bflo(gz.x)), o1 = O[m][nt][1] * rinv * gn[1] * fsilu(bfhi(gz.x));
                const float o2 = O[m][nt][2] * rinv * gn[2] * fsilu(bflo(gz.y)), o3 = O[m][nt][3] * rinv * gn[3] * fsilu(bfhi(gz.y));
                u32x2 o; o.x = pk2(o0, o1); o.y = pk2(o2, o3);
                *(u32x2*)(R + (row0 + i) * 1024 + dv) = o; }
            asm volatile("" ::: "memory"); }
        __syncthreads();
    }
}

#ifndef PHMASK
#define PHMASK 0xffff
#endif
#define PH(k) ((PHMASK >> (k)) & 1)

#define XB_TMO      128
#define XB_XCNT(j)  (256  + 64 * (j))
#define XB_XSUB(j)  (1280 + 64 * (j))
#define XB_XGEN(j)  (2304 + 64 * (j))
#define XB_TOP      3328
#define XB_TOPGEN   3392
#define XCD_BAR_WORDS 3456
#define XB_SPIN_CAP (1u << 22)
DI unsigned xb_ld(unsigned* p)              { return __hip_atomic_load(p, __ATOMIC_RELAXED, __HIP_MEMORY_SCOPE_AGENT); }
DI unsigned xb_add(unsigned* p, unsigned v) { return __hip_atomic_fetch_add(p, v, __ATOMIC_RELAXED, __HIP_MEMORY_SCOPE_AGENT); }
DI unsigned xb_xcc_id() { return (unsigned)__builtin_amdgcn_s_getreg((3 << 11) | 20) & 0xFu; }
#define XB_SPIN(cond, bar) do { unsigned _sp = 0; while (cond) { __builtin_amdgcn_s_sleep(1); \
    if ((++_sp & 255u) == 0u) { if (xb_ld(&(bar)[XB_TMO])) break; if (_sp > XB_SPIN_CAP) { atomicAdd(&(bar)[XB_TMO], 1u); break; } } } } while (0)
DI void xcd_barrier_complete(unsigned* bar, unsigned x, unsigned& nloc, unsigned& nx) {
    const unsigned G = gridDim.x * gridDim.y * gridDim.z;
    unsigned sum, cnt, mine, sp = 0u;
    for (;;) {
        sum = 0u; cnt = 0u; mine = 0u;
#pragma unroll
        for (unsigned j = 0; j < 16; ++j) { const unsigned c = xb_ld(&bar[XB_XCNT(j)]); sum += c; cnt += (c > 0u) ? 1u : 0u; mine = (j == x) ? c : mine; }
        if (sum == G) break;
        __builtin_amdgcn_s_sleep(1);
        if ((++sp & 255u) == 0u) { if (xb_ld(&bar[XB_TMO])) break; if (sp > XB_SPIN_CAP) { atomicAdd(&bar[XB_TMO], 1u); break; } }
    }
    nloc = mine > 0u ? mine : 1u; nx = cnt > 0u ? cnt : 1u;
}
DI void xcd_barrier(unsigned* bar, volatile LAS unsigned* st) {
    asm volatile("s_waitcnt vmcnt(0)" ::: "memory");
    __syncthreads();
    if (threadIdx.x == 0) {
        __builtin_amdgcn_s_waitcnt(0);
        const unsigned x = xb_xcc_id();
        unsigned nloc = st[0], nx = st[1];
        if (nloc == 0u) { xcd_barrier_complete(bar, x, nloc, nx); st[0] = nloc; st[1] = nx; }
        const unsigned old = xb_add(&bar[XB_XSUB(x)], 1u);
        const unsigned gen = old / nloc;
        if (old + 1u == (gen + 1u) * nloc) {
            __builtin_amdgcn_fence(__ATOMIC_RELEASE, "agent");
            asm volatile("s_waitcnt vmcnt(0)" ::: "memory");
            const unsigned og = xb_add(&bar[XB_TOP], 1u);
            const unsigned tg = og / nx;
            if (og + 1u == (tg + 1u) * nx) xb_add(&bar[XB_TOPGEN], 1u);
            else XB_SPIN(xb_ld(&bar[XB_TOPGEN]) == tg, bar);
            __builtin_amdgcn_fence(__ATOMIC_ACQUIRE, "agent");
            xb_add(&bar[XB_XGEN(x)], 1u);
            asm volatile("s_waitcnt vmcnt(0)" ::: "memory");
        } else {
            XB_SPIN(xb_ld(&bar[XB_XGEN(x)]) == gen, bar);
            __builtin_amdgcn_fence(__ATOMIC_ACQUIRE, "agent");
            asm volatile("s_waitcnt vmcnt(0)" ::: "memory");
        }
    }
    __syncthreads();
}

DI void ph_win(LAS unsigned char* lds, int l, int g) {
    unsigned char* ws = arg_ws(); const size_t rb = (size_t)g * GT;
    pg8::Gemm gm{(const bf16_t*)(ws + WS_XB) + rb * D, (const bf16_t*)(ws + WS_W + (size_t)l * LW + OW_IN), GT, INW, D}; pg8::StaticOrder S; S.init(GT, INW, gridDim.x, opaque_bid());
    pg8::EpiZ E{(bf16_t*)(ws + WS_Z), (const float*)(ws + WS_SLOT) + rb * 16, (const float*)(ws + WS_ROPE), (const float*)(ws + WS_ROPE) + SEQ * 64}; pg8::gemm_phase(lds, gm, S, E);
}
DI void ph_post1(LAS unsigned char* lds, int l) {
    unsigned char* ws = arg_ws();
    pg8::Gemm gm{(const bf16_t*)(ws + WS_R), (const bf16_t*)(ws + WS_W + (size_t)l * LW + OW_RO), GT, D, D}; pg8::StaticOrder S; S.init(GT, D, gridDim.x, opaque_bid());
    pg8::EpiGate<false> E{(const bf16_t*)(ws + WS_Z) + ZC_GR, arg_in(I_BG) + l * 2048, (float*)(ws + WS_Y1), (bf16_t*)(ws + WS_MB)}; pg8::gemm_phase(lds, gm, S, E);
}
DI void ph_post2(LAS unsigned char* lds, int l) {
    unsigned char* ws = arg_ws();
    pg8::Gemm gm{(const bf16_t*)(ws + WS_DL), (const bf16_t*)(ws + WS_W + (size_t)l * LW + OW_DO), GT, D, 512}; pg8::StaticOrder S; S.init(GT, D, gridDim.x, opaque_bid());
    pg8::EpiGate<true> E{(const bf16_t*)(ws + WS_Z) + ZC_GD, arg_in(I_BG) + l * 2048 + 1024, (float*)(ws + WS_Y1), (bf16_t*)(ws + WS_MB)}; pg8::gemm_phase(lds, gm, S, E);
}
DI void ph_out(LAS unsigned char* lds, int l, int g) {
    unsigned char* ws = arg_ws(); const size_t rb = (size_t)g * GT;
    pg8::Gemm gm{(const bf16_t*)(ws + WS_MB), (const bf16_t*)(ws + WS_W + (size_t)l * LW + OW_OUT), GT, D, D}; pg8::StaticOrder S; S.init(GT, D, gridDim.x, opaque_bid());
    pg8::EpiRes E{arg_out() + rb * D, (bf16_t*)(ws + WS_XB) + rb * D, (float*)(ws + WS_SLOT) + rb * 16, 1.0f}; pg8::gemm_phase(lds, gm, S, E);
}
DI void ph_gu(LAS unsigned char* lds, int l, int half) {
    unsigned char* ws = arg_ws();
    pg8::Gemm gm{(const bf16_t*)(ws + WS_XB), (const bf16_t*)(ws + WS_W + (size_t)l * LW + (half ? OW_GU2 : OW_GU1)), NTOK, 5632, D}; pg8::StaticOrder S; S.init(NTOK, 5632, gridDim.x, opaque_bid());
    pg8::EpiSwiGLU E{(bf16_t*)(ws + WS_H), (const float*)(ws + WS_SLOT)}; pg8::gemm_phase(lds, gm, S, E);
}
DI void ph_down(LAS unsigned char* lds, int l, int half) {
    unsigned char* ws = arg_ws();
    pg8::Gemm gm{(const bf16_t*)(ws + WS_H), (const bf16_t*)(ws + WS_W + (size_t)l * LW + (half ? OW_D2 : OW_D1)), NTOK, D, FF}; pg8::StaticOrder S; S.init(NTOK, D, gridDim.x, opaque_bid());
    pg8::EpiRes E{arg_out(), (bf16_t*)(ws + WS_XB), (float*)(ws + WS_SLOT), 0.5f}; pg8::gemm_phase(lds, gm, S, E);
}

__global__ void __launch_bounds__(NTHREADS, 2) mega_fwd(Args a) {
    extern __shared__ __attribute__((aligned(16))) unsigned char lds_g[];
    LAS unsigned char* lds = (LAS unsigned char*)lds_g;
    cg::grid_group grid = cg::this_grid();
    volatile LAS unsigned* bst = (volatile LAS unsigned*)(lds + LDS_BYTES - 16);
    if (threadIdx.x < 4) bst[threadIdx.x] = 0u;
    __syncthreads();
    if (threadIdx.x == 0) (void)xb_add((unsigned*)arg_ws() + XB_XCNT(xb_xcc_id()), 1u);
#define GSYNC() xcd_barrier((unsigned*)arg_ws(), bst)
    if (PH(0)) prep_phase(lds);
    grid.sync();
#pragma unroll 1
    for (int l = 0; l < DEPTH; ++l) {
#pragma unroll 1
        for (int half = 0; half < 2; ++half) {
            if (half == 1) {
#pragma unroll 1
                for (int g = 0; g < NGRP; ++g) {
                    if (PH(1)) ph_win(lds, l, g);
                    GSYNC();
                    if (PH(2)) ret_kv_phase(l, lds_g, lds);
                    if (PH(3)) dil_attn_phase(l, lds_g, lds);
                    GSYNC();
                    if (PH(4)) scan_combine_phase(l);
                    GSYNC();
                    if (PH(5)) ret_out_phase(l, lds_g, lds);
                    GSYNC();
                    if (PH(6)) ph_post1(lds, l);
                    if (PH(7)) ph_post2(lds, l);
                    GSYNC();
                    if (PH(8)) ph_out(lds, l, g);
                }
                GSYNC();
            }
            if (PH(9)) ph_gu(lds, l, half);
            GSYNC();
            if (PH(10)) ph_down(lds, l, half);
            if (l != DEPTH - 1 || half != 1) GSYNC();
        }
    }
}

extern "C" void kernel_launch(void* const* d_in, const int* in_sizes, int n_in, void* d_out, int out_size, void* d_ws, size_t ws_size, hipStream_t stream) {
    static int grid = 0;
    if (grid == 0) {
        if (n_in != 20 || out_size != NTOK * D || ws_size < WS_H + (size_t)NTOK * FF * 2 || ws_size < WS_END) { fprintf(stderr, "kernel_launch: unexpected shapes / workspace (n_in %d out %d ws %zu)\n", n_in, out_size, ws_size); grid = -1; return; }
        int dev = 0, cus = 0, per_cu = 0;
        if (hipGetDevice(&dev) != hipSuccess || hipDeviceGetAttribute(&cus, hipDeviceAttributeMultiprocessorCount, dev) != hipSuccess) { grid = -1; return; }
        if (hipFuncSetAttribute((const void*)mega_fwd, hipFuncAttributeMaxDynamicSharedMemorySize, LDS_BYTES) != hipSuccess) { fprintf(stderr, "kernel_launch: hipFuncSetAttribute failed\n"); grid = -1; return; }
        if (hipOccupancyMaxActiveBlocksPerMultiprocessor(&per_cu, (const void*)mega_fwd, NTHREADS, LDS_BYTES) != hipSuccess || per_cu < 1) { fprintf(stderr, "kernel_launch: occupancy query failed (%d)\n", per_cu); (void)hipGetLastError(); per_cu = 1; }
        grid = cus * per_cu;
    }
    if (grid < 0) return;
    if (hipMemsetAsync(d_ws, 0, 16384, stream) != hipSuccess) { fprintf(stderr, "kernel_launch: memset failed\n"); return; }
    Args a{};
    for (int i = 0; i < 20; ++i) a.in[i] = (const float*)d_in[i];
    a.out = (float*)d_out; a.ws = (unsigned char*)d_ws;
    void* args[] = {&a};
    hipError_t e = hipLaunchCooperativeKernel((const void*)mega_fwd, dim3(grid), dim3(NTHREADS), args, LDS_BYTES, stream);
    if (e != hipSuccess) fprintf(stderr, "kernel_launch: cooperative launch failed: %s (grid %d)\n", hipGetErrorString(e), grid);
}
```

```cpp
#include <hip/hip_runtime.h>
#include <hip/hip_cooperative_groups.h>
#include <cstdio>
#include <cstdint>
namespace cg = cooperative_groups;

#define DI __device__ __forceinline__
#define LAS __attribute__((address_space(3)))
typedef unsigned short bf16_t;
typedef short bf16x8 __attribute__((ext_vector_type(8)));
typedef short s16x4 __attribute__((ext_vector_type(4)));
typedef float f32x4 __attribute__((ext_vector_type(4)));
typedef unsigned u32x4 __attribute__((ext_vector_type(4)));
typedef unsigned u32x2 __attribute__((ext_vector_type(2)));

constexpr int D = 1024, FF = 2816, SEQ = 4096, NBATCH = 16, NTOK = NBATCH * SEQ, DEPTH = 4, INW = 9728;
constexpr int GB = 4, GT = GB * SEQ, NGRP = NBATCH / GB;
constexpr int ZC_RQ = 0, ZC_RK = 512, ZC_RV = 1024, ZC_RG = 2048, ZC_DQ = 3072, ZC_DK = 4608, ZC_DV = 6144, ZC_GR = 7680, ZC_GD = 8704;
constexpr float EPS = 1e-6f;
constexpr int NTHREADS = 512;
constexpr int LDS_BYTES = 147456;

constexpr size_t MiB = 1u << 20;
constexpr size_t WS_ROPE = 1 * MiB;
constexpr size_t WS_BIAS = 3 * MiB;
constexpr size_t WS_SLOT = 4 * MiB;
constexpr size_t WS_W = 8 * MiB;
constexpr size_t OW_GU1 = 0, OW_D1 = OW_GU1 + (size_t)5632 * 1024 * 2, OW_IN = OW_D1 + (size_t)1024 * 2816 * 2, OW_RO = OW_IN + (size_t)INW * 1024 * 2,
                 OW_DO = OW_RO + (size_t)1024 * 1024 * 2, OW_OUT = OW_DO + (size_t)1024 * 512 * 2, OW_GU2 = OW_OUT + (size_t)1024 * 1024 * 2,
                 OW_D2 = OW_GU2 + (size_t)5632 * 1024 * 2, LW = OW_D2 + (size_t)1024 * 2816 * 2;
static_assert(LW == 57 * MiB, "layer weight bytes");
constexpr size_t WS_XB = WS_W + DEPTH * LW;
constexpr size_t WS_BIG = WS_XB + (size_t)NTOK * D * 2;
constexpr size_t WS_H = WS_BIG;
constexpr size_t WS_Z = WS_BIG;
constexpr size_t WS_KV = WS_Z + (size_t)GT * INW * 2;
constexpr size_t WS_Y1 = WS_KV;
constexpr size_t WS_MB = WS_KV + (size_t)GT * D * 4;
constexpr size_t WS_S = WS_KV + (size_t)512 * 2 * 32768 * 4;
constexpr size_t WS_R = WS_S + (size_t)512 * 2 * 32768 * 2;
constexpr size_t WS_DL = WS_R + (size_t)GT * 1024 * 2;
constexpr size_t WS_LSE = WS_DL + (size_t)GT * 512 * 2;
constexpr size_t WS_END = WS_LSE + (size_t)GT * 12 * 4;
static_assert(WS_H + (size_t)NTOK * FF * 2 <= ((size_t)1 << 30) && WS_END <= ((size_t)1 << 30), "workspace fits 1 GiB");

DI int opaque_tid() { int t = threadIdx.x; asm volatile("" : "+v"(t)); return t; }
DI int opaque_bid() { int t = blockIdx.x; asm volatile("" : "+s"(t)); return t; }
DI unsigned pk2(float lo, float hi) { unsigned r; asm("v_cvt_pk_bf16_f32 %0, %1, %2" : "=v"(r) : "v"(lo), "v"(hi)); return r; }
DI float bflo(unsigned u) { return __uint_as_float(u << 16); }
DI float bfhi(unsigned u) { return __uint_as_float(u & 0xffff0000u); }
DI float fexp2(float x) { return __builtin_amdgcn_exp2f(x); }
DI float frcp(float x) { return __builtin_amdgcn_rcpf(x); }
DI float fsigmoid(float x) { return frcp(1.0f + fexp2(-1.44269504f * x)); }
DI float fsilu(float x) { return x * fsigmoid(x); }
DI bf16x8 as_frag(u32x4 v) { return __builtin_bit_cast(bf16x8, v); }
DI f32x4 mfma16(bf16x8 a, bf16x8 b, f32x4 c) { return __builtin_amdgcn_mfma_f32_16x16x32_bf16(a, b, c, 0, 0, 0); }
DI bf16x8 tr_frag(unsigned a0, unsigned a1) {
    s16x4 lo, hi;
    asm volatile("ds_read_b64_tr_b16 %0, %2\n\tds_read_b64_tr_b16 %1, %3\n\ts_waitcnt lgkmcnt(0)" : "=&v"(lo), "=&v"(hi) : "v"(a0), "v"(a1) : "memory");
    bf16x8 r; r[0] = lo[0]; r[1] = lo[1]; r[2] = lo[2]; r[3] = lo[3]; r[4] = hi[0]; r[5] = hi[1]; r[6] = hi[2]; r[7] = hi[3]; return r;
}
DI void tr4(unsigned a0, unsigned a1, bf16x8& o0, bf16x8& o1, bf16x8& o2, bf16x8& o3) {
    s16x4 l0, l1, l2, l3, h0, h1, h2, h3;
    asm volatile(
        "ds_read_b64_tr_b16 %0, %8\n\tds_read_b64_tr_b16 %4, %9\n\t"
        "ds_read_b64_tr_b16 %1, %8 offset:32\n\tds_read_b64_tr_b16 %5, %9 offset:32\n\t"
        "ds_read_b64_tr_b16 %2, %8 offset:64\n\tds_read_b64_tr_b16 %6, %9 offset:64\n\t"
        "ds_read_b64_tr_b16 %3, %8 offset:96\n\tds_read_b64_tr_b16 %7, %9 offset:96\n\t"
        "s_waitcnt lgkmcnt(0)"
        : "=&v"(l0), "=&v"(l1), "=&v"(l2), "=&v"(l3), "=&v"(h0), "=&v"(h1), "=&v"(h2), "=&v"(h3)
        : "v"(a0), "v"(a1) : "memory");
#define TR_PACK(o, lo, hi) o[0] = lo[0]; o[1] = lo[1]; o[2] = lo[2]; o[3] = lo[3]; o[4] = hi[0]; o[5] = hi[1]; o[6] = hi[2]; o[7] = hi[3];
    TR_PACK(o0, l0, h0) TR_PACK(o1, l1, h1) TR_PACK(o2, l2, h2) TR_PACK(o3, l3, h3)
#undef TR_PACK
}
DI void tr8(unsigned a0, unsigned a1, bf16x8 (&out)[8]) {
    tr4(a0, a1, out[0], out[1], out[2], out[3]);
    tr4(a0 + 128u, a1 + 128u, out[4], out[5], out[6], out[7]);
}
DI float row_scale(const float* slots, int row, int fq) {
    const f32x4 s = *(const f32x4*)(slots + (size_t)row * 16 + 4 * fq);
    float t = (s[0] + s[1]) + (s[2] + s[3]);
    t += __shfl_xor(t, 16); t += __shfl_xor(t, 32);
    return __builtin_amdgcn_rsqf(t * (1.0f / D) + EPS);
}

namespace pg8 {
constexpr int BM = 256, BK = 64, HALF = 128, HTB = HALF * BK * 2, STAGE_BYTES = 8 * HTB, NXCD = 8, WGM = 8;
__host__ __device__ __forceinline__ int lds_byte(int r, int c) { const int st = (r >> 4) * 2 + (c >> 5), rr = r & 15, cc = c & 31, ob = rr * 64 + cc * 2; return st * 1024 + (ob ^ (((ob >> 9) & 1) << 5)); }
__host__ __device__ __forceinline__ void stage_rc(int b, int& R, int& C) { const int st = b / 1024, sb = b % 1024, swz = sb ^ (((sb >> 9) & 1) << 5); R = (st >> 1) * 16 + swz / 64; C = (st & 1) * 32 + (swz % 64) / 2; }
__host__ __device__ __forceinline__ int perm32(int rho) { const int n = rho >> 4, i = rho & 15; return 8 * (i >> 2) + 4 * n + (i & 3); }
struct Unit { int pm, pn; };
struct Gemm { const bf16_t* A; const bf16_t* Bt; int M, N, K; };
struct StaticOrder {
    int nM, nN, nwg, G, c;
    DI void init(int M, int N, int G_, int c_) { nM = M / BM; nN = N / BM; nwg = nM * nN; G = G_; c = c_; }
    DI bool next(int i, Unit& u) const {
        const long L = (long)i * G + c; if (L >= nwg) return false;
        int wgid = (int)L; { const int q = nwg / NXCD, r = nwg % NXCD, xcd = wgid % NXCD, off = wgid / NXCD; wgid = (xcd < r ? xcd * (q + 1) : r * (q + 1) + (xcd - r) * q) + off; }
        const int nig = WGM * nN, gid = wgid / nig, fm = gid * WGM, gsz = (nM - fm) < WGM ? (nM - fm) : WGM;
        u.pm = fm + ((wgid % nig) % gsz); u.pn = (wgid % nig) / gsz; return true;
    }
};
template <class Epi>
DI void gemm_phase(LAS unsigned char* lds, const Gemm g, const StaticOrder& S, const Epi& E) {
    const int tid = opaque_tid(), wid = __builtin_amdgcn_readfirstlane(tid >> 6), lane = tid & 63, wr = wid >> 2, wc = wid & 3, fr = lane & 15, fq = lane >> 4;
    const int K = g.K, nt = K / BK;
    unsigned voffA[2], voffB[2];
#pragma unroll
    for (int i = 0; i < 2; ++i) { int R, C; stage_rc(tid * 16 + i * 8192, R, C); const int Rb = Epi::PERM ? ((R & ~31) + perm32(R & 31)) : R;
        voffA[i] = (unsigned)(R * K + C) * 2u; voffB[i] = (unsigned)(Rb * K + C) * 2u; }
    const size_t kstep = (size_t)(BK * 2);
    const size_t hstep = (size_t)HALF * K * 2;
    const size_t tstep = 2 * hstep;
    const unsigned ldsw = (unsigned)wid * 1024u;
    const int aoff = lds_byte(wr * 64 + fr, fq * 8), boff = lds_byte(wc * 32 + fr, fq * 8);
#define PG8_SA(b, h) (((b) * 2 + (h)) * HTB)
#define PG8_SB(b, h) ((4 + (b) * 2 + (h)) * HTB)
#define PG8_STAGE(bufoff, gbase, voff) do { _Pragma("unroll") for (int _i = 0; _i < 2; ++_i) \
        __builtin_amdgcn_global_load_lds((const unsigned*)((const char*)(gbase) + (voff)[_i]), (LAS unsigned*)(lds + (bufoff) + ldsw + _i * 8192), 16, 0, 0); } while (0)
#define PG8_LDA(dst, b, h) do { _Pragma("unroll") for (int m = 0; m < 4; ++m) _Pragma("unroll") for (int k = 0; k < 2; ++k) dst[m][k] = *(const LAS bf16x8*)(lds + PG8_SA(b, h) + aoff + m * 2048 + k * 1024); } while (0)
#define PG8_LDB(dst, b, h) do { _Pragma("unroll") for (int n = 0; n < 2; ++n) _Pragma("unroll") for (int k = 0; k < 2; ++k) dst[n][k] = *(const LAS bf16x8*)(lds + PG8_SB(b, h) + boff + n * 2048 + k * 1024); } while (0)
#define PG8_MMA(ai, bj, At, Bt) do { __builtin_amdgcn_s_setprio(1); _Pragma("unroll") for (int m = 0; m < 4; ++m) _Pragma("unroll") for (int n = 0; n < 2; ++n) _Pragma("unroll") for (int k = 0; k < 2; ++k) \
        acc[ai][bj][m][n] = __builtin_amdgcn_mfma_f32_16x16x32_bf16(Bt[n][k], At[m][k], acc[ai][bj][m][n], 0, 0, 0); __builtin_amdgcn_s_setprio(0); } while (0)
#define PG8_WAIT_V(n) asm volatile("s_waitcnt vmcnt(" #n ")" ::: "memory")
#define PG8_WAIT_L(n) asm volatile("s_waitcnt lgkmcnt(" #n ")" ::: "memory")
#define PG8_BAR __builtin_amdgcn_s_barrier()
#define PG8_SCHED __builtin_amdgcn_sched_barrier(0)
    Unit cur, nxt; int ui = 0;
    if (!S.next(0, cur)) return;
    f32x4 acc[2][2][4][2];
#pragma unroll
    for (int a = 0; a < 2; ++a)
#pragma unroll
        for (int b = 0; b < 2; ++b)
#pragma unroll
            for (int m = 0; m < 4; ++m)
#pragma unroll
                for (int n = 0; n < 2; ++n) acc[a][b][m][n] = (f32x4){0.f, 0.f, 0.f, 0.f};
    bf16x8 At[4][2], B0[2][2], B1[2][2];
    const char* cA = (const char*)g.A + (size_t)cur.pm * tstep; const char* cB = (const char*)g.Bt + (size_t)cur.pn * tstep;
    PG8_STAGE(PG8_SB(0, 0), cB, voffB); PG8_STAGE(PG8_SB(0, 1), cB + hstep, voffB); PG8_STAGE(PG8_SA(0, 0), cA, voffA); PG8_STAGE(PG8_SA(0, 1), cA + hstep, voffA);
    if (wr == 1) PG8_BAR;
    PG8_WAIT_V(2); PG8_BAR;
    PG8_STAGE(PG8_SB(1, 0), cB + kstep, voffB); PG8_STAGE(PG8_SA(1, 0), cA + kstep, voffA); PG8_STAGE(PG8_SB(1, 1), cB + hstep + kstep, voffB);
    PG8_WAIT_V(6); PG8_BAR;
    for (;;) {
        const bool has_next = S.next(ui + 1, nxt);
        const char* nA = has_next ? (const char*)g.A + (size_t)nxt.pm * tstep : cA; const char* nB = has_next ? (const char*)g.Bt + (size_t)nxt.pn * tstep : cB;
        for (int t = 0; t < nt; t += 2) {
            const bool last = (t == nt - 2);
            const char* a1 = cA + (size_t)(t + 1) * kstep;
            const char* a2 = last ? nA : cA + (size_t)(t + 2) * kstep; const char* b2 = last ? nB : cB + (size_t)(t + 2) * kstep;
            const char* a3 = a2 + kstep; const char* b3 = b2 + kstep;
            PG8_LDB(B0, 0, 0); PG8_LDB(B1, 0, 1); PG8_SCHED; PG8_LDA(At, 0, 0); PG8_STAGE(PG8_SA(1, 1), a1 + hstep, voffA);
            PG8_WAIT_V(8); PG8_WAIT_L(0); PG8_BAR; PG8_MMA(0, 0, At, B0); PG8_MMA(0, 1, At, B1); PG8_BAR; PG8_SCHED;
            PG8_LDA(At, 0, 1); PG8_STAGE(PG8_SB(0, 0), b2, voffB); PG8_STAGE(PG8_SB(0, 1), b2 + hstep, voffB); PG8_STAGE(PG8_SA(0, 0), a2, voffA);
            PG8_WAIT_V(8); PG8_WAIT_L(0); PG8_BAR; PG8_MMA(1, 0, At, B0); PG8_MMA(1, 1, At, B1); PG8_BAR; PG8_SCHED;
            PG8_LDB(B0, 1, 0); PG8_LDB(B1, 1, 1); PG8_SCHED; PG8_LDA(At, 1, 0); PG8_STAGE(PG8_SA(0, 1), a2 + hstep, voffA);
            PG8_WAIT_V(8); PG8_WAIT_L(0); PG8_BAR; PG8_MMA(0, 0, At, B0); PG8_MMA(0, 1, At, B1); PG8_BAR; PG8_SCHED;
            PG8_LDA(At, 1, 1); PG8_STAGE(PG8_SB(1, 0), b3, voffB); PG8_STAGE(PG8_SB(1, 1), b3 + hstep, voffB); PG8_STAGE(PG8_SA(1, 0), a3, voffA);
            PG8_WAIT_V(8); PG8_WAIT_L(0); PG8_BAR; PG8_MMA(1, 0, At, B0); PG8_MMA(1, 1, At, B1); PG8_BAR; PG8_SCHED;
        }
        if (wr == 0) PG8_BAR;
        E(acc, cur, wr, wc, fr, fq);
        if (!has_next) break;
#pragma unroll
        for (int a = 0; a < 2; ++a)
#pragma unroll
            for (int b = 0; b < 2; ++b)
#pragma unroll
                for (int m = 0; m < 4; ++m)
#pragma unroll
                    for (int n = 0; n < 2; ++n) acc[a][b][m][n] = (f32x4){0.f, 0.f, 0.f, 0.f};
        cur = nxt; cA = nA; cB = nB; ++ui;
        if (wr == 1) PG8_BAR;
    }
    PG8_WAIT_V(0);
    PG8_BAR;
#undef PG8_SA
#undef PG8_SB
#undef PG8_STAGE
#undef PG8_LDA
#undef PG8_LDB
#undef PG8_MMA
#undef PG8_WAIT_V
#undef PG8_WAIT_L
#undef PG8_BAR
#undef PG8_SCHED
}

struct EpiSwiGLU {
    static constexpr bool PERM = true;
    bf16_t* H; const float* slots;
    DI void operator()(const f32x4 (&acc)[2][2][4][2], const Unit& u, int wr, int wc, int fr, int fq) const {
        const int col0 = u.pn * 128 + wc * 32 + 8 * fq;
        const int rowb = u.pm * BM + wr * 64 + fr;
        f32x4 sl[2][4];
#pragma unroll
        for (int ai = 0; ai < 2; ++ai)
#pragma unroll
            for (int m = 0; m < 4; ++m) sl[ai][m] = *(const f32x4*)(slots + (size_t)(rowb + ai * HALF + m * 16) * 16 + 4 * fq);
        asm volatile("" ::: "memory");
#pragma unroll
        for (int ai = 0; ai < 2; ++ai)
#pragma unroll
            for (int m = 0; m < 4; ++m) {
                const int row = rowb + ai * HALF + m * 16;
                float t = (sl[ai][m][0] + sl[ai][m][1]) + (sl[ai][m][2] + sl[ai][m][3]);
                t += __shfl_xor(t, 16); t += __shfl_xor(t, 32);
                const float rs = __builtin_amdgcn_rsqf(t * (1.0f / D) + EPS);
                float h[8];
#pragma unroll
                for (int n = 0; n < 2; ++n)
#pragma unroll
                    for (int j = 0; j < 4; ++j) { const float gv = acc[ai][0][m][n][j] * rs, uv = acc[ai][1][m][n][j] * rs; h[n * 4 + j] = fsilu(gv) * uv; }
                u32x4 w; w.x = pk2(h[0], h[1]); w.y = pk2(h[2], h[3]); w.z = pk2(h[4], h[5]); w.w = pk2(h[6], h[7]);
                *(u32x4*)(H + (size_t)row * FF + col0) = w;
            }
    }
};
struct EpiRes {
    static constexpr bool PERM = false;
    float* x; bf16_t* xb; float* slots; float s;
    DI void operator()(const f32x4 (&acc)[2][2][4][2], const Unit& u, int wr, int wc, int fr, int fq) const {
        const int col0 = u.pn * BM + wc * 32 + 4 * fq;
#pragma unroll
        for (int ai = 0; ai < 2; ++ai) {
            const int rowa = u.pm * BM + ai * HALF + wr * 64 + fr;
            f32x4 xo[4][2][2];
#pragma unroll
            for (int m = 0; m < 4; ++m)
#pragma unroll
                for (int bj = 0; bj < 2; ++bj)
#pragma unroll
                    for (int n = 0; n < 2; ++n) xo[m][bj][n] = *(const f32x4*)(x + (size_t)(rowa + m * 16) * D + col0 + bj * HALF + n * 16);
            asm volatile("" ::: "memory");
#pragma unroll
            for (int m = 0; m < 4; ++m) {
                const int row = rowa + m * 16;
                float* xr = x + (size_t)row * D + col0; bf16_t* br = xb + (size_t)row * D + col0;
                float ss = 0.f;
#pragma unroll
                for (int bj = 0; bj < 2; ++bj)
#pragma unroll
                    for (int n = 0; n < 2; ++n) {
                        const f32x4 xn = xo[m][bj][n] + acc[ai][bj][m][n] * s;
                        *(f32x4*)(xr + bj * HALF + n * 16) = xn;
                        u32x2 w; w.x = pk2(xn[0], xn[1]); w.y = pk2(xn[2], xn[3]);
                        *(u32x2*)(br + bj * HALF + n * 16) = w;
                        ss += (xn[0] * xn[0] + xn[1] * xn[1]) + (xn[2] * xn[2] + xn[3] * xn[3]);
                    }
                ss += __shfl_xor(ss, 16); ss += __shfl_xor(ss, 32);
                if (fq == 0) slots[(size_t)row * 16 + u.pn * 4 + wc] = ss;
            }
            asm volatile("" ::: "memory");
        }
    }
};
struct EpiZ {
    static constexpr bool PERM = true;
    bf16_t* Z; const float* slots; const float* cs; const float* sn;
    DI void operator()(const f32x4 (&acc)[2][2][4][2], const Unit& u, int wr, int wc, int fr, int fq) const {
        const int col0 = u.pn * BM + wc * 32 + 8 * fq;
        const bool rope = u.pn < 4; const float ksc = (u.pn >= 2) ? 0.08838834764831845f : 1.0f;
        const int fi = 4 * (4 * wc + fq);
        const int rowb = u.pm * BM + wr * 64 + fr;
        f32x4 sl[2][4];
#pragma unroll
        for (int ai = 0; ai < 2; ++ai)
#pragma unroll
            for (int m = 0; m < 4; ++m) sl[ai][m] = *(const f32x4*)(slots + (size_t)(rowb + ai * HALF + m * 16) * 16 + 4 * fq);
        asm volatile("" ::: "memory");
#pragma unroll
        for (int ai = 0; ai < 2; ++ai) {
            f32x4 c4[4], s4[4];
#pragma unroll
            for (int m = 0; m < 4; ++m) { c4[m] = (f32x4){1.f, 1.f, 1.f, 1.f}; s4[m] = (f32x4){0.f, 0.f, 0.f, 0.f}; }
            if (rope) {
#pragma unroll
                for (int m = 0; m < 4; ++m) { const int pos = (rowb + ai * HALF + m * 16) & (SEQ - 1); c4[m] = *(const f32x4*)(cs + pos * 64 + fi); s4[m] = *(const f32x4*)(sn + pos * 64 + fi); }
            }
            asm volatile("" ::: "memory");
#pragma unroll
            for (int m = 0; m < 4; ++m) {
                const int row = rowb + ai * HALF + m * 16;
                float t = (sl[ai][m][0] + sl[ai][m][1]) + (sl[ai][m][2] + sl[ai][m][3]);
                t += __shfl_xor(t, 16); t += __shfl_xor(t, 32);
                const float rs = __builtin_amdgcn_rsqf(t * (1.0f / D) + EPS);
#pragma unroll
                for (int bj = 0; bj < 2; ++bj) {
                    f32x4 v0 = acc[ai][bj][m][0] * rs, v1 = acc[ai][bj][m][1] * rs;
                    if (rope) { const f32x4 o0 = (v0 * c4[m] - v1 * s4[m]) * ksc, o1 = (v0 * s4[m] + v1 * c4[m]) * ksc; v0 = o0; v1 = o1; }
                    u32x4 w; w.x = pk2(v0[0], v0[1]); w.y = pk2(v0[2], v0[3]); w.z = pk2(v1[0], v1[1]); w.w = pk2(v1[2], v1[3]);
                    *(u32x4*)(Z + (size_t)row * INW + col0 + bj * HALF) = w;
                }
            }
            asm volatile("" ::: "memory");
        }
    }
};
template <bool SECOND> struct EpiGate {
    static constexpr bool PERM = true;
    const bf16_t* Zg; const float* bg; float* Y1; bf16_t* Mb;
    DI void operator()(const f32x4 (&acc)[2][2][4][2], const Unit& u, int wr, int wc, int fr, int fq) const {
        const int col0 = u.pn * BM + wc * 32 + 8 * fq;
        const int rowb = u.pm * BM + wr * 64 + fr;
        f32x4 bb[2][2];
#pragma unroll
        for (int bj = 0; bj < 2; ++bj) { bb[bj][0] = *(const f32x4*)(bg + col0 + bj * HALF); bb[bj][1] = *(const f32x4*)(bg + col0 + bj * HALF + 4); }
#pragma unroll
        for (int ai = 0; ai < 2; ++ai)
#pragma unroll
            for (int mp = 0; mp < 2; ++mp) {
                u32x4 zg[2][2]; f32x4 y0[2][2], y1[2][2];
#pragma unroll
                for (int mm = 0; mm < 2; ++mm)
#pragma unroll
                    for (int bj = 0; bj < 2; ++bj) { const int row = rowb + ai * HALF + (2 * mp + mm) * 16, col = col0 + bj * HALF;
                        zg[mm][bj] = *(const u32x4*)(Zg + (size_t)row * INW + col);
                        if (SECOND) { y0[mm][bj] = *(const f32x4*)(Y1 + (size_t)row * D + col); y1[mm][bj] = *(const f32x4*)(Y1 + (size_t)row * D + col + 4); } }
                asm volatile("" ::: "memory");
#pragma unroll
                for (int mm = 0; mm < 2; ++mm)
#pragma unroll
                    for (int bj = 0; bj < 2; ++bj) { const int m = 2 * mp + mm; const int row = rowb + ai * HALF + m * 16, col = col0 + bj * HALF;
                        const u32x4 z = zg[mm][bj]; const f32x4 b0 = bb[bj][0], b1 = bb[bj][1];
                        f32x4 g0, g1;
                        g0[0] = fsigmoid(bflo(z.x) + b0[0]); g0[1] = fsigmoid(bfhi(z.x) + b0[1]); g0[2] = fsigmoid(bflo(z.y) + b0[2]); g0[3] = fsigmoid(bfhi(z.y) + b0[3]);
                        g1[0] = fsigmoid(bflo(z.z) + b1[0]); g1[1] = fsigmoid(bfhi(z.z) + b1[1]); g1[2] = fsigmoid(bflo(z.w) + b1[2]); g1[3] = fsigmoid(bfhi(z.w) + b1[3]);
                        f32x4 v0 = g0 * acc[ai][bj][m][0], v1 = g1 * acc[ai][bj][m][1];
                        if (!SECOND) { float* yp = Y1 + (size_t)row * D + col; *(f32x4*)yp = v0; *(f32x4*)(yp + 4) = v1; }
                        else { v0 += y0[mm][bj]; v1 += y1[mm][bj];
                            u32x4 w; w.x = pk2(v0[0], v0[1]); w.y = pk2(v0[2], v0[3]); w.z = pk2(v1[0], v1[1]); w.w = pk2(v1[2], v1[3]);
                            *(u32x4*)(Mb + (size_t)row * D + col) = w; } }
                asm volatile("" ::: "memory");
            }
    }
};
}

struct Args { const float* in[20]; float* out; unsigned char* ws; };
typedef void* const __attribute__((address_space(4)))* kargp_t;
DI void* karg(int i) { kargp_t p = (kargp_t)__builtin_amdgcn_kernarg_segment_ptr(); asm volatile("" : "+s"(p)); return p[i]; }
DI const float* arg_in(int i) { return (const float*)karg(i); }
DI float* arg_out() { return (float*)karg(20); }
DI unsigned char* arg_ws() { return (unsigned char*)karg(21); }
enum { I_X = 0, I_RELB, I_NF1, I_G1, I_U1, I_D1, I_NMIX, I_WIN, I_BG, I_DEC, I_RNORM, I_WRO, I_QN, I_KN, I_WDO, I_WOUT, I_NF2, I_G2, I_U2, I_D2 };

DI int sigma_rope(int p) { return ((p & 4) ? 64 : 0) + 4 * (p >> 3) + (p & 3); }
DI void conv_item(int kind, const float* src, const float* src2, int ldsrc, const float* gain, int K, int N, bf16_t* Bt, LAS float* scr, int item, int lane) {
    const int nblk = N / 32, kb = item / nblk, nb = item % nblk, k0 = 64 * kb, n0 = 32 * nb;
    const int n = n0 + (lane & 31);
    const float* sp;
    if (kind == 1) { const int tile = n >> 8, r = n & 255; sp = (r < 128 ? src : src2) + tile * 128 + (r & 127); }
    else if (kind == 2) { sp = src + (n < 1024 ? (n & ~127) + sigma_rope(n & 127) : n); }
    else sp = src + n;
    float vv[32];
#pragma unroll
    for (int i = 0; i < 32; ++i) { const int kk = 2 * i + (lane >> 5); vv[i] = sp[(size_t)(k0 + kk) * ldsrc]; }
    if (gain) {
#pragma unroll
        for (int i = 0; i < 32; ++i) { const int kk = 2 * i + (lane >> 5); vv[i] *= gain[k0 + kk]; } }
#pragma unroll
    for (int i = 0; i < 32; ++i) { const int kk = 2 * i + (lane >> 5); scr[kk * 33 + (lane & 31)] = vv[i]; }
    asm volatile("s_waitcnt lgkmcnt(0)" ::: "memory");
    const int c = lane & 7;
#pragma unroll
    for (int j = 0; j < 4; ++j) { const int nn = (lane >> 3) + 8 * j; const LAS float* s = scr + (8 * c) * 33 + nn;
        u32x4 o; o.x = pk2(s[0 * 33], s[1 * 33]); o.y = pk2(s[2 * 33], s[3 * 33]); o.z = pk2(s[4 * 33], s[5 * 33]); o.w = pk2(s[6 * 33], s[7 * 33]);
        *(u32x4*)(Bt + (size_t)(n0 + nn) * K + k0 + 8 * c) = o; }
    asm volatile("s_waitcnt lgkmcnt(0)" ::: "memory");
}
DI int t5_bucket(int rel) {
    const int n = rel < 0 ? -rel : rel; int ret = rel > 0 ? 16 : 0;
    const float nf = (float)(n < 1 ? 1 : n);
    int large = 8 + (int)(logf(nf / 8.0f) / logf(128.0f) * 8.0f);
    large = large < 15 ? large : 15;
    return ret + (n < 8 ? n : large);
}
DI void prep_phase(LAS unsigned char* lds) {
    const int tid = opaque_tid(), lane = tid & 63, wave = tid >> 6;
    const int gw = opaque_bid() * 8 + wave, NGW = gridDim.x * 8;
    const int gt = opaque_bid() * NTHREADS + tid, NGT = gridDim.x * NTHREADS;
    unsigned char* ws = arg_ws();
    {
        bf16_t* xb = (bf16_t*)(ws + WS_XB); float* slots = (float*)(ws + WS_SLOT);
        for (int row = gw; row < NTOK; row += NGW) {
            const f32x4* xr = (const f32x4*)(arg_in(I_X) + (size_t)row * D) + lane;
            f32x4* orow = (f32x4*)(arg_out() + (size_t)row * D) + lane;
            u32x2* brow = (u32x2*)(xb + (size_t)row * D) + lane;
            float ss = 0.f;
#pragma unroll
            for (int j = 0; j < 4; ++j) { const f32x4 v = xr[64 * j]; orow[64 * j] = v; u32x2 w; w.x = pk2(v[0], v[1]); w.y = pk2(v[2], v[3]); brow[64 * j] = w;
                ss += (v[0] * v[0] + v[1] * v[1]) + (v[2] * v[2] + v[3] * v[3]); }
#pragma unroll
            for (int o = 1; o < 64; o <<= 1) ss += __shfl_xor(ss, o);
            if (lane < 16) slots[(size_t)row * 16 + lane] = lane == 0 ? ss : 0.f;
        }
    }
    {
        float* cs = (float*)(ws + WS_ROPE); float* sn = cs + SEQ * 64;
        for (int i = gt; i < SEQ * 64; i += NGT) { const int pos = i >> 6, f = i & 63;
            const float inv = powf(10000.0f, -(float)f / 64.0f); const float ang = (float)pos * inv; cs[i] = cosf(ang); sn[i] = sinf(ang); }
    }
    {
        float* bt = (float*)(ws + WS_BIAS);
        for (int i = gt; i < 12 * 129; i += NGT) { const int hh = i / 129, dl = i % 129 - 64; const int gi = hh >> 2, d = gi == 0 ? 1 : (gi == 1 ? 4 : 16);
            bt[i] = arg_in(I_RELB)[t5_bucket(dl * d) * 12 + hh]; }
    }
    {
        LAS float* scr = (LAS float*)(lds + wave * 16384);
        constexpr int I_GU = 16 * 176, I_DN = 44 * 32, I_IN = 16 * 304, I_RO = 16 * 32, I_DO = 8 * 32, I_OU = 16 * 32;
        constexpr int PER_LAYER = 2 * I_GU + 2 * I_DN + I_IN + I_RO + I_DO + I_OU;
        for (int it = gw; it < DEPTH * PER_LAYER; it += NGW) {
            const int l = it / PER_LAYER; int r = it % PER_LAYER;
            unsigned char* wl = ws + WS_W + (size_t)l * LW;
            if (r < I_GU) { conv_item(1, arg_in(I_G1) + (size_t)l * D * FF, arg_in(I_U1) + (size_t)l * D * FF, FF, arg_in(I_NF1) + l * D, D, 5632, (bf16_t*)(wl + OW_GU1), scr, r, lane); continue; } r -= I_GU;
            if (r < I_GU) { conv_item(1, arg_in(I_G2) + (size_t)l * D * FF, arg_in(I_U2) + (size_t)l * D * FF, FF, arg_in(I_NF2) + l * D, D, 5632, (bf16_t*)(wl + OW_GU2), scr, r, lane); continue; } r -= I_GU;
            if (r < I_DN) { conv_item(0, arg_in(I_D1) + (size_t)l * FF * D, nullptr, D, nullptr, FF, D, (bf16_t*)(wl + OW_D1), scr, r, lane); continue; } r -= I_DN;
            if (r < I_DN) { conv_item(0, arg_in(I_D2) + (size_t)l * FF * D, nullptr, D, nullptr, FF, D, (bf16_t*)(wl + OW_D2), scr, r, lane); continue; } r -= I_DN;
            if (r < I_IN) { conv_item(2, arg_in(I_WIN) + (size_t)l * D * INW, nullptr, INW, arg_in(I_NMIX) + l * D, D, INW, (bf16_t*)(wl + OW_IN), scr, r, lane); continue; } r -= I_IN;
            if (r < I_RO) { conv_item(0, arg_in(I_WRO) + (size_t)l * D * D, nullptr, D, nullptr, D, D, (bf16_t*)(wl + OW_RO), scr, r, lane); continue; } r -= I_RO;
            if (r < I_DO) { conv_item(0, arg_in(I_WDO) + (size_t)l * 512 * D, nullptr, D, nullptr, 512, D, (bf16_t*)(wl + OW_DO), scr, r, lane); continue; } r -= I_DO;
            conv_item(0, arg_in(I_WOUT) + (size_t)l * D * D, nullptr, D, nullptr, D, D, (bf16_t*)(wl + OW_OUT), scr, r, lane);
        }
    }
}

constexpr int RV_PITCH = 528, RK_PITCH = 272;
DI void ret_kv_phase(int l, unsigned char* lds_g, LAS unsigned char* lds) {
    const int tid = opaque_tid(), lane = tid & 63, w = tid >> 6, fr = lane & 15, fq = lane >> 4;
    const unsigned lbase = (unsigned)(size_t)lds_g;
    const bf16_t* Z = (const bf16_t*)(arg_ws() + WS_Z); bf16_t* KV = (bf16_t*)(arg_ws() + WS_KV);
    constexpr int OV = 0, OKF = 128 * RV_PITCH, OKB = OKF + 128 * RK_PITCH;
    for (int item = opaque_bid(); item < GB * 4 * 32; item += gridDim.x) {
        const int n = item & 31, h = (item >> 5) & 3, bl = item >> 7;
        const size_t row0 = (size_t)bl * SEQ + n * 128;
        const float de_f = arg_in(I_DEC)[(l * 2 + 0) * 4 + h], de_b = arg_in(I_DEC)[(l * 2 + 1) * 4 + h];
        const float l2f = log1pf(-exp2f(-de_f)) * 1.44269504f, l2b = log1pf(-exp2f(-de_b)) * 1.44269504f;
#pragma unroll
        for (int i = 0; i < 8; ++i) { const int id = tid + 512 * i, r = id >> 5, ch = id & 31;
            const u32x4 v = *(const u32x4*)(Z + (row0 + r) * INW + ZC_RV + h * 256 + ch * 8);
            *(LAS u32x4*)(lds + OV + r * RV_PITCH + ch * 16) = v; }
#pragma unroll
        for (int i = 0; i < 4; ++i) { const int id = tid + 512 * i, r = id >> 4, ch = id & 15;
            const u32x4 v = *(const u32x4*)(Z + (row0 + r) * INW + ZC_RK + h * 128 + ch * 8);
            const float sf = fexp2(l2f * (float)(127 - r)), sb = fexp2(l2b * (float)r);
            u32x4 f, b;
            f.x = pk2(bflo(v.x) * sf, bfhi(v.x) * sf); f.y = pk2(bflo(v.y) * sf, bfhi(v.y) * sf); f.z = pk2(bflo(v.z) * sf, bfhi(v.z) * sf); f.w = pk2(bflo(v.w) * sf, bfhi(v.w) * sf);
            b.x = pk2(bflo(v.x) * sb, bfhi(v.x) * sb); b.y = pk2(bflo(v.y) * sb, bfhi(v.y) * sb); b.z = pk2(bflo(v.z) * sb, bfhi(v.z) * sb); b.w = pk2(bflo(v.w) * sb, bfhi(v.w) * sb);
            *(LAS u32x4*)(lds + OKF + r * RK_PITCH + ch * 16) = f; *(LAS u32x4*)(lds + OKB + r * RK_PITCH + ch * 16) = b; }
        __syncthreads();
        f32x4 acc[2][8][2];
#pragma unroll
        for (int d = 0; d < 2; ++d)
#pragma unroll
            for (int mt = 0; mt < 8; ++mt)
#pragma unroll
                for (int nt = 0; nt < 2; ++nt) acc[d][mt][nt] = (f32x4){0.f, 0.f, 0.f, 0.f};
        const int q = fr >> 2, p = fr & 3;
#pragma unroll 1
        for (int ks = 0; ks < 4; ++ks) {
            const int tr0 = 32 * ks + 8 * fq + q;
            bf16x8 Bv[2];
#pragma unroll
            for (int nt = 0; nt < 2; ++nt) { const unsigned ad = lbase + OV + tr0 * RV_PITCH + (32 * w + 16 * nt + 4 * p) * 2; Bv[nt] = tr_frag(ad, ad + 4 * RV_PITCH); }
#pragma unroll
            for (int d = 0; d < 2; ++d) { const unsigned ad = lbase + (d ? OKB : OKF) + tr0 * RK_PITCH + (4 * p) * 2; bf16x8 Ak[8]; tr8(ad, ad + 4 * RK_PITCH, Ak);
#pragma unroll
                for (int mt = 0; mt < 8; ++mt)
#pragma unroll
                    for (int nt = 0; nt < 2; ++nt) acc[d][mt][nt] = mfma16(Ak[mt], Bv[nt], acc[d][mt][nt]); }
        }
#pragma unroll
        for (int d = 0; d < 2; ++d)
#pragma unroll
            for (int nt = 0; nt < 2; ++nt)
#pragma unroll
                for (int mt = 0; mt < 8; ++mt)
                    { u32x2 o; o.x = pk2(acc[d][mt][nt][0], acc[d][mt][nt][1]); o.y = pk2(acc[d][mt][nt][2], acc[d][mt][nt][3]);
                      *(u32x2*)(KV + (((size_t)item * 2 + d) * 256 + 32 * w + 16 * nt + fr) * 128 + 16 * mt + 4 * fq) = o; }
        __syncthreads();
    }
}

struct DilIt { int hh, d, L, i0; size_t rowb; };
DI DilIt dil_decode(int item) {
    DilIt it; const int blk = item & 31; it.hh = (item >> 5) % 12; const int bl = item / (32 * 12);
    const int gi = it.hh >> 2; it.d = gi == 0 ? 1 : (gi == 1 ? 4 : 16); it.L = SEQ / it.d; const int bpc = it.L / 128;
    const int r = blk / bpc, qb = blk % bpc; it.i0 = 128 * qb; it.rowb = (size_t)bl * SEQ + r; return it;
}
DI void dil_issue(const bf16_t* Z, const DilIt& it, int tid, u32x4 (&kraw)[8], u32x4 (&vraw)[8]) {
#pragma unroll
    for (int i = 0; i < 8; ++i) { const int id = tid + 512 * i, kk = id >> 4, ch = id & 15; const int j = it.i0 - 64 + kk; const bool ok = (j >= 0) && (j < it.L);
        kraw[i] = (u32x4){0u, 0u, 0u, 0u}; vraw[i] = (u32x4){0u, 0u, 0u, 0u};
        if (ok) { const bf16_t* zr = Z + (it.rowb + (size_t)j * it.d) * INW; kraw[i] = *(const u32x4*)(zr + ZC_DK + it.hh * 128 + ch * 8); vraw[i] = *(const u32x4*)(zr + ZC_DV + it.hh * 128 + ch * 8); } }
}
DI void dil_issue_q(const bf16_t* Z, const DilIt& it, int w, int fr, int fq, u32x4 (&qraw)[4]) {
    const size_t qrow = it.rowb + (size_t)(it.i0 + 16 * w + fr) * it.d;
#pragma unroll
    for (int ks = 0; ks < 4; ++ks) qraw[ks] = *(const u32x4*)(Z + qrow * INW + ZC_DQ + it.hh * 128 + 32 * ks + 8 * fq);
}
template <bool STORE = true> DI void dil_attn_phase(int l, unsigned char* lds_g, LAS unsigned char* lds) {
    const int tid = opaque_tid(), lane = tid & 63, w = tid >> 6, fr = lane & 15, fq = lane >> 4;
    const unsigned lbase = (unsigned)(size_t)lds_g;
    bf16_t* Z = (bf16_t*)(arg_ws() + WS_Z); float* LSE = (float*)(arg_ws() + WS_LSE);
    const float* bt = (const float*)(arg_ws() + WS_BIAS);
    const float* qn = arg_in(I_QN) + l * 128; const float* kn = arg_in(I_KN) + l * 128;
    constexpr int KP = 272, OK = 0, OV = 256 * KP, OB = 2 * 256 * KP, NITEM = GB * 12 * 32;
    int item = opaque_bid();
    if (item >= NITEM) return;
    u32x4 kraw[8], vraw[8];
    DilIt it = dil_decode(item);
    dil_issue(Z, it, tid, kraw, vraw);
    for (;;) {
        const int hh = it.hh, d = it.d, L = it.L, i0 = it.i0; const size_t rowb = it.rowb;
        u32x4 qraw[4]; dil_issue_q(Z, it, w, fr, fq, qraw);
#pragma unroll
        for (int i = 0; i < 8; ++i) { const int id = tid + 512 * i, kk = id >> 4, ch = id & 15;
            const u32x4 kv = kraw[i];
            float f[8] = {bflo(kv.x), bfhi(kv.x), bflo(kv.y), bfhi(kv.y), bflo(kv.z), bfhi(kv.z), bflo(kv.w), bfhi(kv.w)};
            float ss = 0.f;
#pragma unroll
            for (int e = 0; e < 8; ++e) ss += f[e] * f[e];
            ss += __shfl_xor(ss, 1); ss += __shfl_xor(ss, 2); ss += __shfl_xor(ss, 4); ss += __shfl_xor(ss, 8);
            const float rs = __builtin_amdgcn_rsqf(ss * (1.0f / 128.0f) + EPS);
            const f32x4 g0 = *(const f32x4*)(kn + ch * 8), g1 = *(const f32x4*)(kn + ch * 8 + 4);
            u32x4 ko; ko.x = pk2(f[0] * rs * g0[0], f[1] * rs * g0[1]); ko.y = pk2(f[2] * rs * g0[2], f[3] * rs * g0[3]); ko.z = pk2(f[4] * rs * g1[0], f[5] * rs * g1[1]); ko.w = pk2(f[6] * rs * g1[2], f[7] * rs * g1[3]);
            *(LAS u32x4*)(lds + OK + kk * KP + ch * 16) = ko; *(LAS u32x4*)(lds + OV + kk * KP + ch * 16) = vraw[i];
            asm volatile("" ::: "memory"); }
        if (tid < 129) *(LAS float*)(lds + OB + tid * 4) = bt[hh * 129 + tid];
        const size_t qrow = rowb + (size_t)(i0 + 16 * w + fr) * d;
        bf16x8 Qf[4];
        {
            float ss = 0.f;
#pragma unroll
            for (int ks = 0; ks < 4; ++ks) { const u32x4 v = qraw[ks];
                ss += bflo(v.x) * bflo(v.x) + bfhi(v.x) * bfhi(v.x) + bflo(v.y) * bflo(v.y) + bfhi(v.y) * bfhi(v.y) + bflo(v.z) * bflo(v.z) + bfhi(v.z) * bfhi(v.z) + bflo(v.w) * bflo(v.w) + bfhi(v.w) * bfhi(v.w); }
            ss += __shfl_xor(ss, 16); ss += __shfl_xor(ss, 32);
            const float rs = __builtin_amdgcn_rsqf(ss * (1.0f / 128.0f) + EPS) * 0.08838834764831845f;
#pragma unroll
            for (int ks = 0; ks < 4; ++ks) { const u32x4 v = qraw[ks]; const f32x4 g0 = *(const f32x4*)(qn + 32 * ks + 8 * fq), g1 = *(const f32x4*)(qn + 32 * ks + 8 * fq + 4);
                u32x4 o; o.x = pk2(bflo(v.x) * rs * g0[0], bfhi(v.x) * rs * g0[1]); o.y = pk2(bflo(v.y) * rs * g0[2], bfhi(v.y) * rs * g0[3]);
                o.z = pk2(bflo(v.z) * rs * g1[0], bfhi(v.z) * rs * g1[1]); o.w = pk2(bflo(v.w) * rs * g1[2], bfhi(v.w) * rs * g1[3]); Qf[ks] = as_frag(o); }
        }
        __syncthreads();
        const int nitem = item + (int)gridDim.x; const bool has_next = nitem < NITEM;
        if (has_next) { it = dil_decode(nitem); dil_issue(Z, it, tid, kraw, vraw); }
        f32x4 sc[9];
#pragma unroll
        for (int jt = 0; jt < 9; ++jt) { f32x4 s = (f32x4){0.f, 0.f, 0.f, 0.f};
#pragma unroll
            for (int ks = 0; ks < 4; ++ks) { const bf16x8 kf = *(const LAS bf16x8*)(lds + OK + (16 * w + 16 * jt + fr) * KP + (32 * ks + 8 * fq) * 2); s = mfma16(kf, Qf[ks], s); }
            sc[jt] = s; if (jt % 3 == 2) asm volatile("" ::: "memory"); }
        float mx = -3.0e38f;
        int dlo = 4 * fq - 64 - fr; asm volatile("" : "+v"(dlo));
#pragma unroll
        for (int jt = 0; jt < 9; ++jt)
#pragma unroll
            for (int e = 0; e < 4; ++e) { const int dl = 16 * jt + e + dlo; const int j = i0 + 16 * w + fr + dl;
                const bool ok = (dl >= -64) && (dl <= 64) && (j >= 0) && (j < L);
                const int bi = dl < -64 ? 0 : (dl > 64 ? 128 : dl + 64);
                const float v = ok ? sc[jt][e] + *(const LAS float*)(lds + OB + bi * 4) : -1.0e30f; sc[jt][e] = v; mx = fmaxf(mx, v); }
        mx = fmaxf(mx, __shfl_xor(mx, 16)); mx = fmaxf(mx, __shfl_xor(mx, 32));
        float den = 0.f;
#pragma unroll
        for (int jt = 0; jt < 9; ++jt)
#pragma unroll
            for (int e = 0; e < 4; ++e) { const float pv = fexp2((sc[jt][e] - mx) * 1.44269504f); sc[jt][e] = pv; den += pv; }
        den += __shfl_xor(den, 16); den += __shfl_xor(den, 32);
        f32x4 oc[8];
#pragma unroll
        for (int c = 0; c < 8; ++c) oc[c] = (f32x4){0.f, 0.f, 0.f, 0.f};
        const int q = fr >> 2, p = fr & 3;
#pragma unroll
        for (int kp = 0; kp < 5; ++kp) {
            u32x4 pw; pw.x = pk2(sc[2 * kp][0], sc[2 * kp][1]); pw.y = pk2(sc[2 * kp][2], sc[2 * kp][3]);
            if (kp < 4) { pw.z = pk2(sc[2 * kp + 1 > 8 ? 8 : 2 * kp + 1][0], sc[2 * kp + 1 > 8 ? 8 : 2 * kp + 1][1]); pw.w = pk2(sc[2 * kp + 1 > 8 ? 8 : 2 * kp + 1][2], sc[2 * kp + 1 > 8 ? 8 : 2 * kp + 1][3]); }
            else { pw.z = 0u; pw.w = 0u; }
            const bf16x8 Pf = as_frag(pw);
            const int ra = 16 * w + 32 * kp + 4 * fq + q, rb = kp < 4 ? ra + 16 : ra;
            bf16x8 Vf[8]; tr8(lbase + OV + ra * KP + (4 * p) * 2, lbase + OV + rb * KP + (4 * p) * 2, Vf);
#pragma unroll
            for (int c = 0; c < 8; ++c) oc[c] = mfma16(Vf[c], Pf, oc[c]);
        }
        const float rden = 1.0f / den;
        if (STORE || den == -1.0f) {
#pragma unroll
        for (int c = 0; c < 8; ++c) { u32x2 o; o.x = pk2(oc[c][0] * rden, oc[c][1] * rden); o.y = pk2(oc[c][2] * rden, oc[c][3] * rden);
            *(u32x2*)(Z + qrow * INW + ZC_DQ + hh * 128 + 16 * c + 4 * fq) = o; }
        if (fq == 0) LSE[qrow * 12 + hh] = mx + logf(den);
        }
        if (!has_next) break;
        item = nitem;
        __syncthreads();
    }
    __syncthreads();
}

DI void scan_combine_phase(int l) {
    const int gt = opaque_bid() * NTHREADS + opaque_tid(), NGT = gridDim.x * NTHREADS;
    const u32x2* KV = (const u32x2*)(arg_ws() + WS_KV); u32x2* S = (u32x2*)(arg_ws() + WS_S);
    for (int v = gt; v < GB * 4 * 2 * 8192; v += NGT) {
        const int bh = v >> 14, dir = (v >> 13) & 1, e4 = v & 8191, h = bh & 3;
        const float de = arg_in(I_DEC)[(l * 2 + dir) * 4 + h];
        const float cd = exp2f(log1pf(-exp2f(-de)) * 1.44269504f * 128.0f);
        u32x2 kw[32];
#pragma unroll
        for (int step = 0; step < 32; ++step) { const int n = dir ? 31 - step : step; kw[step] = KV[((size_t)(bh * 32 + n) * 2 + dir) * 8192 + e4]; }
        f32x4 st = (f32x4){0.f, 0.f, 0.f, 0.f};
#pragma unroll
        for (int step = 0; step < 32; ++step) { const int n = dir ? 31 - step : step; const size_t idx = ((size_t)(bh * 32 + n) * 2 + dir) * 8192 + e4;
            u32x2 o; o.x = pk2(st[0], st[1]); o.y = pk2(st[2], st[3]); S[idx] = o;
            const f32x4 kv = (f32x4){bflo(kw[step].x), bfhi(kw[step].x), bflo(kw[step].y), bfhi(kw[step].y)}; st = st * cd + kv; }
    }
    const bf16_t* Z = (const bf16_t*)(arg_ws() + WS_Z); const float* LSE = (const float*)(arg_ws() + WS_LSE); bf16_t* DL = (bf16_t*)(arg_ws() + WS_DL);
    for (int id = gt; id < GT * 64; id += NGT) {
        const int tok = id >> 6, j = (id >> 4) & 3, ch = id & 15;
        const float l0 = LSE[tok * 12 + j], l1 = LSE[tok * 12 + 4 + j], l2 = LSE[tok * 12 + 8 + j];
        const float mx = fmaxf(l0, fmaxf(l1, l2));
        float w0 = __expf(l0 - mx), w1 = __expf(l1 - mx), w2 = __expf(l2 - mx); const float rw = 1.0f / (w0 + w1 + w2); w0 *= rw; w1 *= rw; w2 *= rw;
        const bf16_t* zr = Z + (size_t)tok * INW + ZC_DQ + j * 128 + ch * 8;
        const u32x4 a0 = *(const u32x4*)zr, a1 = *(const u32x4*)(zr + 512), a2 = *(const u32x4*)(zr + 1024);
        u32x4 o;
        o.x = pk2(w0 * bflo(a0.x) + w1 * bflo(a1.x) + w2 * bflo(a2.x), w0 * bfhi(a0.x) + w1 * bfhi(a1.x) + w2 * bfhi(a2.x));
        o.y = pk2(w0 * bflo(a0.y) + w1 * bflo(a1.y) + w2 * bflo(a2.y), w0 * bfhi(a0.y) + w1 * bfhi(a1.y) + w2 * bfhi(a2.y));
        o.z = pk2(w0 * bflo(a0.z) + w1 * bflo(a1.z) + w2 * bflo(a2.z), w0 * bfhi(a0.z) + w1 * bfhi(a1.z) + w2 * bfhi(a2.z));
        o.w = pk2(w0 * bflo(a0.w) + w1 * bflo(a1.w) + w2 * bflo(a2.w), w0 * bfhi(a0.w) + w1 * bfhi(a1.w) + w2 * bfhi(a2.w));
        *(u32x4*)(DL + (size_t)tok * 512 + j * 128 + ch * 8) = o;
    }
}

DI void ret_out_phase(int l, unsigned char* lds_g, LAS unsigned char* lds) {
    const int tid = opaque_tid(), lane = tid & 63, w = tid >> 6, fr = lane & 15, fq = lane >> 4;
    const unsigned lbase = (unsigned)(size_t)lds_g;
    const bf16_t* Z = (const bf16_t*)(arg_ws() + WS_Z); const bf16_t* S = (const bf16_t*)(arg_ws() + WS_S); bf16_t* R = (bf16_t*)(arg_ws() + WS_R);
    const float* rn = arg_in(I_RNORM) + l * 1024;
    constexpr int OQ = 0, OKP = 128 * RK_PITCH, OV = 2 * 128 * RK_PITCH, OT = OV + 128 * RV_PITCH;
    for (int item = opaque_bid(); item < GB * 4 * 32; item += gridDim.x) {
        const int n = item & 31, h = (item >> 5) & 3, bl = item >> 7;
        const size_t row0 = (size_t)bl * SEQ + n * 128;
        const float de_f = arg_in(I_DEC)[(l * 2 + 0) * 4 + h], de_b = arg_in(I_DEC)[(l * 2 + 1) * 4 + h];
        const float l2f = log1pf(-exp2f(-de_f)) * 1.44269504f, l2b = log1pf(-exp2f(-de_b)) * 1.44269504f;
#pragma unroll
        for (int i = 0; i < 8; ++i) { const int id = tid + 512 * i, r = id >> 5, ch = id & 31;
            *(LAS u32x4*)(lds + OV + r * RV_PITCH + ch * 16) = *(const u32x4*)(Z + (row0 + r) * INW + ZC_RV + h * 256 + ch * 8); }
#pragma unroll
        for (int i = 0; i < 4; ++i) { const int id = tid + 512 * i, r = id >> 4, ch = id & 15;
            *(LAS u32x4*)(lds + OQ + r * RK_PITCH + ch * 16) = *(const u32x4*)(Z + (row0 + r) * INW + ZC_RQ + h * 128 + ch * 8);
            *(LAS u32x4*)(lds + OKP + r * RK_PITCH + ch * 16) = *(const u32x4*)(Z + (row0 + r) * INW + ZC_RK + h * 128 + ch * 8); }
        __syncthreads();
        {
            bf16x8 Qf[4];
#pragma unroll
            for (int ks = 0; ks < 4; ++ks) Qf[ks] = *(const LAS bf16x8*)(lds + OQ + (16 * w + fr) * RK_PITCH + (32 * ks + 8 * fq) * 2);
            u32x2 pw[8];
            const int i = 16 * w + fr;
#pragma unroll
            for (int jt = 0; jt < 8; ++jt) { f32x4 s = (f32x4){0.f, 0.f, 0.f, 0.f};
#pragma unroll
                for (int ks = 0; ks < 4; ++ks) { const bf16x8 kf = *(const LAS bf16x8*)(lds + OKP + (16 * jt + fr) * RK_PITCH + (32 * ks + 8 * fq) * 2); s = mfma16(kf, Qf[ks], s); }
                int io = i - 4 * fq; asm volatile("" : "+v"(io));
#pragma unroll
                for (int e = 0; e < 4; ++e) { const int x = io - (16 * jt + e); const float dm = fexp2(x >= 0 ? l2f * (float)x : l2b * (float)(-x)); s[e] *= dm; }
                pw[jt].x = pk2(s[0], s[1]); pw[jt].y = pk2(s[2], s[3]); asm volatile("" ::: "memory"); }
            __syncthreads();
#pragma unroll
            for (int jt = 0; jt < 8; ++jt) *(LAS u32x2*)(lds + OKP + i * RK_PITCH + (16 * jt + 4 * fq) * 2) = pw[jt];
        }
        __syncthreads();
        f32x4 O[2][8];
        {
            const int q = fr >> 2, p = fr & 3;
#pragma unroll 1
            for (int dir = 0; dir < 2; ++dir) {
                const bf16_t* Sd = S + (((size_t)item * 2 + dir) * 256 + 32 * w) * 128;
#pragma unroll
                for (int m = 0; m < 2; ++m) {
                    f32x4 T[8];
#pragma unroll
                    for (int nt = 0; nt < 8; ++nt) T[nt] = (f32x4){0.f, 0.f, 0.f, 0.f};
#pragma unroll 1
                    for (int ks = 0; ks < 4; ++ks) {
                        const bf16x8 Af = as_frag(*(const u32x4*)(Sd + (16 * m + fr) * 128 + 32 * ks + 8 * fq));
#pragma unroll
                        for (int nt = 0; nt < 8; ++nt) { const bf16x8 qf = *(const LAS bf16x8*)(lds + OQ + (16 * nt + fr) * RK_PITCH + (32 * ks + 8 * fq) * 2); T[nt] = mfma16(Af, qf, T[nt]); }
                    }
                    int fro = fr; asm volatile("" : "+v"(fro));
#pragma unroll
                    for (int nt = 0; nt < 8; ++nt) { const int i = 16 * nt + fro; const float sc = dir ? fexp2(l2b * (float)(128 - i)) : fexp2(l2f * (float)(i + 1));
                        if (dir) O[m][nt] += T[nt] * sc; else O[m][nt] = T[nt] * sc; }
                    asm volatile("" ::: "memory");
                }
            }
#pragma unroll 1
            for (int ks = 0; ks < 4; ++ks) {
                bf16x8 Vf[2];
                const int tr0 = 32 * ks + 8 * fq + q;
#pragma unroll
                for (int m = 0; m < 2; ++m) { const unsigned ad = lbase + OV + tr0 * RV_PITCH + (32 * w + 16 * m + 4 * p) * 2; Vf[m] = tr_frag(ad, ad + 4 * RV_PITCH); }
#pragma unroll
                for (int nt = 0; nt < 8; ++nt) { const bf16x8 pf = *(const LAS bf16x8*)(lds + OKP + (16 * nt + fr) * RK_PITCH + (32 * ks + 8 * fq) * 2);
#pragma unroll
                    for (int m = 0; m < 2; ++m) O[m][nt] = mfma16(Vf[m], pf, O[m][nt]); }
            }
        }
#pragma unroll
        for (int nt = 0; nt < 8; ++nt) { float ss = 0.f;
#pragma unroll
            for (int m = 0; m < 2; ++m)
#pragma unroll
                for (int e = 0; e < 4; ++e) ss += O[m][nt][e] * O[m][nt][e];
            ss += __shfl_xor(ss, 16); ss += __shfl_xor(ss, 32);
            if (fq == 0) *(LAS float*)(lds + OT + (w * 128 + 16 * nt + fr) * 4) = ss; }
        __syncthreads();
#pragma unroll
        for (int nt = 0; nt < 8; ++nt) { const int i = 16 * nt + fr; float tot = 0.f;
#pragma unroll
            for (int ww = 0; ww < 8; ++ww) tot += *(const LAS float*)(lds + OT + (ww * 128 + i) * 4);
            const float rinv = __builtin_amdgcn_rsqf(tot * (1.0f / 256.0f) + EPS);
#pragma unroll
            for (int m = 0; m < 2; ++m) { const int dv = h * 256 + 32 * w + 16 * m + 4 * fq;
                const u32x2 gz = *(const u32x2*)(Z + (row0 + i) * INW + ZC_RG + dv); const f32x4 gn = *(const f32x4*)(rn + dv);
                const float o0 = O[m][nt][0] * rinv * gn[0] * fsilu(bflo(gz.x)), o1 = O[m][nt][1] * rinv * gn[1] * fsilu(bfhi(gz.x));
                const float o2 = O[m][nt][2] * rinv * gn[2] * fsilu(bflo(gz.y)), o3 = O[m][nt][3] * rinv * gn[3] * fsilu(bfhi(gz.y));
                u32x2 o; o.x = pk2(o0, o1); o.y = pk2(o2, o3);
                *(u32x2*)(R + (row0 + i) * 1024 + dv) = o; }
            asm volatile("" ::: "memory"); }
        __syncthreads();
    }
}

#ifndef PHMASK
#define PHMASK 0xffff
#endif
#define PH(k) ((PHMASK >> (k)) & 1)

#define XB_TMO      128
#define XB_XCNT(j)  (256  + 64 * (j))
#define XB_XSUB(j)  (1280 + 64 * (j))
#define XB_XGEN(j)  (2304 + 64 * (j))
#define XB_TOP      3328
#define XB_TOPGEN   3392
#define XCD_BAR_WORDS 3456
#define XB_SPIN_CAP (1u << 22)
DI unsigned xb_ld(unsigned* p)              { return __hip_atomic_load(p, __ATOMIC_RELAXED, __HIP_MEMORY_SCOPE_AGENT); }
DI unsigned xb_add(unsigned* p, unsigned v) { return __hip_atomic_fetch_add(p, v, __ATOMIC_RELAXED, __HIP_MEMORY_SCOPE_AGENT); }
DI unsigned xb_xcc_id() { return (unsigned)__builtin_amdgcn_s_getreg((3 << 11) | 20) & 0xFu; }
#define XB_SPIN(cond, bar) do { unsigned _sp = 0; while (cond) { __builtin_amdgcn_s_sleep(1); \
    if ((++_sp & 255u) == 0u) { if (xb_ld(&(bar)[XB_TMO])) break; if (_sp > XB_SPIN_CAP) { atomicAdd(&(bar)[XB_TMO], 1u); break; } } } } while (0)
DI void xcd_barrier_complete(unsigned* bar, unsigned x, unsigned& nloc, unsigned& nx) {
    const unsigned G = gridDim.x * gridDim.y * gridDim.z;
    unsigned sum, cnt, mine, sp = 0u;
    for (;;) {
        sum = 0u; cnt = 0u; mine = 0u;
#pragma unroll
        for (unsigned j = 0; j < 16; ++j) { const unsigned c = xb_ld(&bar[XB_XCNT(j)]); sum += c; cnt += (c > 0u) ? 1u : 0u; mine = (j == x) ? c : mine; }
        if (sum == G) break;
        __builtin_amdgcn_s_sleep(1);
        if ((++sp & 255u) == 0u) { if (xb_ld(&bar[XB_TMO])) break; if (sp > XB_SPIN_CAP) { atomicAdd(&bar[XB_TMO], 1u); break; } }
    }
    nloc = mine > 0u ? mine : 1u; nx = cnt > 0u ? cnt : 1u;
}
DI void xcd_barrier(unsigned* bar, volatile LAS unsigned* st) {
    asm volatile("s_waitcnt vmcnt(0)" ::: "memory");
    __syncthreads();
    if (threadIdx.x == 0) {
        __builtin_amdgcn_s_waitcnt(0);
        const unsigned x = xb_xcc_id();
        unsigned nloc = st[0], nx = st[1];
        if (nloc == 0u) { xcd_barrier_complete(bar, x, nloc, nx); st[0] = nloc; st[1] = nx; }
        const unsigned old = xb_add(&bar[XB_XSUB(x)], 1u);
        const unsigned gen = old / nloc;
        if (old + 1u == (gen + 1u) * nloc) {
            __builtin_amdgcn_fence(__ATOMIC_RELEASE, "agent");
            asm volatile("s_waitcnt vmcnt(0)" ::: "memory");
            const unsigned og = xb_add(&bar[XB_TOP], 1u);
            const unsigned tg = og / nx;
            if (og + 1u == (tg + 1u) * nx) xb_add(&bar[XB_TOPGEN], 1u);
            else XB_SPIN(xb_ld(&bar[XB_TOPGEN]) == tg, bar);
            __builtin_amdgcn_fence(__ATOMIC_ACQUIRE, "agent");
            xb_add(&bar[XB_XGEN(x)], 1u);
            asm volatile("s_waitcnt vmcnt(0)" ::: "memory");
        } else {
            XB_SPIN(xb_ld(&bar[XB_XGEN(x)]) == gen, bar);
            __builtin_amdgcn_fence(__ATOMIC_ACQUIRE, "agent");
            asm volatile("s_waitcnt vmcnt(0)" ::: "memory");
        }
    }
    __syncthreads();
}

DI void ph_win(LAS unsigned char* lds, int l, int g) {
    unsigned char* ws = arg_ws(); const size_t rb = (size_t)g * GT;
    pg8::Gemm gm{(const bf16_t*)(ws + WS_XB) + rb * D, (const bf16_t*)(ws + WS_W + (size_t)l * LW + OW_IN), GT, INW, D}; pg8::StaticOrder S; S.init(GT, INW, gridDim.x, opaque_bid());
    pg8::EpiZ E{(bf16_t*)(ws + WS_Z), (const float*)(ws + WS_SLOT) + rb * 16, (const float*)(ws + WS_ROPE), (const float*)(ws + WS_ROPE) + SEQ * 64}; pg8::gemm_phase(lds, gm, S, E);
}
DI void ph_post1(LAS unsigned char* lds, int l) {
    unsigned char* ws = arg_ws();
    pg8::Gemm gm{(const bf16_t*)(ws + WS_R), (const bf16_t*)(ws + WS_W + (size_t)l * LW + OW_RO), GT, D, D}; pg8::StaticOrder S; S.init(GT, D, gridDim.x, opaque_bid());
    pg8::EpiGate<false> E{(const bf16_t*)(ws + WS_Z) + ZC_GR, arg_in(I_BG) + l * 2048, (float*)(ws + WS_Y1), (bf16_t*)(ws + WS_MB)}; pg8::gemm_phase(lds, gm, S, E);
}
DI void ph_post2(LAS unsigned char* lds, int l) {
    unsigned char* ws = arg_ws();
    pg8::Gemm gm{(const bf16_t*)(ws + WS_DL), (const bf16_t*)(ws + WS_W + (size_t)l * LW + OW_DO), GT, D, 512}; pg8::StaticOrder S; S.init(GT, D, gridDim.x, opaque_bid());
    pg8::EpiGate<true> E{(const bf16_t*)(ws + WS_Z) + ZC_GD, arg_in(I_BG) + l * 2048 + 1024, (float*)(ws + WS_Y1), (bf16_t*)(ws + WS_MB)}; pg8::gemm_phase(lds, gm, S, E);
}
DI void ph_out(LAS unsigned char* lds, int l, int g) {
    unsigned char* ws = arg_ws(); const size_t rb = (size_t)g * GT;
    pg8::Gemm gm{(const bf16_t*)(ws + WS_MB), (const bf16_t*)(ws + WS_W + (size_t)l * LW + OW_OUT), GT, D, D}; pg8::StaticOrder S; S.init(GT, D, gridDim.x, opaque_bid());
    pg8::EpiRes E{arg_out() + rb * D, (bf16_t*)(ws + WS_XB) + rb * D, (float*)(ws + WS_SLOT) + rb * 16, 1.0f}; pg8::gemm_phase(lds, gm, S, E);
}
DI void ph_gu(LAS unsigned char* lds, int l, int half) {
    unsigned char* ws = arg_ws();
    pg8::Gemm gm{(const bf16_t*)(ws + WS_XB), (const bf16_t*)(ws + WS_W + (size_t)l * LW + (half ? OW_GU2 : OW_GU1)), NTOK, 5632, D}; pg8::StaticOrder S; S.init(NTOK, 5632, gridDim.x, opaque_bid());
    pg8::EpiSwiGLU E{(bf16_t*)(ws + WS_H), (const float*)(ws + WS_SLOT)}; pg8::gemm_phase(lds, gm, S, E);
}
DI void ph_down(LAS unsigned char* lds, int l, int half) {
    unsigned char* ws = arg_ws();
    pg8::Gemm gm{(const bf16_t*)(ws + WS_H), (const bf16_t*)(ws + WS_W + (size_t)l * LW + (half ? OW_D2 : OW_D1)), NTOK, D, FF}; pg8::StaticOrder S; S.init(NTOK, D, gridDim.x, opaque_bid());
    pg8::EpiRes E{arg_out(), (bf16_t*)(ws + WS_XB), (float*)(ws + WS_SLOT), 0.5f}; pg8::gemm_phase(lds, gm, S, E);
}

__global__ void __launch_bounds__(NTHREADS, 2) mega_fwd(Args a) {
    extern __shared__ __attribute__((aligned(16))) unsigned char lds_g[];
    LAS unsigned char* lds = (LAS unsigned char*)lds_g;
    cg::grid_group grid = cg::this_grid();
    volatile LAS unsigned* bst = (volatile LAS unsigned*)(lds + LDS_BYTES - 16);
    if (threadIdx.x < 4) bst[threadIdx.x] = 0u;
    __syncthreads();
    if (threadIdx.x == 0) (void)xb_add((unsigned*)arg_ws() + XB_XCNT(xb_xcc_id()), 1u);
#define GSYNC() xcd_barrier((unsigned*)arg_ws(), bst)
    if (PH(0)) prep_phase(lds);
    grid.sync();
#pragma unroll 1
    for (int l = 0; l < DEPTH; ++l) {
#pragma unroll 1
        for (int half = 0; half < 2; ++half) {
            if (half == 1) {
#pragma unroll 1
                for (int g = 0; g < NGRP; ++g) {
                    if (PH(1)) ph_win(lds, l, g);
                    GSYNC();
                    if (PH(2)) ret_kv_phase(l, lds_g, lds);
                    if (PH(3)) dil_attn_phase(l, lds_g, lds);
                    GSYNC();
                    if (PH(4)) scan_combine_phase(l);
                    GSYNC();
                    if (PH(5)) ret_out_phase(l, lds_g, lds);
                    GSYNC();
                    if (PH(6)) ph_post1(lds, l);
                    if (PH(7)) ph_post2(lds, l);
                    GSYNC();
                    if (PH(8)) ph_out(lds, l, g);
                }
                GSYNC();
            }
            if (PH(9)) ph_gu(lds, l, half);
            GSYNC();
            if (PH(10)) ph_down(lds, l, half);
            if (l != DEPTH - 1 || half != 1) GSYNC();
        }
    }
}

extern "C" void kernel_launch(void* const* d_in, const int* in_sizes, int n_in, void* d_out, int out_size, void* d_ws, size_t ws_size, hipStream_t stream) {
    static int grid = 0;
    if (grid == 0) {
        if (n_in != 20 || out_size != NTOK * D || ws_size < WS_H + (size_t)NTOK * FF * 2 || ws_size < WS_END) { fprintf(stderr, "kernel_launch: unexpected shapes / workspace (n_in %d out %d ws %zu)\n", n_in, out_size, ws_size); grid = -1; return; }
        int dev = 0, cus = 0, per_cu = 0;
        if (hipGetDevice(&dev) != hipSuccess || hipDeviceGetAttribute(&cus, hipDeviceAttributeMultiprocessorCount, dev) != hipSuccess) { grid = -1; return; }
        if (hipFuncSetAttribute((const void*)mega_fwd, hipFuncAttributeMaxDynamicSharedMemorySize, LDS_BYTES) != hipSuccess) { fprintf(stderr, "kernel_launch: hipFuncSetAttribute failed\n"); grid = -1; return; }
        if (hipOccupancyMaxActiveBlocksPerMultiprocessor(&per_cu, (const void*)mega_fwd, NTHREADS, LDS_BYTES) != hipSuccess || per_cu < 1) { fprintf(stderr, "kernel_launch: occupancy query failed (%d)\n", per_cu); (void)hipGetLastError(); per_cu = 1; }
        grid = cus * per_cu;
    }
    if (grid < 0) return;
    if (hipMemsetAsync(d_ws, 0, 16384, stream) != hipSuccess) { fprintf(stderr, "kernel_launch: memset failed\n"); return; }
    Args a{};
    for (int i = 0; i < 20; ++i) a.in[i] = (const float*)d_in[i];
    a.out = (float*)d_out; a.ws = (unsigned char*)d_ws;
    void* args[] = {&a};
    hipError_t e = hipLaunchCooperativeKernel((const void*)mega_fwd, dim3(grid), dim3(NTHREADS), args, LDS_BYTES, stream);
    if (e != hipSuccess) fprintf(stderr, "kernel_launch: cooperative launch failed: %s (grid %d)\n", hipGetErrorString(e), grid);
}
```

```cpp
#include <hip/hip_runtime.h>
#include <hip/hip_cooperative_groups.h>
#include <cstdio>
#include <cstdint>
namespace cg = cooperative_groups;

#define DI __device__ __forceinline__
#define LAS __attribute__((address_space(3)))
typedef unsigned short bf16_t;
typedef short bf16x8 __attribute__((ext_vector_type(8)));
typedef short s16x4 __attribute__((ext_vector_type(4)));
typedef float f32x4 __attribute__((ext_vector_type(4)));
typedef unsigned u32x4 __attribute__((ext_vector_type(4)));
typedef unsigned u32x2 __attribute__((ext_vector_type(2)));

constexpr int D = 1024, FF = 2816, SEQ = 4096, NBATCH = 16, NTOK = NBATCH * SEQ, DEPTH = 4, INW = 9728;
constexpr int GB = 4, GT = GB * SEQ, NGRP = NBATCH / GB;
constexpr int ZC_RQ = 0, ZC_RK = 512, ZC_RV = 1024, ZC_RG = 2048, ZC_DQ = 3072, ZC_DK = 4608, ZC_DV = 6144, ZC_GR = 7680, ZC_GD = 8704;
constexpr float EPS = 1e-6f;
constexpr int NTHREADS = 512;
constexpr int LDS_BYTES = 147456;

constexpr size_t MiB = 1u << 20;
constexpr size_t WS_ROPE = 1 * MiB;
constexpr size_t WS_BIAS = 3 * MiB;
constexpr size_t WS_SLOT = 4 * MiB;
constexpr size_t WS_W = 8 * MiB;
constexpr size_t OW_GU1 = 0, OW_D1 = OW_GU1 + (size_t)5632 * 1024 * 2, OW_IN = OW_D1 + (size_t)1024 * 2816 * 2, OW_RO = OW_IN + (size_t)INW * 1024 * 2,
                 OW_DO = OW_RO + (size_t)1024 * 1024 * 2, OW_OUT = OW_DO + (size_t)1024 * 512 * 2, OW_GU2 = OW_OUT + (size_t)1024 * 1024 * 2,
                 OW_D2 = OW_GU2 + (size_t)5632 * 1024 * 2, LW = OW_D2 + (size_t)1024 * 2816 * 2;
static_assert(LW == 57 * MiB, "layer weight bytes");
constexpr size_t WS_XB = WS_W + DEPTH * LW;
constexpr size_t WS_BIG = WS_XB + (size_t)NTOK * D * 2;
constexpr size_t WS_H = WS_BIG;
constexpr size_t WS_Z = WS_BIG;
constexpr size_t WS_KV = WS_Z + (size_t)GT * INW * 2;
constexpr size_t WS_Y1 = WS_KV;
constexpr size_t WS_MB = WS_KV + (size_t)GT * D * 4;
constexpr size_t WS_S = WS_KV + (size_t)512 * 2 * 32768 * 4;
constexpr size_t WS_R = WS_S + (size_t)512 * 2 * 32768 * 2;
constexpr size_t WS_DL = WS_R + (size_t)GT * 1024 * 2;
constexpr size_t WS_LSE = WS_DL + (size_t)GT * 512 * 2;
constexpr size_t WS_END = WS_LSE + (size_t)GT * 12 * 4;
static_assert(WS_H + (size_t)NTOK * FF * 2 <= ((size_t)1 << 30) && WS_END <= ((size_t)1 << 30), "workspace fits 1 GiB");

DI int opaque_tid() { int t = threadIdx.x; asm volatile("" : "+v"(t)); return t; }
DI int opaque_bid() { int t = blockIdx.x; asm volatile("" : "+s"(t)); return t; }
DI unsigned pk2(float lo, float hi) { unsigned r; asm("v_cvt_pk_bf16_f32 %0, %1, %2" : "=v"(r) : "v"(lo), "v"(hi)); return r; }
DI float bflo(unsigned u) { return __uint_as_float(u << 16); }
DI float bfhi(unsigned u) { return __uint_as_float(u & 0xffff0000u); }
DI float fexp2(float x) { return __builtin_amdgcn_exp2f(x); }
DI float frcp(float x) { return __builtin_amdgcn_rcpf(x); }
DI float fsigmoid(float x) { return frcp(1.0f + fexp2(-1.44269504f * x)); }
DI float fsilu(float x) { return x * fsigmoid(x); }
DI bf16x8 as_frag(u32x4 v) { return __builtin_bit_cast(bf16x8, v); }
DI f32x4 mfma16(bf16x8 a, bf16x8 b, f32x4 c) { return __builtin_amdgcn_mfma_f32_16x16x32_bf16(a, b, c, 0, 0, 0); }
DI bf16x8 tr_frag(unsigned a0, unsigned a1) {
    s16x4 lo, hi;
    asm volatile("ds_read_b64_tr_b16 %0, %2\n\tds_read_b64_tr_b16 %1, %3\n\ts_waitcnt lgkmcnt(0)" : "=&v"(lo), "=&v"(hi) : "v"(a0), "v"(a1) : "memory");
    bf16x8 r; r[0] = lo[0]; r[1] = lo[1]; r[2] = lo[2]; r[3] = lo[3]; r[4] = hi[0]; r[5] = hi[1]; r[6] = hi[2]; r[7] = hi[3]; return r;
}
DI void tr4(unsigned a0, unsigned a1, bf16x8& o0, bf16x8& o1, bf16x8& o2, bf16x8& o3) {
    s16x4 l0, l1, l2, l3, h0, h1, h2, h3;
    asm volatile(
        "ds_read_b64_tr_b16 %0, %8\n\tds_read_b64_tr_b16 %4, %9\n\t"
        "ds_read_b64_tr_b16 %1, %8 offset:32\n\tds_read_b64_tr_b16 %5, %9 offset:32\n\t"
        "ds_read_b64_tr_b16 %2, %8 offset:64\n\tds_read_b64_tr_b16 %6, %9 offset:64\n\t"
        "ds_read_b64_tr_b16 %3, %8 offset:96\n\tds_read_b64_tr_b16 %7, %9 offset:96\n\t"
        "s_waitcnt lgkmcnt(0)"
        : "=&v"(l0), "=&v"(l1), "=&v"(l2), "=&v"(l3), "=&v"(h0), "=&v"(h1), "=&v"(h2), "=&v"(h3)
        : "v"(a0), "v"(a1) : "memory");
#define TR_PACK(o, lo, hi) o[0] = lo[0]; o[1] = lo[1]; o[2] = lo[2]; o[3] = lo[3]; o[4] = hi[0]; o[5] = hi[1]; o[6] = hi[2]; o[7] = hi[3];
    TR_PACK(o0, l0, h0) TR_PACK(o1, l1, h1) TR_PACK(o2, l2, h2) TR_PACK(o3, l3, h3)
#undef TR_PACK
}
DI void tr8(unsigned a0, unsigned a1, bf16x8 (&out)[8]) {
    tr4(a0, a1, out[0], out[1], out[2], out[3]);
    tr4(a0 + 128u, a1 + 128u, out[4], out[5], out[6], out[7]);
}
DI float row_scale(const float* slots, int row, int fq) {
    const f32x4 s = *(const f32x4*)(slots + (size_t)row * 16 + 4 * fq);
    float t = (s[0] + s[1]) + (s[2] + s[3]);
    t += __shfl_xor(t, 16); t += __shfl_xor(t, 32);
    return __builtin_amdgcn_rsqf(t * (1.0f / D) + EPS);
}

namespace pg8 {
constexpr int BM = 256, BK = 64, HALF = 128, HTB = HALF * BK * 2, STAGE_BYTES = 8 * HTB, NXCD = 8, WGM = 8;
__host__ __device__ __forceinline__ int lds_byte(int r, int c) { const int st = (r >> 4) * 2 + (c >> 5), rr = r & 15, cc = c & 31, ob = rr * 64 + cc * 2; return st * 1024 + (ob ^ (((ob >> 9) & 1) << 5)); }
__host__ __device__ __forceinline__ void stage_rc(int b, int& R, int& C) { const int st = b / 1024, sb = b % 1024, swz = sb ^ (((sb >> 9) & 1) << 5); R = (st >> 1) * 16 + swz / 64; C = (st & 1) * 32 + (swz % 64) / 2; }
__host__ __device__ __forceinline__ int perm32(int rho) { const int n = rho >> 4, i = rho & 15; return 8 * (i >> 2) + 4 * n + (i & 3); }
struct Unit { int pm, pn; };
struct Gemm { const bf16_t* A; const bf16_t* Bt; int M, N, K; };
struct StaticOrder {
    int nM, nN, nwg, G, c;
    DI void init(int M, int N, int G_, int c_) { nM = M / BM; nN = N / BM; nwg = nM * nN; G = G_; c = c_; }
    DI bool next(int i, Unit& u) const {
        const long L = (long)i * G + c; if (L >= nwg) return false;
        int wgid = (int)L; { const int q = nwg / NXCD, r = nwg % NXCD, xcd = wgid % NXCD, off = wgid / NXCD; wgid = (xcd < r ? xcd * (q + 1) : r * (q + 1) + (xcd - r) * q) + off; }
        const int nig = WGM * nN, gid = wgid / nig, fm = gid * WGM, gsz = (nM - fm) < WGM ? (nM - fm) : WGM;
        u.pm = fm + ((wgid % nig) % gsz); u.pn = (wgid % nig) / gsz; return true;
    }
};
template <class Epi>
DI void gemm_phase(LAS unsigned char* lds, const Gemm g, const StaticOrder& S, const Epi& E) {
    const int tid = opaque_tid(), wid = __builtin_amdgcn_readfirstlane(tid >> 6), lane = tid & 63, wr = wid >> 2, wc = wid & 3, fr = lane & 15, fq = lane >> 4;
    const int K = g.K, nt = K / BK;
    unsigned voffA[2], voffB[2];
#pragma unroll
    for (int i = 0; i < 2; ++i) { int R, C; stage_rc(tid * 16 + i * 8192, R, C); const int Rb = Epi::PERM ? ((R & ~31) + perm32(R & 31)) : R;
        voffA[i] = (unsigned)(R * K + C) * 2u; voffB[i] = (unsigned)(Rb * K + C) * 2u; }
    const size_t kstep = (size_t)(BK * 2);
    const size_t hstep = (size_t)HALF * K * 2;
    const size_t tstep = 2 * hstep;
    const unsigned ldsw = (unsigned)wid * 1024u;
    const int aoff = lds_byte(wr * 64 + fr, fq * 8), boff = lds_byte(wc * 32 + fr, fq * 8);
#define PG8_SA(b, h) (((b) * 2 + (h)) * HTB)
#define PG8_SB(b, h) ((4 + (b) * 2 + (h)) * HTB)
#define PG8_STAGE(bufoff, gbase, voff) do { _Pragma("unroll") for (int _i = 0; _i < 2; ++_i) \
        __builtin_amdgcn_global_load_lds((const unsigned*)((const char*)(gbase) + (voff)[_i]), (LAS unsigned*)(lds + (bufoff) + ldsw + _i * 8192), 16, 0, 0); } while (0)
#define PG8_LDA(dst, b, h) do { _Pragma("unroll") for (int m = 0; m < 4; ++m) _Pragma("unroll") for (int k = 0; k < 2; ++k) dst[m][k] = *(const LAS bf16x8*)(lds + PG8_SA(b, h) + aoff + m * 2048 + k * 1024); } while (0)
#define PG8_LDB(dst, b, h) do { _Pragma("unroll") for (int n = 0; n < 2; ++n) _Pragma("unroll") for (int k = 0; k < 2; ++k) dst[n][k] = *(const LAS bf16x8*)(lds + PG8_SB(b, h) + boff + n * 2048 + k * 1024); } while (0)
#define PG8_MMA(ai, bj, At, Bt) do { __builtin_amdgcn_s_setprio(1); _Pragma("unroll") for (int m = 0; m < 4; ++m) _Pragma("unroll") for (int n = 0; n < 2; ++n) _Pragma("unroll") for (int k = 0; k < 2; ++k) \
        acc[ai][bj][m][n] = __builtin_amdgcn_mfma_f32_16x16x32_bf16(Bt[n][k], At[m][k], acc[ai][bj][m][n], 0, 0, 0); __builtin_amdgcn_s_setprio(0); } while (0)
#define PG8_WAIT_V(n) asm volatile("s_waitcnt vmcnt(" #n ")" ::: "memory")
#define PG8_WAIT_L(n) asm volatile("s_waitcnt lgkmcnt(" #n ")" ::: "memory")
#define PG8_BAR __builtin_amdgcn_s_barrier()
#define PG8_SCHED __builtin_amdgcn_sched_barrier(0)
    Unit cur, nxt; int ui = 0;
    if (!S.next(0, cur)) return;
    f32x4 acc[2][2][4][2];
#pragma unroll
    for (int a = 0; a < 2; ++a)
#pragma unroll
        for (int b = 0; b < 2; ++b)
#pragma unroll
            for (int m = 0; m < 4; ++m)
#pragma unroll
                for (int n = 0; n < 2; ++n) acc[a][b][m][n] = (f32x4){0.f, 0.f, 0.f, 0.f};
    bf16x8 At[4][2], B0[2][2], B1[2][2];
    const char* cA = (const char*)g.A + (size_t)cur.pm * tstep; const char* cB = (const char*)g.Bt + (size_t)cur.pn * tstep;
    PG8_STAGE(PG8_SB(0, 0), cB, voffB); PG8_STAGE(PG8_SB(0, 1), cB + hstep, voffB); PG8_STAGE(PG8_SA(0, 0), cA, voffA); PG8_STAGE(PG8_SA(0, 1), cA + hstep, voffA);
    if (wr == 1) PG8_BAR;
    PG8_WAIT_V(2); PG8_BAR;
    PG8_STAGE(PG8_SB(1, 0), cB + kstep, voffB); PG8_STAGE(PG8_SA(1, 0), cA + kstep, voffA); PG8_STAGE(PG8_SB(1, 1), cB + hstep + kstep, voffB);
    PG8_WAIT_V(6); PG8_BAR;
    for (;;) {
        const bool has_next = S.next(ui + 1, nxt);
        const char* nA = has_next ? (const char*)g.A + (size_t)nxt.pm * tstep : cA; const char* nB = has_next ? (const char*)g.Bt + (size_t)nxt.pn * tstep : cB;
        for (int t = 0; t < nt; t += 2) {
            const bool last = (t == nt - 2);
            const char* a1 = cA + (size_t)(t + 1) * kstep;
            const char* a2 = last ? nA : cA + (size_t)(t + 2) * kstep; const char* b2 = last ? nB : cB + (size_t)(t + 2) * kstep;
            const char* a3 = a2 + kstep; const char* b3 = b2 + kstep;
            PG8_LDB(B0, 0, 0); PG8_LDB(B1, 0, 1); PG8_SCHED; PG8_LDA(At, 0, 0); PG8_STAGE(PG8_SA(1, 1), a1 + hstep, voffA);
            PG8_WAIT_V(8); PG8_WAIT_L(0); PG8_BAR; PG8_MMA(0, 0, At, B0); PG8_MMA(0, 1, At, B1); PG8_BAR; PG8_SCHED;
            PG8_LDA(At, 0, 1); PG8_STAGE(PG8_SB(0, 0), b2, voffB); PG8_STAGE(PG8_SB(0, 1), b2 + hstep, voffB); PG8_STAGE(PG8_SA(0, 0), a2, voffA);
            PG8_WAIT_V(8); PG8_WAIT_L(0); PG8_BAR; PG8_MMA(1, 0, At, B0); PG8_MMA(1, 1, At, B1); PG8_BAR; PG8_SCHED;
            PG8_LDB(B0, 1, 0); PG8_LDB(B1, 1, 1); PG8_SCHED; PG8_LDA(At, 1, 0); PG8_STAGE(PG8_SA(0, 1), a2 + hstep, voffA);
            PG8_WAIT_V(8); PG8_WAIT_L(0); PG8_BAR; PG8_MMA(0, 0, At, B0); PG8_MMA(0, 1, At, B1); PG8_BAR; PG8_SCHED;
            PG8_LDA(At, 1, 1); PG8_STAGE(PG8_SB(1, 0), b3, voffB); PG8_STAGE(PG8_SB(1, 1), b3 + hstep, voffB); PG8_STAGE(PG8_SA(1, 0), a3, voffA);
            PG8_WAIT_V(8); PG8_WAIT_L(0); PG8_BAR; PG8_MMA(1, 0, At, B0); PG8_MMA(1, 1, At, B1); PG8_BAR; PG8_SCHED;
        }
        if (wr == 0) PG8_BAR;
        E(acc, cur, wr, wc, fr, fq);
        if (!has_next) break;
#pragma unroll
        for (int a = 0; a < 2; ++a)
#pragma unroll
            for (int b = 0; b < 2; ++b)
#pragma unroll
                for (int m = 0; m < 4; ++m)
#pragma unroll
                    for (int n = 0; n < 2; ++n) acc[a][b][m][n] = (f32x4){0.f, 0.f, 0.f, 0.f};
        cur = nxt; cA = nA; cB = nB; ++ui;
        if (wr == 1) PG8_BAR;
    }
    PG8_WAIT_V(0);
    PG8_BAR;
#undef PG8_SA
#undef PG8_SB
#undef PG8_STAGE
#undef PG8_LDA
#undef PG8_LDB
#undef PG8_MMA
#undef PG8_WAIT_V
#undef PG8_WAIT_L
#undef PG8_BAR
#undef PG8_SCHED
}

struct EpiSwiGLU {
    static constexpr bool PERM = true;
    bf16_t* H; const float* slots;
    DI void operator()(const f32x4 (&acc)[2][2][4][2], const Unit& u, int wr, int wc, int fr, int fq) const {
        const int col0 = u.pn * 128 + wc * 32 + 8 * fq;
        const int rowb = u.pm * BM + wr * 64 + fr;
        f32x4 sl[2][4];
#pragma unroll
        for (int ai = 0; ai < 2; ++ai)
#pragma unroll
            for (int m = 0; m < 4; ++m) sl[ai][m] = *(const f32x4*)(slots + (size_t)(rowb + ai * HALF + m * 16) * 16 + 4 * fq);
        asm volatile("" ::: "memory");
#pragma unroll
        for (int ai = 0; ai < 2; ++ai)
#pragma unroll
            for (int m = 0; m < 4; ++m) {
                const int row = rowb + ai * HALF + m * 16;
                float t = (sl[ai][m][0] + sl[ai][m][1]) + (sl[ai][m][2] + sl[ai][m][3]);
                t += __shfl_xor(t, 16); t += __shfl_xor(t, 32);
                const float rs = __builtin_amdgcn_rsqf(t * (1.0f / D) + EPS);
                float h[8];
#pragma unroll
                for (int n = 0; n < 2; ++n)
#pragma unroll
                    for (int j = 0; j < 4; ++j) { const float gv = acc[ai][0][m][n][j] * rs, uv = acc[ai][1][m][n][j] * rs; h[n * 4 + j] = fsilu(gv) * uv; }
                u32x4 w; w.x = pk2(h[0], h[1]); w.y = pk2(h[2], h[3]); w.z = pk2(h[4], h[5]); w.w = pk2(h[6], h[7]);
                *(u32x4*)(H + (size_t)row * FF + col0) = w;
            }
    }
};
struct EpiRes {
    static constexpr bool PERM = false;
    float* x; bf16_t* xb; float* slots; float s;
    DI void operator()(const f32x4 (&acc)[2][2][4][2], const Unit& u, int wr, int wc, int fr, int fq) const {
        const int col0 = u.pn * BM + wc * 32 + 4 * fq;
#pragma unroll
        for (int ai = 0; ai < 2; ++ai) {
            const int rowa = u.pm * BM + ai * HALF + wr * 64 + fr;
            f32x4 xo[4][2][2];
#pragma unroll
            for (int m = 0; m < 4; ++m)
#pragma unroll
                for (int bj = 0; bj < 2; ++bj)
#pragma unroll
                    for (int n = 0; n < 2; ++n) xo[m][bj][n] = *(const f32x4*)(x + (size_t)(rowa + m * 16) * D + col0 + bj * HALF + n * 16);
            asm volatile("" ::: "memory");
#pragma unroll
            for (int m = 0; m < 4; ++m) {
                const int row = rowa + m * 16;
                float* xr = x + (size_t)row * D + col0; bf16_t* br = xb + (size_t)row * D + col0;
                float ss = 0.f;
#pragma unroll
                for (int bj = 0; bj < 2; ++bj)
#pragma unroll
                    for (int n = 0; n < 2; ++n) {
                        const f32x4 xn = xo[m][bj][n] + acc[ai][bj][m][n] * s;
                        *(f32x4*)(xr + bj * HALF + n * 16) = xn;
                        u32x2 w; w.x = pk2(xn[0], xn[1]); w.y = pk2(xn[2], xn[3]);
                        *(u32x2*)(br + bj * HALF + n * 16) = w;
                        ss += (xn[0] * xn[0] + xn[1] * xn[1]) + (xn[2] * xn[2] + xn[3] * xn[3]);
                    }
                ss += __shfl_xor(ss, 16); ss += __shfl_xor(ss, 32);
                if (fq == 0) slots[(size_t)row * 16 + u.pn * 4 + wc] = ss;
            }
            asm volatile("" ::: "memory");
        }
    }
};
struct EpiZ {
    static constexpr bool PERM = true;
    bf16_t* Z; const float* slots; const float* cs; const float* sn;
    DI void operator()(const f32x4 (&acc)[2][2][4][2], const Unit& u, int wr, int wc, int fr, int fq) const {
        const int col0 = u.pn * BM + wc * 32 + 8 * fq;
        const bool rope = u.pn < 4; const float ksc = (u.pn >= 2) ? 0.08838834764831845f : 1.0f;
        const int fi = 4 * (4 * wc + fq);
        const int rowb = u.pm * BM + wr * 64 + fr;
        f32x4 sl[2][4];
#pragma unroll
        for (int ai = 0; ai < 2; ++ai)
#pragma unroll
            for (int m = 0; m < 4; ++m) sl[ai][m] = *(const f32x4*)(slots + (size_t)(rowb + ai * HALF + m * 16) * 16 + 4 * fq);
        asm volatile("" ::: "memory");
#pragma unroll
        for (int ai = 0; ai < 2; ++ai) {
            f32x4 c4[4], s4[4];
#pragma unroll
            for (int m = 0; m < 4; ++m) { c4[m] = (f32x4){1.f, 1.f, 1.f, 1.f}; s4[m] = (f32x4){0.f, 0.f, 0.f, 0.f}; }
            if (rope) {
#pragma unroll
                for (int m = 0; m < 4; ++m) { const int pos = (rowb + ai * HALF + m * 16) & (SEQ - 1); c4[m] = *(const f32x4*)(cs + pos * 64 + fi); s4[m] = *(const f32x4*)(sn + pos * 64 + fi); }
            }
            asm volatile("" ::: "memory");
#pragma unroll
            for (int m = 0; m < 4; ++m) {
                const int row = rowb + ai * HALF + m * 16;
                float t = (sl[ai][m][0] + sl[ai][m][1]) + (sl[ai][m][2] + sl[ai][m][3]);
                t += __shfl_xor(t, 16); t += __shfl_xor(t, 32);
                const float rs = __builtin_amdgcn_rsqf(t * (1.0f / D) + EPS);
#pragma unroll
                for (int bj = 0; bj < 2; ++bj) {
                    f32x4 v0 = acc[ai][bj][m][0] * rs, v1 = acc[ai][bj][m][1] * rs;
                    if (rope) { const f32x4 o0 = (v0 * c4[m] - v1 * s4[m]) * ksc, o1 = (v0 * s4[m] + v1 * c4[m]) * ksc; v0 = o0; v1 = o1; }
                    u32x4 w; w.x = pk2(v0[0], v0[1]); w.y = pk2(v0[2], v0[3]); w.z = pk2(v1[0], v1[1]); w.w = pk2(v1[2], v1[3]);
                    *(u32x4*)(Z + (size_t)row * INW + col0 + bj * HALF) = w;
                }
            }
            asm volatile("" ::: "memory");
        }
    }
};
template <bool SECOND> struct EpiGate {
    static constexpr bool PERM = true;
    const bf16_t* Zg; const float* bg; float* Y1; bf16_t* Mb;
    DI void operator()(const f32x4 (&acc)[2][2][4][2], const Unit& u, int wr, int wc, int fr, int fq) const {
        const int col0 = u.pn * BM + wc * 32 + 8 * fq;
        const int rowb = u.pm * BM + wr * 64 + fr;
        f32x4 bb[2][2];
#pragma unroll
        for (int bj = 0; bj < 2; ++bj) { bb[bj][0] = *(const f32x4*)(bg + col0 + bj * HALF); bb[bj][1] = *(const f32x4*)(bg + col0 + bj * HALF + 4); }
#pragma unroll
        for (int ai = 0; ai < 2; ++ai)
#pragma unroll
            for (int mp = 0; mp < 2; ++mp) {
                u32x4 zg[2][2]; f32x4 y0[2][2], y1[2][2];
#pragma unroll
                for (int mm = 0; mm < 2; ++mm)
#pragma unroll
                    for (int bj = 0; bj < 2; ++bj) { const int row = rowb + ai * HALF + (2 * mp + mm) * 16, col = col0 + bj * HALF;
                        zg[mm][bj] = *(const u32x4*)(Zg + (size_t)row * INW + col);
                        if (SECOND) { y0[mm][bj] = *(const f32x4*)(Y1 + (size_t)row * D + col); y1[mm][bj] = *(const f32x4*)(Y1 + (size_t)row * D + col + 4); } }
                asm volatile("" ::: "memory");
#pragma unroll
                for (int mm = 0; mm < 2; ++mm)
#pragma unroll
                    for (int bj = 0; bj < 2; ++bj) { const int m = 2 * mp + mm; const int row = rowb + ai * HALF + m * 16, col = col0 + bj * HALF;
                        const u32x4 z = zg[mm][bj]; const f32x4 b0 = bb[bj][0], b1 = bb[bj][1];
                        f32x4 g0, g1;
                        g0[0] = fsigmoid(bflo(z.x) + b0[0]); g0[1] = fsigmoid(bfhi(z.x) + b0[1]); g0[2] = fsigmoid(bflo(z.y) + b0[2]); g0[3] = fsigmoid(bfhi(z.y) + b0[3]);
                        g1[0] = fsigmoid(bflo(z.z) + b1[0]); g1[1] = fsigmoid(bfhi(z.z) + b1[1]); g1[2] = fsigmoid(bflo(z.w) + b1[2]); g1[3] = fsigmoid(bfhi(z.w) + b1[3]);
                        f32x4 v0 = g0 * acc[ai][bj][m][0], v1 = g1 * acc[ai][bj][m][1];
                        if (!SECOND) { float* yp = Y1 + (size_t)row * D + col; *(f32x4*)yp = v0; *(f32x4*)(yp + 4) = v1; }
                        else { v0 += y0[mm][bj]; v1 += y1[mm][bj];
                            u32x4 w; w.x = pk2(v0[0], v0[1]); w.y = pk2(v0[2], v0[3]); w.z = pk2(v1[0], v1[1]); w.w = pk2(v1[2], v1[3]);
                            *(u32x4*)(Mb + (size_t)row * D + col) = w; } }
                asm volatile("" ::: "memory");
            }
    }
};
}

struct Args { const float* in[20]; float* out; unsigned char* ws; };
typedef void* const __attribute__((address_space(4)))* kargp_t;
DI void* karg(int i) { kargp_t p = (kargp_t)__builtin_amdgcn_kernarg_segment_ptr(); asm volatile("" : "+s"(p)); return p[i]; }
DI const float* arg_in(int i) { return (const float*)karg(i); }
DI float* arg_out() { return (float*)karg(20); }
DI unsigned char* arg_ws() { return (unsigned char*)karg(21); }
enum { I_X = 0, I_RELB, I_NF1, I_G1, I_U1, I_D1, I_NMIX, I_WIN, I_BG, I_DEC, I_RNORM, I_WRO, I_QN, I_KN, I_WDO, I_WOUT, I_NF2, I_G2, I_U2, I_D2 };

DI int sigma_rope(int p) { return ((p & 4) ? 64 : 0) + 4 * (p >> 3) + (p & 3); }
DI void conv_item(int kind, const float* src, const float* src2, int ldsrc, const float* gain, int K, int N, bf16_t* Bt, LAS float* scr, int item, int lane) {
    const int nblk = N / 32, kb = item / nblk, nb = item % nblk, k0 = 64 * kb, n0 = 32 * nb;
    const int n = n0 + (lane & 31);
    const float* sp;
    if (kind == 1) { const int tile = n >> 8, r = n & 255; sp = (r < 128 ? src : src2) + tile * 128 + (r & 127); }
    else if (kind == 2) { sp = src + (n < 1024 ? (n & ~127) + sigma_rope(n & 127) : n); }
    else sp = src + n;
    float vv[32];
#pragma unroll
    for (int i = 0; i < 32; ++i) { const int kk = 2 * i + (lane >> 5); vv[i] = sp[(size_t)(k0 + kk) * ldsrc]; }
    if (gain) {
#pragma unroll
        for (int i = 0; i < 32; ++i) { const int kk = 2 * i + (lane >> 5); vv[i] *= gain[k0 + kk]; } }
#pragma unroll
    for (int i = 0; i < 32; ++i) { const int kk = 2 * i + (lane >> 5); scr[kk * 33 + (lane & 31)] = vv[i]; }
    asm volatile("s_waitcnt lgkmcnt(0)" ::: "memory");
    const int c = lane & 7;
#pragma unroll
    for (int j = 0; j < 4; ++j) { const int nn = (lane >> 3) + 8 * j; const LAS float* s = scr + (8 * c) * 33 + nn;
        u32x4 o; o.x = pk2(s[0 * 33], s[1 * 33]); o.y = pk2(s[2 * 33], s[3 * 33]); o.z = pk2(s[4 * 33], s[5 * 33]); o.w = pk2(s[6 * 33], s[7 * 33]);
        *(u32x4*)(Bt + (size_t)(n0 + nn) * K + k0 + 8 * c) = o; }
    asm volatile("s_waitcnt lgkmcnt(0)" ::: "memory");
}
DI int t5_bucket(int rel) {
    const int n = rel < 0 ? -rel : rel; int ret = rel > 0 ? 16 : 0;
    const float nf = (float)(n < 1 ? 1 : n);
    int large = 8 + (int)(logf(nf / 8.0f) / logf(128.0f) * 8.0f);
    large = large < 15 ? large : 15;
    return ret + (n < 8 ? n : large);
}
DI void prep_phase(LAS unsigned char* lds) {
    const int tid = opaque_tid(), lane = tid & 63, wave = tid >> 6;
    const int gw = opaque_bid() * 8 + wave, NGW = gridDim.x * 8;
    const int gt = opaque_bid() * NTHREADS + tid, NGT = gridDim.x * NTHREADS;
    unsigned char* ws = arg_ws();
    {
        bf16_t* xb = (bf16_t*)(ws + WS_XB); float* slots = (float*)(ws + WS_SLOT);
        for (int row = gw; row < NTOK; row += NGW) {
            const f32x4* xr = (const f32x4*)(arg_in(I_X) + (size_t)row * D) + lane;
            f32x4* orow = (f32x4*)(arg_out() + (size_t)row * D) + lane;
            u32x2* brow = (u32x2*)(xb + (size_t)row * D) + lane;
            float ss = 0.f;
#pragma unroll
            for (int j = 0; j < 4; ++j) { const f32x4 v = xr[64 * j]; orow[64 * j] = v; u32x2 w; w.x = pk2(v[0], v[1]); w.y = pk2(v[2], v[3]); brow[64 * j] = w;
                ss += (v[0] * v[0] + v[1] * v[1]) + (v[2] * v[2] + v[3] * v[3]); }
#pragma unroll
            for (int o = 1; o < 64; o <<= 1) ss += __shfl_xor(ss, o);
            if (lane < 16) slots[(size_t)row * 16 + lane] = lane == 0 ? ss : 0.f;
        }
    }
    {
        float* cs = (float*)(ws + WS_ROPE); float* sn = cs + SEQ * 64;
        for (int i = gt; i < SEQ * 64; i += NGT) { const int pos = i >> 6, f = i & 63;
            const float inv = powf(10000.0f, -(float)f / 64.0f); const float ang = (float)pos * inv; cs[i] = cosf(ang); sn[i] = sinf(ang); }
    }
    {
        float* bt = (float*)(ws + WS_BIAS);
        for (int i = gt; i < 12 * 129; i += NGT) { const int hh = i / 129, dl = i % 129 - 64; const int gi = hh >> 2, d = gi == 0 ? 1 : (gi == 1 ? 4 : 16);
            bt[i] = arg_in(I_RELB)[t5_bucket(dl * d) * 12 + hh]; }
    }
    {
        LAS float* scr = (LAS float*)(lds + wave * 16384);
        constexpr int I_GU = 16 * 176, I_DN = 44 * 32, I_IN = 16 * 304, I_RO = 16 * 32, I_DO = 8 * 32, I_OU = 16 * 32;
        constexpr int PER_LAYER = 2 * I_GU + 2 * I_DN + I_IN + I_RO + I_DO + I_OU;
        for (int it = gw; it < DEPTH * PER_LAYER; it += NGW) {
            const int l = it / PER_LAYER; int r = it % PER_LAYER;
            unsigned char* wl = ws + WS_W + (size_t)l * LW;
            if (r < I_GU) { conv_item(1, arg_in(I_G1) + (size_t)l * D * FF, arg_in(I_U1) + (size_t)l * D * FF, FF, arg_in(I_NF1) + l * D, D, 5632, (bf16_t*)(wl + OW_GU1), scr, r, lane); continue; } r -= I_GU;
            if (r < I_GU) { conv_item(1, arg_in(I_G2) + (size_t)l * D * FF, arg_in(I_U2) + (size_t)l * D * FF, FF, arg_in(I_NF2) + l * D, D, 5632, (bf16_t*)(wl + OW_GU2), scr, r, lane); continue; } r -= I_GU;
            if (r < I_DN) { conv_item(0, arg_in(I_D1) + (size_t)l * FF * D, nullptr, D, nullptr, FF, D, (bf16_t*)(wl + OW_D1), scr, r, lane); continue; } r -= I_DN;
            if (r < I_DN) { conv_item(0, arg_in(I_D2) + (size_t)l * FF * D, nullptr, D, nullptr, FF, D, (bf16_t*)(wl + OW_D2), scr, r, lane); continue; } r -= I_DN;
            if (r < I_IN) { conv_item(2, arg_in(I_WIN) + (size_t)l * D * INW, nullptr, INW, arg_in(I_NMIX) + l * D, D, INW, (bf16_t*)(wl + OW_IN), scr, r, lane); continue; } r -= I_IN;
            if (r < I_RO) { conv_item(0, arg_in(I_WRO) + (size_t)l * D * D, nullptr, D, nullptr, D, D, (bf16_t*)(wl + OW_RO), scr, r, lane); continue; } r -= I_RO;
            if (r < I_DO) { conv_item(0, arg_in(I_WDO) + (size_t)l * 512 * D, nullptr, D, nullptr, 512, D, (bf16_t*)(wl + OW_DO), scr, r, lane); continue; } r -= I_DO;
            conv_item(0, arg_in(I_WOUT) + (size_t)l * D * D, nullptr, D, nullptr, D, D, (bf16_t*)(wl + OW_OUT), scr, r, lane);
        }
    }
}

constexpr int RV_PITCH = 528, RK_PITCH = 272;
DI void ret_kv_phase(int l, unsigned char* lds_g, LAS unsigned char* lds) {
    const int tid = opaque_tid(), lane = tid & 63, w = tid >> 6, fr = lane & 15, fq = lane >> 4;
    const unsigned lbase = (unsigned)(size_t)lds_g;
    const bf16_t* Z = (const bf16_t*)(arg_ws() + WS_Z); bf16_t* KV = (bf16_t*)(arg_ws() + WS_KV);
    constexpr int OV = 0, OKF = 128 * RV_PITCH, OKB = OKF + 128 * RK_PITCH;
    for (int item = opaque_bid(); item < GB * 4 * 32; item += gridDim.x) {
        const int n = item & 31, h = (item >> 5) & 3, bl = item >> 7;
        const size_t row0 = (size_t)bl * SEQ + n * 128;
        const float de_f = arg_in(I_DEC)[(l * 2 + 0) * 4 + h], de_b = arg_in(I_DEC)[(l * 2 + 1) * 4 + h];
        const float l2f = log1pf(-exp2f(-de_f)) * 1.44269504f, l2b = log1pf(-exp2f(-de_b)) * 1.44269504f;
#pragma unroll
        for (int i = 0; i < 8; ++i) { const int id = tid + 512 * i, r = id >> 5, ch = id & 31;
            const u32x4 v = *(const u32x4*)(Z + (row0 + r) * INW + ZC_RV + h * 256 + ch * 8);
            *(LAS u32x4*)(lds + OV + r * RV_PITCH + ch * 16) = v; }
#pragma unroll
        for (int i = 0; i < 4; ++i) { const int id = tid + 512 * i, r = id >> 4, ch = id & 15;
            const u32x4 v = *(const u32x4*)(Z + (row0 + r) * INW + ZC_RK + h * 128 + ch * 8);
            const float sf = fexp2(l2f * (float)(127 - r)), sb = fexp2(l2b * (float)r);
            u32x4 f, b;
            f.x = pk2(bflo(v.x) * sf, bfhi(v.x) * sf); f.y = pk2(bflo(v.y) * sf, bfhi(v.y) * sf); f.z = pk2(bflo(v.z) * sf, bfhi(v.z) * sf); f.w = pk2(bflo(v.w) * sf, bfhi(v.w) * sf);
            b.x = pk2(bflo(v.x) * sb, bfhi(v.x) * sb); b.y = pk2(bflo(v.y) * sb, bfhi(v.y) * sb); b.z = pk2(bflo(v.z) * sb, bfhi(v.z) * sb); b.w = pk2(bflo(v.w) * sb, bfhi(v.w) * sb);
            *(LAS u32x4*)(lds + OKF + r * RK_PITCH + ch * 16) = f; *(LAS u32x4*)(lds + OKB + r * RK_PITCH + ch * 16) = b; }
        __syncthreads();
        f32x4 acc[2][8][2];
#pragma unroll
        for (int d = 0; d < 2; ++d)
#pragma unroll
            for (int mt = 0; mt < 8; ++mt)
#pragma unroll
                for (int nt = 0; nt < 2; ++nt) acc[d][mt][nt] = (f32x4){0.f, 0.f, 0.f, 0.f};
        const int q = fr >> 2, p = fr & 3;
#pragma unroll 1
        for (int ks = 0; ks < 4; ++ks) {
            const int tr0 = 32 * ks + 8 * fq + q;
            bf16x8 Bv[2];
#pragma unroll
            for (int nt = 0; nt < 2; ++nt) { const unsigned ad = lbase + OV + tr0 * RV_PITCH + (32 * w + 16 * nt + 4 * p) * 2; Bv[nt] = tr_frag(ad, ad + 4 * RV_PITCH); }
#pragma unroll
            for (int d = 0; d < 2; ++d) { const unsigned ad = lbase + (d ? OKB : OKF) + tr0 * RK_PITCH + (4 * p) * 2; bf16x8 Ak[8]; tr8(ad, ad + 4 * RK_PITCH, Ak);
#pragma unroll
                for (int mt = 0; mt < 8; ++mt)
#pragma unroll
                    for (int nt = 0; nt < 2; ++nt) acc[d][mt][nt] = mfma16(Ak[mt], Bv[nt], acc[d][mt][nt]); }
        }
#pragma unroll
        for (int d = 0; d < 2; ++d)
#pragma unroll
            for (int nt = 0; nt < 2; ++nt)
#pragma unroll
                for (int mt = 0; mt < 8; ++mt)
                    { u32x2 o; o.x = pk2(acc[d][mt][nt][0], acc[d][mt][nt][1]); o.y = pk2(acc[d][mt][nt][2], acc[d][mt][nt][3]);
                      *(u32x2*)(KV + (((size_t)item * 2 + d) * 256 + 32 * w + 16 * nt + fr) * 128 + 16 * mt + 4 * fq) = o; }
        __syncthreads();
    }
}

struct DilIt { int hh, d, L, i0; size_t rowb; };
DI DilIt dil_decode(int item) {
    DilIt it; const int blk = item & 31; it.hh = (item >> 5) % 12; const int bl = item / (32 * 12);
    const int gi = it.hh >> 2; it.d = gi == 0 ? 1 : (gi == 1 ? 4 : 16); it.L = SEQ / it.d; const int bpc = it.L / 128;
    const int r = blk / bpc, qb = blk % bpc; it.i0 = 128 * qb; it.rowb = (size_t)bl * SEQ + r; return it;
}
DI void dil_issue(const bf16_t* Z, const DilIt& it, int tid, u32x4 (&kraw)[8], u32x4 (&vraw)[8]) {
#pragma unroll
    for (int i = 0; i < 8; ++i) { const int id = tid + 512 * i, kk = id >> 4, ch = id & 15; const int j = it.i0 - 64 + kk; const bool ok = (j >= 0) && (j < it.L);
        kraw[i] = (u32x4){0u, 0u, 0u, 0u}; vraw[i] = (u32x4){0u, 0u, 0u, 0u};
        if (ok) { const bf16_t* zr = Z + (it.rowb + (size_t)j * it.d) * INW; kraw[i] = *(const u32x4*)(zr + ZC_DK + it.hh * 128 + ch * 8); vraw[i] = *(const u32x4*)(zr + ZC_DV + it.hh * 128 + ch * 8); } }
}
DI void dil_issue_q(const bf16_t* Z, const DilIt& it, int w, int fr, int fq, u32x4 (&qraw)[4]) {
    const size_t qrow = it.rowb + (size_t)(it.i0 + 16 * w + fr) * it.d;
#pragma unroll
    for (int ks = 0; ks < 4; ++ks) qraw[ks] = *(const u32x4*)(Z + qrow * INW + ZC_DQ + it.hh * 128 + 32 * ks + 8 * fq);
}
template <bool STORE = true> DI void dil_attn_phase(int l, unsigned char* lds_g, LAS unsigned char* lds) {
    const int tid = opaque_tid(), lane = tid & 63, w = tid >> 6, fr = lane & 15, fq = lane >> 4;
    const unsigned lbase = (unsigned)(size_t)lds_g;
    bf16_t* Z = (bf16_t*)(arg_ws() + WS_Z); float* LSE = (float*)(arg_ws() + WS_LSE);
    const float* bt = (const float*)(arg_ws() + WS_BIAS);
    const float* qn = arg_in(I_QN) + l * 128; const float* kn = arg_in(I_KN) + l * 128;
    constexpr int KP = 272, OK = 0, OV = 256 * KP, OB = 2 * 256 * KP, NITEM = GB * 12 * 32;
    int item = opaque_bid();
    if (item >= NITEM) return;
    u32x4 kraw[8], vraw[8];
    DilIt it = dil_decode(item);
    dil_issue(Z, it, tid, kraw, vraw);
    for (;;) {
        const int hh = it.hh, d = it.d, L = it.L, i0 = it.i0; const size_t rowb = it.rowb;
        u32x4 qraw[4]; dil_issue_q(Z, it, w, fr, fq, qraw);
#pragma unroll
        for (int i = 0; i < 8; ++i) { const int id = tid + 512 * i, kk = id >> 4, ch = id & 15;
            const u32x4 kv = kraw[i];
            float f[8] = {bflo(kv.x), bfhi(kv.x), bflo(kv.y), bfhi(kv.y), bflo(kv.z), bfhi(kv.z), bflo(kv.w), bfhi(kv.w)};
            float ss = 0.f;
#pragma unroll
            for (int e = 0; e < 8; ++e) ss += f[e] * f[e];
            ss += __shfl_xor(ss, 1); ss += __shfl_xor(ss, 2); ss += __shfl_xor(ss, 4); ss += __shfl_xor(ss, 8);
            const float rs = __builtin_amdgcn_rsqf(ss * (1.0f / 128.0f) + EPS);
            const f32x4 g0 = *(const f32x4*)(kn + ch * 8), g1 = *(const f32x4*)(kn + ch * 8 + 4);
            u32x4 ko; ko.x = pk2(f[0] * rs * g0[0], f[1] * rs * g0[1]); ko.y = pk2(f[2] * rs * g0[2], f[3] * rs * g0[3]); ko.z = pk2(f[4] * rs * g1[0], f[5] * rs * g1[1]); ko.w = pk2(f[6] * rs * g1[2], f[7] * rs * g1[3]);
            *(LAS u32x4*)(lds + OK + kk * KP + ch * 16) = ko; *(LAS u32x4*)(lds + OV + kk * KP + ch * 16) = vraw[i];
            asm volatile("" ::: "memory"); }
        if (tid < 129) *(LAS float*)(lds + OB + tid * 4) = bt[hh * 129 + tid];
        const size_t qrow = rowb + (size_t)(i0 + 16 * w + fr) * d;
        bf16x8 Qf[4];
        {
            float ss = 0.f;
#pragma unroll
            for (int ks = 0; ks < 4; ++ks) { const u32x4 v = qraw[ks];
                ss += bflo(v.x) * bflo(v.x) + bfhi(v.x) * bfhi(v.x) + bflo(v.y) * bflo(v.y) + bfhi(v.y) * bfhi(v.y) + bflo(v.z) * bflo(v.z) + bfhi(v.z) * bfhi(v.z) + bflo(v.w) * bflo(v.w) + bfhi(v.w) * bfhi(v.w); }
            ss += __shfl_xor(ss, 16); ss += __shfl_xor(ss, 32);
            const float rs = __builtin_amdgcn_rsqf(ss * (1.0f / 128.0f) + EPS) * 0.08838834764831845f;
#pragma unroll
            for (int ks = 0; ks < 4; ++ks) { const u32x4 v = qraw[ks]; const f32x4 g0 = *(const f32x4*)(qn + 32 * ks + 8 * fq), g1 = *(const f32x4*)(qn + 32 * ks + 8 * fq + 4);
                u32x4 o; o.x = pk2(bflo(v.x) * rs * g0[0], bfhi(v.x) * rs * g0[1]); o.y = pk2(bflo(v.y) * rs * g0[2], bfhi(v.y) * rs * g0[3]);
                o.z = pk2(bflo(v.z) * rs * g1[0], bfhi(v.z) * rs * g1[1]); o.w = pk2(bflo(v.w) * rs * g1[2], bfhi(v.w) * rs * g1[3]); Qf[ks] = as_frag(o); }
        }
        __syncthreads();
        const int nitem = item + (int)gridDim.x; const bool has_next = nitem < NITEM;
        if (has_next) { it = dil_decode(nitem); dil_issue(Z, it, tid, kraw, vraw); }
        f32x4 sc[9];
#pragma unroll
        for (int jt = 0; jt < 9; ++jt) { f32x4 s = (f32x4){0.f, 0.f, 0.f, 0.f};
#pragma unroll
            for (int ks = 0; ks < 4; ++ks) { const bf16x8 kf = *(const LAS bf16x8*)(lds + OK + (16 * w + 16 * jt + fr) * KP + (32 * ks + 8 * fq) * 2); s = mfma16(kf, Qf[ks], s); }
            sc[jt] = s; if (jt % 3 == 2) asm volatile("" ::: "memory"); }
        float mx = -3.0e38f;
        int dlo = 4 * fq - 64 - fr; asm volatile("" : "+v"(dlo));
#pragma unroll
        for (int jt = 0; jt < 9; ++jt)
#pragma unroll
            for (int e = 0; e < 4; ++e) { const int dl = 16 * jt + e + dlo; const int j = i0 + 16 * w + fr + dl;
                const bool ok = (dl >= -64) && (dl <= 64) && (j >= 0) && (j < L);
                const int bi = dl < -64 ? 0 : (dl > 64 ? 128 : dl + 64);
                const float v = ok ? sc[jt][e] + *(const LAS float*)(lds + OB + bi * 4) : -1.0e30f; sc[jt][e] = v; mx = fmaxf(mx, v); }
        mx = fmaxf(mx, __shfl_xor(mx, 16)); mx = fmaxf(mx, __shfl_xor(mx, 32));
        float den = 0.f;
#pragma unroll
        for (int jt = 0; jt < 9; ++jt)
#pragma unroll
            for (int e = 0; e < 4; ++e) { const float pv = fexp2((sc[jt][e] - mx) * 1.44269504f); sc[jt][e] = pv; den += pv; }
        den += __shfl_xor(den, 16); den += __shfl_xor(den, 32);
        f32x4 oc[8];
#pragma unroll
        for (int c = 0; c < 8; ++c) oc[c] = (f32x4){0.f, 0.f, 0.f, 0.f};
        const int q = fr >> 2, p = fr & 3;
#pragma unroll
        for (int kp = 0; kp < 5; ++kp) {
            u32x4 pw; pw.x = pk2(sc[2 * kp][0], sc[2 * kp][1]); pw.y = pk2(sc[2 * kp][2], sc[2 * kp][3]);
            if (kp < 4) { pw.z = pk2(sc[2 * kp + 1 > 8 ? 8 : 2 * kp + 1][0], sc[2 * kp + 1 > 8 ? 8 : 2 * kp + 1][1]); pw.w = pk2(sc[2 * kp + 1 > 8 ? 8 : 2 * kp + 1][2], sc[2 * kp + 1 > 8 ? 8 : 2 * kp + 1][3]); }
            else { pw.z = 0u; pw.w = 0u; }
            const bf16x8 Pf = as_frag(pw);
            const int ra = 16 * w + 32 * kp + 4 * fq + q, rb = kp < 4 ? ra + 16 : ra;
            bf16x8 Vf[8]; tr8(lbase + OV + ra * KP + (4 * p) * 2, lbase + OV + rb * KP + (4 * p) * 2, Vf);
#pragma unroll
            for (int c = 0; c < 8; ++c) oc[c] = mfma16(Vf[c], Pf, oc[c]);
        }
        const float rden = 1.0f / den;
        if (STORE || den == -1.0f) {
#pragma unroll
        for (int c = 0; c < 8; ++c) { u32x2 o; o.x = pk2(oc[c][0] * rden, oc[c][1] * rden); o.y = pk2(oc[c][2] * rden, oc[c][3] * rden);
            *(u32x2*)(Z + qrow * INW + ZC_DQ + hh * 128 + 16 * c + 4 * fq) = o; }
        if (fq == 0) LSE[qrow * 12 + hh] = mx + logf(den);
        }
        if (!has_next) break;
        item = nitem;
        __syncthreads();
    }
    __syncthreads();
}

DI void scan_combine_phase(int l) {
    const int gt = opaque_bid() * NTHREADS + opaque_tid(), NGT = gridDim.x * NTHREADS;
    const u32x2* KV = (const u32x2*)(arg_ws() + WS_KV); u32x2* S = (u32x2*)(arg_ws() + WS_S);
    for (int v = gt; v < GB * 4 * 2 * 8192; v += NGT) {
        const int bh = v >> 14, dir = (v >> 13) & 1, e4 = v & 8191, h = bh & 3;
        const float de = arg_in(I_DEC)[(l * 2 + dir) * 4 + h];
        const float cd = exp2f(log1pf(-exp2f(-de)) * 1.44269504f * 128.0f);
        u32x2 kw[32];
#pragma unroll
        for (int step = 0; step < 32; ++step) { const int n = dir ? 31 - step : step; kw[step] = KV[((size_t)(bh * 32 + n) * 2 + dir) * 8192 + e4]; }
        f32x4 st = (f32x4){0.f, 0.f, 0.f, 0.f};
#pragma unroll
        for (int step = 0; step < 32; ++step) { const int n = dir ? 31 - step : step; const size_t idx = ((size_t)(bh * 32 + n) * 2 + dir) * 8192 + e4;
            u32x2 o; o.x = pk2(st[0], st[1]); o.y = pk2(st[2], st[3]); S[idx] = o;
            const f32x4 kv = (f32x4){bflo(kw[step].x), bfhi(kw[step].x), bflo(kw[step].y), bfhi(kw[step].y)}; st = st * cd + kv; }
    }
    const bf16_t* Z = (const bf16_t*)(arg_ws() + WS_Z); const float* LSE = (const float*)(arg_ws() + WS_LSE); bf16_t* DL = (bf16_t*)(arg_ws() + WS_DL);
    for (int id = gt; id < GT * 64; id += NGT) {
        const int tok = id >> 6, j = (id >> 4) & 3, ch = id & 15;
        const float l0 = LSE[tok * 12 + j], l1 = LSE[tok * 12 + 4 + j], l2 = LSE[tok * 12 + 8 + j];
        const float mx = fmaxf(l0, fmaxf(l1, l2));
        float w0 = __expf(l0 - mx), w1 = __expf(l1 - mx), w2 = __expf(l2 - mx); const float rw = 1.0f / (w0 + w1 + w2); w0 *= rw; w1 *= rw; w2 *= rw;
        const bf16_t* zr = Z + (size_t)tok * INW + ZC_DQ + j * 128 + ch * 8;
        const u32x4 a0 = *(const u32x4*)zr, a1 = *(const u32x4*)(zr + 512), a2 = *(const u32x4*)(zr + 1024);
        u32x4 o;
        o.x = pk2(w0 * bflo(a0.x) + w1 * bflo(a1.x) + w2 * bflo(a2.x), w0 * bfhi(a0.x) + w1 * bfhi(a1.x) + w2 * bfhi(a2.x));
        o.y = pk2(w0 * bflo(a0.y) + w1 * bflo(a1.y) + w2 * bflo(a2.y), w0 * bfhi(a0.y) + w1 * bfhi(a1.y) + w2 * bfhi(a2.y));
        o.z = pk2(w0 * bflo(a0.z) + w1 * bflo(a1.z) + w2 * bflo(a2.z), w0 * bfhi(a0.z) + w1 * bfhi(a1.z) + w2 * bfhi(a2.z));
        o.w = pk2(w0 * bflo(a0.w) + w1 * bflo(a1.w) + w2 * bflo(a2.w), w0 * bfhi(a0.w) + w1 * bfhi(a1.w) + w2 * bfhi(a2.w));
        *(u32x4*)(DL + (size_t)tok * 512 + j * 128 + ch * 8) = o;
    }
}

DI void ret_out_phase(int l, unsigned char* lds_g, LAS unsigned char* lds) {
    const int tid = opaque_tid(), lane = tid & 63, w = tid >> 6, fr = lane & 15, fq = lane >> 4;
    const unsigned lbase = (unsigned)(size_t)lds_g;
    const bf16_t* Z = (const bf16_t*)(arg_ws() + WS_Z); const bf16_t* S = (const bf16_t*)(arg_ws() + WS_S); bf16_t* R = (bf16_t*)(arg_ws() + WS_R);
    const float* rn = arg_in(I_RNORM) + l * 1024;
    constexpr int OQ = 0, OKP = 128 * RK_PITCH, OV = 2 * 128 * RK_PITCH, OT = OV + 128 * RV_PITCH;
    for (int item = opaque_bid(); item < GB * 4 * 32; item += gridDim.x) {
        const int n = item & 31, h = (item >> 5) & 3, bl = item >> 7;
        const size_t row0 = (size_t)bl * SEQ + n * 128;
        const float de_f = arg_in(I_DEC)[(l * 2 + 0) * 4 + h], de_b = arg_in(I_DEC)[(l * 2 + 1) * 4 + h];
        const float l2f = log1pf(-exp2f(-de_f)) * 1.44269504f, l2b = log1pf(-exp2f(-de_b)) * 1.44269504f;
#pragma unroll
        for (int i = 0; i < 8; ++i) { const int id = tid + 512 * i, r = id >> 5, ch = id & 31;
            *(LAS u32x4*)(lds + OV + r * RV_PITCH + ch * 16) = *(const u32x4*)(Z + (row0 + r) * INW + ZC_RV + h * 256 + ch * 8); }
#pragma unroll
        for (int i = 0; i < 4; ++i) { const int id = tid + 512 * i, r = id >> 4, ch = id & 15;
            *(LAS u32x4*)(lds + OQ + r * RK_PITCH + ch * 16) = *(const u32x4*)(Z + (row0 + r) * INW + ZC_RQ + h * 128 + ch * 8);
            *(LAS u32x4*)(lds + OKP + r * RK_PITCH + ch * 16) = *(const u32x4*)(Z + (row0 + r) * INW + ZC_RK + h * 128 + ch * 8); }
        __syncthreads();
        {
            bf16x8 Qf[4];
#pragma unroll
            for (int ks = 0; ks < 4; ++ks) Qf[ks] = *(const LAS bf16x8*)(lds + OQ + (16 * w + fr) * RK_PITCH + (32 * ks + 8 * fq) * 2);
            u32x2 pw[8];
            const int i = 16 * w + fr;
#pragma unroll
            for (int jt = 0; jt < 8; ++jt) { f32x4 s = (f32x4){0.f, 0.f, 0.f, 0.f};
#pragma unroll
                for (int ks = 0; ks < 4; ++ks) { const bf16x8 kf = *(const LAS bf16x8*)(lds + OKP + (16 * jt + fr) * RK_PITCH + (32 * ks + 8 * fq) * 2); s = mfma16(kf, Qf[ks], s); }
                int io = i - 4 * fq; asm volatile("" : "+v"(io));
#pragma unroll
                for (int e = 0; e < 4; ++e) { const int x = io - (16 * jt + e); const float dm = fexp2(x >= 0 ? l2f * (float)x : l2b * (float)(-x)); s[e] *= dm; }
                pw[jt].x = pk2(s[0], s[1]); pw[jt].y = pk2(s[2], s[3]); asm volatile("" ::: "memory"); }
            __syncthreads();
#pragma unroll
            for (int jt = 0; jt < 8; ++jt) *(LAS u32x2*)(lds + OKP + i * RK_PITCH + (16 * jt + 4 * fq) * 2) = pw[jt];
        }
        __syncthreads();
        f32x4 O[2][8];
        {
            const int q = fr >> 2, p = fr & 3;
#pragma unroll 1
            for (int dir = 0; dir < 2; ++dir) {
                const bf16_t* Sd = S + (((size_t)item * 2 + dir) * 256 + 32 * w) * 128;
#pragma unroll
                for (int m = 0; m < 2; ++m) {
                    f32x4 T[8];
#pragma unroll
                    for (int nt = 0; nt < 8; ++nt) T[nt] = (f32x4){0.f, 0.f, 0.f, 0.f};
                    u32x4 Sf4[4];
#pragma unroll
                    for (int ks = 0; ks < 4; ++ks) Sf4[ks] = *(const u32x4*)(Sd + (16 * m + fr) * 128 + 32 * ks + 8 * fq);
                    asm volatile("" ::: "memory");
#pragma unroll
                    for (int ks = 0; ks < 4; ++ks) {
                        const bf16x8 Af = as_frag(Sf4[ks]);
#pragma unroll
                        for (int nt = 0; nt < 8; ++nt) { const bf16x8 qf = *(const LAS bf16x8*)(lds + OQ + (16 * nt + fr) * RK_PITCH + (32 * ks + 8 * fq) * 2); T[nt] = mfma16(Af, qf, T[nt]); }
                        asm volatile("" ::: "memory");
                    }
                    int fro = fr; asm volatile("" : "+v"(fro));
#pragma unroll
                    for (int nt = 0; nt < 8; ++nt) { const int i = 16 * nt + fro; const float sc = dir ? fexp2(l2b * (float)(128 - i)) : fexp2(l2f * (float)(i + 1));
                        if (dir) O[m][nt] += T[nt] * sc; else O[m][nt] = T[nt] * sc; }
                    asm volatile("" ::: "memory");
                }
            }
#pragma unroll 1
            for (int ks = 0; ks < 4; ++ks) {
                bf16x8 Vf[2];
                const int tr0 = 32 * ks + 8 * fq + q;
#pragma unroll
                for (int m = 0; m < 2; ++m) { const unsigned ad = lbase + OV + tr0 * RV_PITCH + (32 * w + 16 * m + 4 * p) * 2; Vf[m] = tr_frag(ad, ad + 4 * RV_PITCH); }
#pragma unroll
                for (int nt = 0; nt < 8; ++nt) { const bf16x8 pf = *(const LAS bf16x8*)(lds + OKP + (16 * nt + fr) * RK_PITCH + (32 * ks + 8 * fq) * 2);
#pragma unroll
                    for (int m = 0; m < 2; ++m) O[m][nt] = mfma16(Vf[m], pf, O[m][nt]); }
            }
        }
#pragma unroll
        for (int nt = 0; nt < 8; ++nt) { float ss = 0.f;
#pragma unroll
            for (int m = 0; m < 2; ++m)
#pragma unroll
                for (int e = 0; e < 4; ++e) ss += O[m][nt][e] * O[m][nt][e];
            ss += __shfl_xor(ss, 16); ss += __shfl_xor(ss, 32);
            if (fq == 0) *(LAS float*)(lds + OT + (w * 128 + 16 * nt + fr) * 4) = ss; }
        __syncthreads();
#pragma unroll
        for (int nt = 0; nt < 8; ++nt) { const int i = 16 * nt + fr; float tot = 0.f;
#pragma unroll
            for (int ww = 0; ww < 8; ++ww) tot += *(const LAS float*)(lds + OT + (ww * 128 + i) * 4);
            const float rinv = __builtin_amdgcn_rsqf(tot * (1.0f / 256.0f) + EPS);
#pragma unroll
            for (int m = 0; m < 2; ++m) { const int dv = h * 256 + 32 * w + 16 * m + 4 * fq;
                const u32x2 gz = *(const u32x2*)(Z + (row0 + i) * INW + ZC_RG + dv); const f32x4 gn = *(const f32x4*)(rn + dv);
                const float o0 = O[m][nt][0] * rinv * gn[0] * fsilu(bflo(gz.x)), o1 = O[m][nt][1] * rinv * gn[1] * fsilu(bfhi(gz.x));
                const float o2 = O[m][nt][2] * rinv * gn[2] * fsilu(bflo(gz.y)), o3 = O[m][nt][3] * rinv * gn[3] * fsilu(bfhi(gz.y));
                u32x2 o; o.x = pk2(o0, o1); o.y = pk2(o2, o3);
                *(u32x2*)(R + (row0 + i) * 1024 + dv) = o; }
            asm volatile("" ::: "memory"); }
        __syncthreads();
    }
}

#ifndef PHMASK
#define PHMASK 0xffff
#endif
#define PH(k) ((PHMASK >> (k)) & 1)

#define XB_TMO      128
#define XB_XCNT(j)  (256  + 64 * (j))
#define XB_XSUB(j)  (1280 + 64 * (j))
#define XB_XGEN(j)  (2304 + 64 * (j))
#define XB_TOP      3328
#define XB_TOPGEN   3392
#define XCD_BAR_WORDS 3456
#define XB_SPIN_CAP (1u << 22)
DI unsigned xb_ld(unsigned* p)              { return __hip_atomic_load(p, __ATOMIC_RELAXED, __HIP_MEMORY_SCOPE_AGENT); }
DI unsigned xb_add(unsigned* p, unsigned v) { return __hip_atomic_fetch_add(p, v, __ATOMIC_RELAXED, __HIP_MEMORY_SCOPE_AGENT); }
DI unsigned xb_xcc_id() { return (unsigned)__builtin_amdgcn_s_getreg((3 << 11) | 20) & 0xFu; }
#define XB_SPIN(cond, bar) do { unsigned _sp = 0; while (cond) { __builtin_amdgcn_s_sleep(1); \
    if ((++_sp & 255u) == 0u) { if (xb_ld(&(bar)[XB_TMO])) break; if (_sp > XB_SPIN_CAP) { atomicAdd(&(bar)[XB_TMO], 1u); break; } } } } while (0)
DI void xcd_barrier_complete(unsigned* bar, unsigned x, unsigned& nloc, unsigned& nx) {
    const unsigned G = gridDim.x * gridDim.y * gridDim.z;
    unsigned sum, cnt, mine, sp = 0u;
    for (;;) {
        sum = 0u; cnt = 0u; mine = 0u;
#pragma unroll
        for (unsigned j = 0; j < 16; ++j) { const unsigned c = xb_ld(&bar[XB_XCNT(j)]); sum += c; cnt += (c > 0u) ? 1u : 0u; mine = (j == x) ? c : mine; }
        if (sum == G) break;
        __builtin_amdgcn_s_sleep(1);
        if ((++sp & 255u) == 0u) { if (xb_ld(&bar[XB_TMO])) break; if (sp > XB_SPIN_CAP) { atomicAdd(&bar[XB_TMO], 1u); break; } }
    }
    nloc = mine > 0u ? mine : 1u; nx = cnt > 0u ? cnt : 1u;
}
DI void xcd_barrier(unsigned* bar, volatile LAS unsigned* st) {
    asm volatile("s_waitcnt vmcnt(0)" ::: "memory");
    __syncthreads();
    if (threadIdx.x == 0) {
        __builtin_amdgcn_s_waitcnt(0);
        const unsigned x = xb_xcc_id();
        unsigned nloc = st[0], nx = st[1];
        if (nloc == 0u) { xcd_barrier_complete(bar, x, nloc, nx); st[0] = nloc; st[1] = nx; }
        const unsigned old = xb_add(&bar[XB_XSUB(x)], 1u);
        const unsigned gen = old / nloc;
        if (old + 1u == (gen + 1u) * nloc) {
            __builtin_amdgcn_fence(__ATOMIC_RELEASE, "agent");
            asm volatile("s_waitcnt vmcnt(0)" ::: "memory");
            const unsigned og = xb_add(&bar[XB_TOP], 1u);
            const unsigned tg = og / nx;
            if (og + 1u == (tg + 1u) * nx) xb_add(&bar[XB_TOPGEN], 1u);
            else XB_SPIN(xb_ld(&bar[XB_TOPGEN]) == tg, bar);
            __builtin_amdgcn_fence(__ATOMIC_ACQUIRE, "agent");
            xb_add(&bar[XB_XGEN(x)], 1u);
            asm volatile("s_waitcnt vmcnt(0)" ::: "memory");
        } else {
            XB_SPIN(xb_ld(&bar[XB_XGEN(x)]) == gen, bar);
            __builtin_amdgcn_fence(__ATOMIC_ACQUIRE, "agent");
            asm volatile("s_waitcnt vmcnt(0)" ::: "memory");
        }
    }
    __syncthreads();
}

DI void ph_win(LAS unsigned char* lds, int l, int g) {
    unsigned char* ws = arg_ws(); const size_t rb = (size_t)g * GT;
    pg8::Gemm gm{(const bf16_t*)(ws + WS_XB) + rb * D, (const bf16_t*)(ws + WS_W + (size_t)l * LW + OW_IN), GT, INW, D}; pg8::StaticOrder S; S.init(GT, INW, gridDim.x, opaque_bid());
    pg8::EpiZ E{(bf16_t*)(ws + WS_Z), (const float*)(ws + WS_SLOT) + rb * 16, (const float*)(ws + WS_ROPE), (const float*)(ws + WS_ROPE) + SEQ * 64}; pg8::gemm_phase(lds, gm, S, E);
}
DI void ph_post1(LAS unsigned char* lds, int l) {
    unsigned char* ws = arg_ws();
    pg8::Gemm gm{(const bf16_t*)(ws + WS_R), (const bf16_t*)(ws + WS_W + (size_t)l * LW + OW_RO), GT, D, D}; pg8::StaticOrder S; S.init(GT, D, gridDim.x, opaque_bid());
    pg8::EpiGate<false> E{(const bf16_t*)(ws + WS_Z) + ZC_GR, arg_in(I_BG) + l * 2048, (float*)(ws + WS_Y1), (bf16_t*)(ws + WS_MB)}; pg8::gemm_phase(lds, gm, S, E);
}
DI void ph_post2(LAS unsigned char* lds, int l) {
    unsigned char* ws = arg_ws();
    pg8::Gemm gm{(const bf16_t*)(ws + WS_DL), (const bf16_t*)(ws + WS_W + (size_t)l * LW + OW_DO), GT, D, 512}; pg8::StaticOrder S; S.init(GT, D, gridDim.x, opaque_bid());
    pg8::EpiGate<true> E{(const bf16_t*)(ws + WS_Z) + ZC_GD, arg_in(I_BG) + l * 2048 + 1024, (float*)(ws + WS_Y1), (bf16_t*)(ws + WS_MB)}; pg8::gemm_phase(lds, gm, S, E);
}
DI void ph_out(LAS unsigned char* lds, int l, int g) {
    unsigned char* ws = arg_ws(); const size_t rb = (size_t)g * GT;
    pg8::Gemm gm{(const bf16_t*)(ws + WS_MB), (const bf16_t*)(ws + WS_W + (size_t)l * LW + OW_OUT), GT, D, D}; pg8::StaticOrder S; S.init(GT, D, gridDim.x, opaque_bid());
    pg8::EpiRes E{arg_out() + rb * D, (bf16_t*)(ws + WS_XB) + rb * D, (float*)(ws + WS_SLOT) + rb * 16, 1.0f}; pg8::gemm_phase(lds, gm, S, E);
}
DI void ph_gu(LAS unsigned char* lds, int l, int half) {
    unsigned char* ws = arg_ws();
    pg8::Gemm gm{(const bf16_t*)(ws + WS_XB), (const bf16_t*)(ws + WS_W + (size_t)l * LW + (half ? OW_GU2 : OW_GU1)), NTOK, 5632, D}; pg8::StaticOrder S; S.init(NTOK, 5632, gridDim.x, opaque_bid());
    pg8::EpiSwiGLU E{(bf16_t*)(ws + WS_H), (const float*)(ws + WS_SLOT)}; pg8::gemm_phase(lds, gm, S, E);
}
DI void ph_down(LAS unsigned char* lds, int l, int half) {
    unsigned char* ws = arg_ws();
    pg8::Gemm gm{(const bf16_t*)(ws + WS_H), (const bf16_t*)(ws + WS_W + (size_t)l * LW + (half ? OW_D2 : OW_D1)), NTOK, D, FF}; pg8::StaticOrder S; S.init(NTOK, D, gridDim.x, opaque_bid());
    pg8::EpiRes E{arg_out(), (bf16_t*)(ws + WS_XB), (float*)(ws + WS_SLOT), 0.5f}; pg8::gemm_phase(lds, gm, S, E);
}

__global__ void __launch_bounds__(NTHREADS, 2) mega_fwd(Args a) {
    extern __shared__ __attribute__((aligned(16))) unsigned char lds_g[];
    LAS unsigned char* lds = (LAS unsigned char*)lds_g;
    cg::grid_group grid = cg::this_grid();
    volatile LAS unsigned* bst = (volatile LAS unsigned*)(lds + LDS_BYTES - 16);
    if (threadIdx.x < 4) bst[threadIdx.x] = 0u;
    __syncthreads();
    if (threadIdx.x == 0) (void)xb_add((unsigned*)arg_ws() + XB_XCNT(xb_xcc_id()), 1u);
#define GSYNC() xcd_barrier((unsigned*)arg_ws(), bst)
    if (PH(0)) prep_phase(lds);
    grid.sync();
#pragma unroll 1
    for (int l = 0; l < DEPTH; ++l) {
#pragma unroll 1
        for (int half = 0; half < 2; ++half) {
            if (half == 1) {
#pragma unroll 1
                for (int g = 0; g < NGRP; ++g) {
                    if (PH(1)) ph_win(lds, l, g);
                    GSYNC();
                    if (PH(2)) ret_kv_phase(l, lds_g, lds);
                    if (PH(3)) dil_attn_phase(l, lds_g, lds);
                    GSYNC();
                    if (PH(4)) scan_combine_phase(l);
                    GSYNC();
                    if (PH(5)) ret_out_phase(l, lds_g, lds);
                    GSYNC();
                    if (PH(6)) ph_post1(lds, l);
                    if (PH(7)) ph_post2(lds, l);
                    GSYNC();
                    if (PH(8)) ph_out(lds, l, g);
                }
                GSYNC();
            }
            if (PH(9)) ph_gu(lds, l, half);
            GSYNC();
            if (PH(10)) ph_down(lds, l, half);
            if (l != DEPTH - 1 || half != 1) GSYNC();
        }
    }
}

extern "C" void kernel_launch(void* const* d_in, const int* in_sizes, int n_in, void* d_out, int out_size, void* d_ws, size_t ws_size, hipStream_t stream) {
    static int grid = 0;
    if (grid == 0) {
        if (n_in != 20 || out_size != NTOK * D || ws_size < WS_H + (size_t)NTOK * FF * 2 || ws_size < WS_END) { fprintf(stderr, "kernel_launch: unexpected shapes / workspace (n_in %d out %d ws %zu)\n", n_in, out_size, ws_size); grid = -1; return; }
        int dev = 0, cus = 0, per_cu = 0;
        if (hipGetDevice(&dev) != hipSuccess || hipDeviceGetAttribute(&cus, hipDeviceAttributeMultiprocessorCount, dev) != hipSuccess) { grid = -1; return; }
        if (hipFuncSetAttribute((const void*)mega_fwd, hipFuncAttributeMaxDynamicSharedMemorySize, LDS_BYTES) != hipSuccess) { fprintf(stderr, "kernel_launch: hipFuncSetAttribute failed\n"); grid = -1; return; }
        if (hipOccupancyMaxActiveBlocksPerMultiprocessor(&per_cu, (const void*)mega_fwd, NTHREADS, LDS_BYTES) != hipSuccess || per_cu < 1) { fprintf(stderr, "kernel_launch: occupancy query failed (%d)\n", per_cu); (void)hipGetLastError(); per_cu = 1; }
        grid = cus * per_cu;
    }
    if (grid < 0) return;
    if (hipMemsetAsync(d_ws, 0, 16384, stream) != hipSuccess) { fprintf(stderr, "kernel_launch: memset failed\n"); return; }
    Args a{};
    for (int i = 0; i < 20; ++i) a.in[i] = (const float*)d_in[i];
    a.out = (float*)d_out; a.ws = (unsigned char*)d_ws;
    void* args[] = {&a};
    hipError_t e = hipLaunchCooperativeKernel((const void*)mega_fwd, dim3(grid), dim3(NTHREADS), args, LDS_BYTES, stream);
    if (e != hipSuccess) fprintf(stderr, "kernel_launch: cooperative launch failed: %s (grid %d)\n", hipGetErrorString(e), grid);
}
```

```cpp
#include <hip/hip_runtime.h>
#include <hip/hip_cooperative_groups.h>
#include <cstdio>
#include <cstdint>
namespace cg = cooperative_groups;

#define DI __device__ __forceinline__
#define LAS __attribute__((address_space(3)))
typedef unsigned short bf16_t;
typedef short bf16x8 __attribute__((ext_vector_type(8)));
typedef short s16x4 __attribute__((ext_vector_type(4)));
typedef float f32x4 __attribute__((ext_vector_type(4)));
typedef unsigned u32x4 __attribute__((ext_vector_type(4)));
typedef unsigned u32x2 __attribute__((ext_vector_type(2)));

constexpr int D = 1024, FF = 2816, SEQ = 4096, NBATCH = 16, NTOK = NBATCH * SEQ, DEPTH = 4, INW = 9728;
constexpr int GB = 4, GT = GB * SEQ, NGRP = NBATCH / GB;
constexpr int ZC_RQ = 0, ZC_RK = 512, ZC_RV = 1024, ZC_RG = 2048, ZC_DQ = 3072, ZC_DK = 4608, ZC_DV = 6144, ZC_GR = 7680, ZC_GD = 8704;
constexpr float EPS = 1e-6f;
constexpr int NTHREADS = 512;
constexpr int LDS_BYTES = 147456;

constexpr size_t MiB = 1u << 20;
constexpr size_t WS_ROPE = 1 * MiB;
constexpr size_t WS_BIAS = 3 * MiB;
constexpr size_t WS_SLOT = 4 * MiB;
constexpr size_t WS_W = 8 * MiB;
constexpr size_t OW_GU1 = 0, OW_D1 = OW_GU1 + (size_t)5632 * 1024 * 2, OW_IN = OW_D1 + (size_t)1024 * 2816 * 2, OW_RO = OW_IN + (size_t)INW * 1024 * 2,
                 OW_DO = OW_RO + (size_t)1024 * 1024 * 2, OW_OUT = OW_DO + (size_t)1024 * 512 * 2, OW_GU2 = OW_OUT + (size_t)1024 * 1024 * 2,
                 OW_D2 = OW_GU2 + (size_t)5632 * 1024 * 2, LW = OW_D2 + (size_t)1024 * 2816 * 2;
static_assert(LW == 57 * MiB, "layer weight bytes");
constexpr size_t WS_XB = WS_W + DEPTH * LW;
constexpr size_t WS_BIG = WS_XB + (size_t)NTOK * D * 2;
constexpr size_t WS_H = WS_BIG;
constexpr size_t WS_Z = WS_BIG;
constexpr size_t WS_KV = WS_Z + (size_t)GT * INW * 2;
constexpr size_t WS_Y1 = WS_KV;
constexpr size_t WS_MB = WS_KV + (size_t)GT * D * 4;
constexpr size_t WS_S = WS_KV + (size_t)512 * 2 * 32768 * 4;
constexpr size_t WS_R = WS_S + (size_t)512 * 2 * 32768 * 2;
constexpr size_t WS_DL = WS_R + (size_t)GT * 1024 * 2;
constexpr size_t WS_LSE = WS_DL + (size_t)GT * 512 * 2;
constexpr size_t WS_END = WS_LSE + (size_t)GT * 12 * 4;
static_assert(WS_H + (size_t)NTOK * FF * 2 <= ((size_t)1 << 30) && WS_END <= ((size_t)1 << 30), "workspace fits 1 GiB");

DI int opaque_tid() { int t = threadIdx.x; asm volatile("" : "+v"(t)); return t; }
DI int opaque_bid() { int t = blockIdx.x; asm volatile("" : "+s"(t)); return t; }
DI unsigned pk2(float lo, float hi) { unsigned r; asm("v_cvt_pk_bf16_f32 %0, %1, %2" : "=v"(r) : "v"(lo), "v"(hi)); return r; }
DI float bflo(unsigned u) { return __uint_as_float(u << 16); }
DI float bfhi(unsigned u) { return __uint_as_float(u & 0xffff0000u); }
DI float fexp2(float x) { return __builtin_amdgcn_exp2f(x); }
DI float frcp(float x) { return __builtin_amdgcn_rcpf(x); }
DI float fsigmoid(float x) { return frcp(1.0f + fexp2(-1.44269504f * x)); }
DI float fsilu(float x) { return x * fsigmoid(x); }
DI bf16x8 as_frag(u32x4 v) { return __builtin_bit_cast(bf16x8, v); }
DI f32x4 mfma16(bf16x8 a, bf16x8 b, f32x4 c) { return __builtin_amdgcn_mfma_f32_16x16x32_bf16(a, b, c, 0, 0, 0); }
DI bf16x8 tr_frag(unsigned a0, unsigned a1) {
    s16x4 lo, hi;
    asm volatile("ds_read_b64_tr_b16 %0, %2\n\tds_read_b64_tr_b16 %1, %3\n\ts_waitcnt lgkmcnt(0)" : "=&v"(lo), "=&v"(hi) : "v"(a0), "v"(a1) : "memory");
    bf16x8 r; r[0] = lo[0]; r[1] = lo[1]; r[2] = lo[2]; r[3] = lo[3]; r[4] = hi[0]; r[5] = hi[1]; r[6] = hi[2]; r[7] = hi[3]; return r;
}
DI void tr4(unsigned a0, unsigned a1, bf16x8& o0, bf16x8& o1, bf16x8& o2, bf16x8& o3) {
    s16x4 l0, l1, l2, l3, h0, h1, h2, h3;
    asm volatile(
        "ds_read_b64_tr_b16 %0, %8\n\tds_read_b64_tr_b16 %4, %9\n\t"
        "ds_read_b64_tr_b16 %1, %8 offset:32\n\tds_read_b64_tr_b16 %5, %9 offset:32\n\t"
        "ds_read_b64_tr_b16 %2, %8 offset:64\n\tds_read_b64_tr_b16 %6, %9 offset:64\n\t"
        "ds_read_b64_tr_b16 %3, %8 offset:96\n\tds_read_b64_tr_b16 %7, %9 offset:96\n\t"
        "s_waitcnt lgkmcnt(0)"
        : "=&v"(l0), "=&v"(l1), "=&v"(l2), "=&v"(l3), "=&v"(h0), "=&v"(h1), "=&v"(h2), "=&v"(h3)
        : "v"(a0), "v"(a1) : "memory");
#define TR_PACK(o, lo, hi) o[0] = lo[0]; o[1] = lo[1]; o[2] = lo[2]; o[3] = lo[3]; o[4] = hi[0]; o[5] = hi[1]; o[6] = hi[2]; o[7] = hi[3];
    TR_PACK(o0, l0, h0) TR_PACK(o1, l1, h1) TR_PACK(o2, l2, h2) TR_PACK(o3, l3, h3)
#undef TR_PACK
}
DI void tr8(unsigned a0, unsigned a1, bf16x8 (&out)[8]) {
    tr4(a0, a1, out[0], out[1], out[2], out[3]);
    tr4(a0 + 128u, a1 + 128u, out[4], out[5], out[6], out[7]);
}
DI float row_scale(const float* slots, int row, int fq) {
    const f32x4 s = *(const f32x4*)(slots + (size_t)row * 16 + 4 * fq);
    float t = (s[0] + s[1]) + (s[2] + s[3]);
    t += __shfl_xor(t, 16); t += __shfl_xor(t, 32);
    return __builtin_amdgcn_rsqf(t * (1.0f / D) + EPS);
}

namespace pg8 {
constexpr int BM = 256, BK = 64, HALF = 128, HTB = HALF * BK * 2, STAGE_BYTES = 8 * HTB, NXCD = 8, WGM = 4;
__host__ __device__ __forceinline__ int lds_byte(int r, int c) { const int st = (r >> 4) * 2 + (c >> 5), rr = r & 15, cc = c & 31, ob = rr * 64 + cc * 2; return st * 1024 + (ob ^ (((ob >> 9) & 1) << 5)); }
__host__ __device__ __forceinline__ void stage_rc(int b, int& R, int& C) { const int st = b / 1024, sb = b % 1024, swz = sb ^ (((sb >> 9) & 1) << 5); R = (st >> 1) * 16 + swz / 64; C = (st & 1) * 32 + (swz % 64) / 2; }
__host__ __device__ __forceinline__ int perm32(int rho) { const int n = rho >> 4, i = rho & 15; return 8 * (i >> 2) + 4 * n + (i & 3); }
struct Unit { int pm, pn; };
struct Gemm { const bf16_t* A; const bf16_t* Bt; int M, N, K; };
struct StaticOrder {
    int nM, nN, nwg, G, c;
    DI void init(int M, int N, int G_, int c_) { nM = M / BM; nN = N / BM; nwg = nM * nN; G = G_; c = c_; }
    DI bool next(int i, Unit& u) const {
        const long L = (long)i * G + c; if (L >= nwg) return false;
        int wgid = (int)L; { const int q = nwg / NXCD, r = nwg % NXCD, xcd = wgid % NXCD, off = wgid / NXCD; wgid = (xcd < r ? xcd * (q + 1) : r * (q + 1) + (xcd - r) * q) + off; }
        const int nig = WGM * nN, gid = wgid / nig, fm = gid * WGM, gsz = (nM - fm) < WGM ? (nM - fm) : WGM;
        u.pm = fm + ((wgid % nig) % gsz); u.pn = (wgid % nig) / gsz; return true;
    }
};
template <class Epi>
DI void gemm_phase(LAS unsigned char* lds, const Gemm g, const StaticOrder& S, const Epi& E) {
    const int tid = opaque_tid(), wid = __builtin_amdgcn_readfirstlane(tid >> 6), lane = tid & 63, wr = wid >> 2, wc = wid & 3, fr = lane & 15, fq = lane >> 4;
    const int K = g.K, nt = K / BK;
    unsigned voffA[2], voffB[2];
#pragma unroll
    for (int i = 0; i < 2; ++i) { int R, C; stage_rc(tid * 16 + i * 8192, R, C); const int Rb = Epi::PERM ? ((R & ~31) + perm32(R & 31)) : R;
        voffA[i] = (unsigned)(R * K + C) * 2u; voffB[i] = (unsigned)(Rb * K + C) * 2u; }
    const size_t kstep = (size_t)(BK * 2);
    const size_t hstep = (size_t)HALF * K * 2;
    const size_t tstep = 2 * hstep;
    const unsigned ldsw = (unsigned)wid * 1024u;
    const int aoff = lds_byte(wr * 64 + fr, fq * 8), boff = lds_byte(wc * 32 + fr, fq * 8);
#define PG8_SA(b, h) (((b) * 2 + (h)) * HTB)
#define PG8_SB(b, h) ((4 + (b) * 2 + (h)) * HTB)
#define PG8_STAGE(bufoff, gbase, voff) do { _Pragma("unroll") for (int _i = 0; _i < 2; ++_i) \
        __builtin_amdgcn_global_load_lds((const unsigned*)((const char*)(gbase) + (voff)[_i]), (LAS unsigned*)(lds + (bufoff) + ldsw + _i * 8192), 16, 0, 0); } while (0)
#define PG8_LDA(dst, b, h) do { _Pragma("unroll") for (int m = 0; m < 4; ++m) _Pragma("unroll") for (int k = 0; k < 2; ++k) dst[m][k] = *(const LAS bf16x8*)(lds + PG8_SA(b, h) + aoff + m * 2048 + k * 1024); } while (0)
#define PG8_LDB(dst, b, h) do { _Pragma("unroll") for (int n = 0; n < 2; ++n) _Pragma("unroll") for (int k = 0; k < 2; ++k) dst[n][k] = *(const LAS bf16x8*)(lds + PG8_SB(b, h) + boff + n * 2048 + k * 1024); } while (0)
#define PG8_MMA(ai, bj, At, Bt) do { __builtin_amdgcn_s_setprio(1); _Pragma("unroll") for (int m = 0; m < 4; ++m) _Pragma("unroll") for (int n = 0; n < 2; ++n) _Pragma("unroll") for (int k = 0; k < 2; ++k) \
        acc[ai][bj][m][n] = __builtin_amdgcn_mfma_f32_16x16x32_bf16(Bt[n][k], At[m][k], acc[ai][bj][m][n], 0, 0, 0); __builtin_amdgcn_s_setprio(0); } while (0)
#define PG8_WAIT_V(n) asm volatile("s_waitcnt vmcnt(" #n ")" ::: "memory")
#define PG8_WAIT_L(n) asm volatile("s_waitcnt lgkmcnt(" #n ")" ::: "memory")
#define PG8_BAR __builtin_amdgcn_s_barrier()
#define PG8_SCHED __builtin_amdgcn_sched_barrier(0)
    Unit cur, nxt; int ui = 0;
    if (!S.next(0, cur)) return;
    f32x4 acc[2][2][4][2];
#pragma unroll
    for (int a = 0; a < 2; ++a)
#pragma unroll
        for (int b = 0; b < 2; ++b)
#pragma unroll
            for (int m = 0; m < 4; ++m)
#pragma unroll
                for (int n = 0; n < 2; ++n) acc[a][b][m][n] = (f32x4){0.f, 0.f, 0.f, 0.f};
    bf16x8 At[4][2], B0[2][2], B1[2][2];
    const char* cA = (const char*)g.A + (size_t)cur.pm * tstep; const char* cB = (const char*)g.Bt + (size_t)cur.pn * tstep;
    PG8_STAGE(PG8_SB(0, 0), cB, voffB); PG8_STAGE(PG8_SB(0, 1), cB + hstep, voffB); PG8_STAGE(PG8_SA(0, 0), cA, voffA); PG8_STAGE(PG8_SA(0, 1), cA + hstep, voffA);
    if (wr == 1) PG8_BAR;
    PG8_WAIT_V(2); PG8_BAR;
    PG8_STAGE(PG8_SB(1, 0), cB + kstep, voffB); PG8_STAGE(PG8_SA(1, 0), cA + kstep, voffA); PG8_STAGE(PG8_SB(1, 1), cB + hstep + kstep, voffB);
    PG8_WAIT_V(6); PG8_BAR;
    for (;;) {
        const bool has_next = S.next(ui + 1, nxt);
        const char* nA = has_next ? (const char*)g.A + (size_t)nxt.pm * tstep : cA; const char* nB = has_next ? (const char*)g.Bt + (size_t)nxt.pn * tstep : cB;
        for (int t = 0; t < nt; t += 2) {
            const bool last = (t == nt - 2);
            const char* a1 = cA + (size_t)(t + 1) * kstep;
            const char* a2 = last ? nA : cA + (size_t)(t + 2) * kstep; const char* b2 = last ? nB : cB + (size_t)(t + 2) * kstep;
            const char* a3 = a2 + kstep; const char* b3 = b2 + kstep;
            PG8_LDB(B0, 0, 0); PG8_LDB(B1, 0, 1); PG8_SCHED; PG8_LDA(At, 0, 0); PG8_STAGE(PG8_SA(1, 1), a1 + hstep, voffA);
            PG8_WAIT_V(8); PG8_WAIT_L(0); PG8_BAR; PG8_MMA(0, 0, At, B0); PG8_MMA(0, 1, At, B1); PG8_BAR; PG8_SCHED;
            PG8_LDA(At, 0, 1); PG8_STAGE(PG8_SB(0, 0), b2, voffB); PG8_STAGE(PG8_SB(0, 1), b2 + hstep, voffB); PG8_STAGE(PG8_SA(0, 0), a2, voffA);
            PG8_WAIT_V(8); PG8_WAIT_L(0); PG8_BAR; PG8_MMA(1, 0, At, B0); PG8_MMA(1, 1, At, B1); PG8_BAR; PG8_SCHED;
            PG8_LDB(B0, 1, 0); PG8_LDB(B1, 1, 1); PG8_SCHED; PG8_LDA(At, 1, 0); PG8_STAGE(PG8_SA(0, 1), a2 + hstep, voffA);
            PG8_WAIT_V(8); PG8_WAIT_L(0); PG8_BAR; PG8_MMA(0, 0, At, B0); PG8_MMA(0, 1, At, B1); PG8_BAR; PG8_SCHED;
            PG8_LDA(At, 1, 1); PG8_STAGE(PG8_SB(1, 0), b3, voffB); PG8_STAGE(PG8_SB(1, 1), b3 + hstep, voffB); PG8_STAGE(PG8_SA(1, 0), a3, voffA);
            PG8_WAIT_V(8); PG8_WAIT_L(0); PG8_BAR; PG8_MMA(1, 0, At, B0); PG8_MMA(1, 1, At, B1); PG8_BAR; PG8_SCHED;
        }
        if (wr == 0) PG8_BAR;
        E(acc, cur, wr, wc, fr, fq);
        if (!has_next) break;
#pragma unroll
        for (int a = 0; a < 2; ++a)
#pragma unroll
            for (int b = 0; b < 2; ++b)
#pragma unroll
                for (int m = 0; m < 4; ++m)
#pragma unroll
                    for (int n = 0; n < 2; ++n) acc[a][b][m][n] = (f32x4){0.f, 0.f, 0.f, 0.f};
        cur = nxt; cA = nA; cB = nB; ++ui;
        if (wr == 1) PG8_BAR;
    }
    PG8_WAIT_V(0);
    PG8_BAR;
#undef PG8_SA
#undef PG8_SB
#undef PG8_STAGE
#undef PG8_LDA
#undef PG8_LDB
#undef PG8_MMA
#undef PG8_WAIT_V
#undef PG8_WAIT_L
#undef PG8_BAR
#undef PG8_SCHED
}

struct EpiSwiGLU {
    static constexpr bool PERM = true;
    bf16_t* H; const float* slots;
    DI void operator()(const f32x4 (&acc)[2][2][4][2], const Unit& u, int wr, int wc, int fr, int fq) const {
        const int col0 = u.pn * 128 + wc * 32 + 8 * fq;
        const int rowb = u.pm * BM + wr * 64 + fr;
        f32x4 sl[2][4];
#pragma unroll
        for (int ai = 0; ai < 2; ++ai)
#pragma unroll
            for (int m = 0; m < 4; ++m) sl[ai][m] = *(const f32x4*)(slots + (size_t)(rowb + ai * HALF + m * 16) * 16 + 4 * fq);
        asm volatile("" ::: "memory");
#pragma unroll
        for (int ai = 0; ai < 2; ++ai)
#pragma unroll
            for (int m = 0; m < 4; ++m) {
                const int row = rowb + ai * HALF + m * 16;
                float t = (sl[ai][m][0] + sl[ai][m][1]) + (sl[ai][m][2] + sl[ai][m][3]);
                t += __shfl_xor(t, 16); t += __shfl_xor(t, 32);
                const float rs = __builtin_amdgcn_rsqf(t * (1.0f / D) + EPS);
                float h[8];
#pragma unroll
                for (int n = 0; n < 2; ++n)
#pragma unroll
                    for (int j = 0; j < 4; ++j) { const float gv = acc[ai][0][m][n][j] * rs, uv = acc[ai][1][m][n][j] * rs; h[n * 4 + j] = fsilu(gv) * uv; }
                u32x4 w; w.x = pk2(h[0], h[1]); w.y = pk2(h[2], h[3]); w.z = pk2(h[4], h[5]); w.w = pk2(h[6], h[7]);
                *(u32x4*)(H + (size_t)row * FF + col0) = w;
            }
    }
};
struct EpiRes {
    static constexpr bool PERM = false;
    float* x; bf16_t* xb; float* slots; float s;
    DI void operator()(const f32x4 (&acc)[2][2][4][2], const Unit& u, int wr, int wc, int fr, int fq) const {
        const int col0 = u.pn * BM + wc * 32 + 4 * fq;
#pragma unroll
        for (int ai = 0; ai < 2; ++ai) {
            const int rowa = u.pm * BM + ai * HALF + wr * 64 + fr;
            f32x4 xo[4][2][2];
#pragma unroll
            for (int m = 0; m < 4; ++m)
#pragma unroll
                for (int bj = 0; bj < 2; ++bj)
#pragma unroll
                    for (int n = 0; n < 2; ++n) xo[m][bj][n] = *(const f32x4*)(x + (size_t)(rowa + m * 16) * D + col0 + bj * HALF + n * 16);
            asm volatile("" ::: "memory");
#pragma unroll
            for (int m = 0; m < 4; ++m) {
                const int row = rowa + m * 16;
                float* xr = x + (size_t)row * D + col0; bf16_t* br = xb + (size_t)row * D + col0;
                float ss = 0.f;
#pragma unroll
                for (int bj = 0; bj < 2; ++bj)
#pragma unroll
                    for (int n = 0; n < 2; ++n) {
                        const f32x4 xn = xo[m][bj][n] + acc[ai][bj][m][n] * s;
                        *(f32x4*)(xr + bj * HALF + n * 16) = xn;
                        u32x2 w; w.x = pk2(xn[0], xn[1]); w.y = pk2(xn[2], xn[3]);
                        *(u32x2*)(br + bj * HALF + n * 16) = w;
                        ss += (xn[0] * xn[0] + xn[1] * xn[1]) + (xn[2] * xn[2] + xn[3] * xn[3]);
                    }
                ss += __shfl_xor(ss, 16); ss += __shfl_xor(ss, 32);
                if (fq == 0) slots[(size_t)row * 16 + u.pn * 4 + wc] = ss;
            }
            asm volatile("" ::: "memory");
        }
    }
};
struct EpiZ {
    static constexpr bool PERM = true;
    bf16_t* Z; const float* slots; const float* cs; const float* sn;
    DI void operator()(const f32x4 (&acc)[2][2][4][2], const Unit& u, int wr, int wc, int fr, int fq) const {
        const int col0 = u.pn * BM + wc * 32 + 8 * fq;
        const bool rope = u.pn < 4; const float ksc = (u.pn >= 2) ? 0.08838834764831845f : 1.0f;
        const int fi = 4 * (4 * wc + fq);
        const int rowb = u.pm * BM + wr * 64 + fr;
        f32x4 sl[2][4];
#pragma unroll
        for (int ai = 0; ai < 2; ++ai)
#pragma unroll
            for (int m = 0; m < 4; ++m) sl[ai][m] = *(const f32x4*)(slots + (size_t)(rowb + ai * HALF + m * 16) * 16 + 4 * fq);
        asm volatile("" ::: "memory");
#pragma unroll
        for (int ai = 0; ai < 2; ++ai) {
            f32x4 c4[4], s4[4];
#pragma unroll
            for (int m = 0; m < 4; ++m) { c4[m] = (f32x4){1.f, 1.f, 1.f, 1.f}; s4[m] = (f32x4){0.f, 0.f, 0.f, 0.f}; }
            if (rope) {
#pragma unroll
                for (int m = 0; m < 4; ++m) { const int pos = (rowb + ai * HALF + m * 16) & (SEQ - 1); c4[m] = *(const f32x4*)(cs + pos * 64 + fi); s4[m] = *(const f32x4*)(sn + pos * 64 + fi); }
            }
            asm volatile("" ::: "memory");
#pragma unroll
            for (int m = 0; m < 4; ++m) {
                const int row = rowb + ai * HALF + m * 16;
                float t = (sl[ai][m][0] + sl[ai][m][1]) + (sl[ai][m][2] + sl[ai][m][3]);
                t += __shfl_xor(t, 16); t += __shfl_xor(t, 32);
                const float rs = __builtin_amdgcn_rsqf(t * (1.0f / D) + EPS);
#pragma unroll
                for (int bj = 0; bj < 2; ++bj) {
                    f32x4 v0 = acc[ai][bj][m][0] * rs, v1 = acc[ai][bj][m][1] * rs;
                    if (rope) { const f32x4 o0 = (v0 * c4[m] - v1 * s4[m]) * ksc, o1 = (v0 * s4[m] + v1 * c4[m]) * ksc; v0 = o0; v1 = o1; }
                    u32x4 w; w.x = pk2(v0[0], v0[1]); w.y = pk2(v0[2], v0[3]); w.z = pk2(v1[0], v1[1]); w.w = pk2(v1[2], v1[3]);
                    *(u32x4*)(Z + (size_t)row * INW + col0 + bj * HALF) = w;
                }
            }
            asm volatile("" ::: "memory");
        }
    }
};
template <bool SECOND> struct EpiGate {
    static constexpr bool PERM = true;
    const bf16_t* Zg; const float* bg; float* Y1; bf16_t* Mb;
    DI void operator()(const f32x4 (&acc)[2][2][4][2], const Unit& u, int wr, int wc, int fr, int fq) const {
        const int col0 = u.pn * BM + wc * 32 + 8 * fq;
        const int rowb = u.pm * BM + wr * 64 + fr;
        f32x4 bb[2][2];
#pragma unroll
        for (int bj = 0; bj < 2; ++bj) { bb[bj][0] = *(const f32x4*)(bg + col0 + bj * HALF); bb[bj][1] = *(const f32x4*)(bg + col0 + bj * HALF + 4); }
#pragma unroll
        for (int ai = 0; ai < 2; ++ai)
#pragma unroll
            for (int mp = 0; mp < 2; ++mp) {
                u32x4 zg[2][2]; f32x4 y0[2][2], y1[2][2];
#pragma unroll
                for (int mm = 0; mm < 2; ++mm)
#pragma unroll
                    for (int bj = 0; bj < 2; ++bj) { const int row = rowb + ai * HALF + (2 * mp + mm) * 16, col = col0 + bj * HALF;
                        zg[mm][bj] = *(const u32x4*)(Zg + (size_t)row * INW + col);
                        if (SECOND) { y0[mm][bj] = *(const f32x4*)(Y1 + (size_t)row * D + col); y1[mm][bj] = *(const f32x4*)(Y1 + (size_t)row * D + col + 4); } }
                asm volatile("" ::: "memory");
#pragma unroll
                for (int mm = 0; mm < 2; ++mm)
#pragma unroll
                    for (int bj = 0; bj < 2; ++bj) { const int m = 2 * mp + mm; const int row = rowb + ai * HALF + m * 16, col = col0 + bj * HALF;
                        const u32x4 z = zg[mm][bj]; const f32x4 b0 = bb[bj][0], b1 = bb[bj][1];
                        f32x4 g0, g1;
                        g0[0] = fsigmoid(bflo(z.x) + b0[0]); g0[1] = fsigmoid(bfhi(z.x) + b0[1]); g0[2] = fsigmoid(bflo(z.y) + b0[2]); g0[3] = fsigmoid(bfhi(z.y) + b0[3]);
                        g1[0] = fsigmoid(bflo(z.z) + b1[0]); g1[1] = fsigmoid(bfhi(z.z) + b1[1]); g1[2] = fsigmoid(bflo(z.w) + b1[2]); g1[3] = fsigmoid(bfhi(z.w) + b1[3]);
                        f32x4 v0 = g0 * acc[ai][bj][m][0], v1 = g1 * acc[ai][bj][m][1];
                        if (!SECOND) { float* yp = Y1 + (size_t)row * D + col; *(f32x4*)yp = v0; *(f32x4*)(yp + 4) = v1; }
                        else { v0 += y0[mm][bj]; v1 += y1[mm][bj];
                            u32x4 w; w.x = pk2(v0[0], v0[1]); w.y = pk2(v0[2], v0[3]); w.z = pk2(v1[0], v1[1]); w.w = pk2(v1[2], v1[3]);
                            *(u32x4*)(Mb + (size_t)row * D + col) = w; } }
                asm volatile("" ::: "memory");
            }
    }
};
}

struct Args { const float* in[20]; float* out; unsigned char* ws; };
typedef void* const __attribute__((address_space(4)))* kargp_t;
DI void* karg(int i) { kargp_t p = (kargp_t)__builtin_amdgcn_kernarg_segment_ptr(); asm volatile("" : "+s"(p)); return p[i]; }
DI const float* arg_in(int i) { return (const float*)karg(i); }
DI float* arg_out() { return (float*)karg(20); }
DI unsigned char* arg_ws() { return (unsigned char*)karg(21); }
enum { I_X = 0, I_RELB, I_NF1, I_G1, I_U1, I_D1, I_NMIX, I_WIN, I_BG, I_DEC, I_RNORM, I_WRO, I_QN, I_KN, I_WDO, I_WOUT, I_NF2, I_G2, I_U2, I_D2 };

DI int sigma_rope(int p) { return ((p & 4) ? 64 : 0) + 4 * (p >> 3) + (p & 3); }
DI void conv_item(int kind, const float* src, const float* src2, int ldsrc, const float* gain, int K, int N, bf16_t* Bt, LAS float* scr, int item, int lane) {
    const int nblk = N / 32, kb = item / nblk, nb = item % nblk, k0 = 64 * kb, n0 = 32 * nb;
    const int n = n0 + (lane & 31);
    const float* sp;
    if (kind == 1) { const int tile = n >> 8, r = n & 255; sp = (r < 128 ? src : src2) + tile * 128 + (r & 127); }
    else if (kind == 2) { sp = src + (n < 1024 ? (n & ~127) + sigma_rope(n & 127) : n); }
    else sp = src + n;
    float vv[32];
#pragma unroll
    for (int i = 0; i < 32; ++i) { const int kk = 2 * i + (lane >> 5); vv[i] = sp[(size_t)(k0 + kk) * ldsrc]; }
    if (gain) {
#pragma unroll
        for (int i = 0; i < 32; ++i) { const int kk = 2 * i + (lane >> 5); vv[i] *= gain[k0 + kk]; } }
#pragma unroll
    for (int i = 0; i < 32; ++i) { const int kk = 2 * i + (lane >> 5); scr[kk * 33 + (lane & 31)] = vv[i]; }
    asm volatile("s_waitcnt lgkmcnt(0)" ::: "memory");
    const int c = lane & 7;
#pragma unroll
    for (int j = 0; j < 4; ++j) { const int nn = (lane >> 3) + 8 * j; const LAS float* s = scr + (8 * c) * 33 + nn;
        u32x4 o; o.x = pk2(s[0 * 33], s[1 * 33]); o.y = pk2(s[2 * 33], s[3 * 33]); o.z = pk2(s[4 * 33], s[5 * 33]); o.w = pk2(s[6 * 33], s[7 * 33]);
        *(u32x4*)(Bt + (size_t)(n0 + nn) * K + k0 + 8 * c) = o; }
    asm volatile("s_waitcnt lgkmcnt(0)" ::: "memory");
}
DI int t5_bucket(int rel) {
    const int n = rel < 0 ? -rel : rel; int ret = rel > 0 ? 16 : 0;
    const float nf = (float)(n < 1 ? 1 : n);
    int large = 8 + (int)(logf(nf / 8.0f) / logf(128.0f) * 8.0f);
    large = large < 15 ? large : 15;
    return ret + (n < 8 ? n : large);
}
DI void prep_phase(LAS unsigned char* lds) {
    const int tid = opaque_tid(), lane = tid & 63, wave = tid >> 6;
    const int gw = opaque_bid() * 8 + wave, NGW = gridDim.x * 8;
    const int gt = opaque_bid() * NTHREADS + tid, NGT = gridDim.x * NTHREADS;
    unsigned char* ws = arg_ws();
    {
        bf16_t* xb = (bf16_t*)(ws + WS_XB); float* slots = (float*)(ws + WS_SLOT);
        for (int row = gw; row < NTOK; row += NGW) {
            const f32x4* xr = (const f32x4*)(arg_in(I_X) + (size_t)row * D) + lane;
            f32x4* orow = (f32x4*)(arg_out() + (size_t)row * D) + lane;
            u32x2* brow = (u32x2*)(xb + (size_t)row * D) + lane;
            float ss = 0.f;
#pragma unroll
            for (int j = 0; j < 4; ++j) { const f32x4 v = xr[64 * j]; orow[64 * j] = v; u32x2 w; w.x = pk2(v[0], v[1]); w.y = pk2(v[2], v[3]); brow[64 * j] = w;
                ss += (v[0] * v[0] + v[1] * v[1]) + (v[2] * v[2] + v[3] * v[3]); }
#pragma unroll
            for (int o = 1; o < 64; o <<= 1) ss += __shfl_xor(ss, o);
            if (lane < 16) slots[(size_t)row * 16 + lane] = lane == 0 ? ss : 0.f;
        }
    }
    {
        float* cs = (float*)(ws + WS_ROPE); float* sn = cs + SEQ * 64;
        for (int i = gt; i < SEQ * 64; i += NGT) { const int pos = i >> 6, f = i & 63;
            const float inv = powf(10000.0f, -(float)f / 64.0f); const float ang = (float)pos * inv; cs[i] = cosf(ang); sn[i] = sinf(ang); }
    }
    {
        float* bt = (float*)(ws + WS_BIAS);
        for (int i = gt; i < 12 * 129; i += NGT) { const int hh = i / 129, dl = i % 129 - 64; const int gi = hh >> 2, d = gi == 0 ? 1 : (gi == 1 ? 4 : 16);
            bt[i] = arg_in(I_RELB)[t5_bucket(dl * d) * 12 + hh]; }
    }
    {
        LAS float* scr = (LAS float*)(lds + wave * 16384);
        constexpr int I_GU = 16 * 176, I_DN = 44 * 32, I_IN = 16 * 304, I_RO = 16 * 32, I_DO = 8 * 32, I_OU = 16 * 32;
        constexpr int PER_LAYER = 2 * I_GU + 2 * I_DN + I_IN + I_RO + I_DO + I_OU;
        for (int it = gw; it < DEPTH * PER_LAYER; it += NGW) {
            const int l = it / PER_LAYER; int r = it % PER_LAYER;
            unsigned char* wl = ws + WS_W + (size_t)l * LW;
            if (r < I_GU) { conv_item(1, arg_in(I_G1) + (size_t)l * D * FF, arg_in(I_U1) + (size_t)l * D * FF, FF, arg_in(I_NF1) + l * D, D, 5632, (bf16_t*)(wl + OW_GU1), scr, r, lane); continue; } r -= I_GU;
            if (r < I_GU) { conv_item(1, arg_in(I_G2) + (size_t)l * D * FF, arg_in(I_U2) + (size_t)l * D * FF, FF, arg_in(I_NF2) + l * D, D, 5632, (bf16_t*)(wl + OW_GU2), scr, r, lane); continue; } r -= I_GU;
            if (r < I_DN) { conv_item(0, arg_in(I_D1) + (size_t)l * FF * D, nullptr, D, nullptr, FF, D, (bf16_t*)(wl + OW_D1), scr, r, lane); continue; } r -= I_DN;
            if (r < I_DN) { conv_item(0, arg_in(I_D2) + (size_t)l * FF * D, nullptr, D, nullptr, FF, D, (bf16_t*)(wl + OW_D2), scr, r, lane); continue; } r -= I_DN;
            if (r < I_IN) { conv_item(2, arg_in(I_WIN) + (size_t)l * D * INW, nullptr, INW, arg_in(I_NMIX) + l * D, D, INW, (bf16_t*)(wl + OW_IN), scr, r, lane); continue; } r -= I_IN;
            if (r < I_RO) { conv_item(0, arg_in(I_WRO) + (size_t)l * D * D, nullptr, D, nullptr, D, D, (bf16_t*)(wl + OW_RO), scr, r, lane); continue; } r -= I_RO;
            if (r < I_DO) { conv_item(0, arg_in(I_WDO) + (size_t)l * 512 * D, nullptr, D, nullptr, 512, D, (bf16_t*)(wl + OW_DO), scr, r, lane); continue; } r -= I_DO;
            conv_item(0, arg_in(I_WOUT) + (size_t)l * D * D, nullptr, D, nullptr, D, D, (bf16_t*)(wl + OW_OUT), scr, r, lane);
        }
    }
}

constexpr int RV_PITCH = 528, RK_PITCH = 272;
DI void ret_kv_phase(int l, unsigned char* lds_g, LAS unsigned char* lds) {
    const int tid = opaque_tid(), lane = tid & 63, w = tid >> 6, fr = lane & 15, fq = lane >> 4;
    const unsigned lbase = (unsigned)(size_t)lds_g;
    const bf16_t* Z = (const bf16_t*)(arg_ws() + WS_Z); bf16_t* KV = (bf16_t*)(arg_ws() + WS_KV);
    constexpr int OV = 0, OKF = 128 * RV_PITCH, OKB = OKF + 128 * RK_PITCH;
    for (int item = opaque_bid(); item < GB * 4 * 32; item += gridDim.x) {
        const int n = item & 31, h = (item >> 5) & 3, bl = item >> 7;
        const size_t row0 = (size_t)bl * SEQ + n * 128;
        const float de_f = arg_in(I_DEC)[(l * 2 + 0) * 4 + h], de_b = arg_in(I_DEC)[(l * 2 + 1) * 4 + h];
        const float l2f = log1pf(-exp2f(-de_f)) * 1.44269504f, l2b = log1pf(-exp2f(-de_b)) * 1.44269504f;
#pragma unroll
        for (int i = 0; i < 8; ++i) { const int id = tid + 512 * i, r = id >> 5, ch = id & 31;
            const u32x4 v = *(const u32x4*)(Z + (row0 + r) * INW + ZC_RV + h * 256 + ch * 8);
            *(LAS u32x4*)(lds + OV + r * RV_PITCH + ch * 16) = v; }
#pragma unroll
        for (int i = 0; i < 4; ++i) { const int id = tid + 512 * i, r = id >> 4, ch = id & 15;
            const u32x4 v = *(const u32x4*)(Z + (row0 + r) * INW + ZC_RK + h * 128 + ch * 8);
            const float sf = fexp2(l2f * (float)(127 - r)), sb = fexp2(l2b * (float)r);
            u32x4 f, b;
            f.x = pk2(bflo(v.x) * sf, bfhi(v.x) * sf); f.y = pk2(bflo(v.y) * sf, bfhi(v.y) * sf); f.z = pk2(bflo(v.z) * sf, bfhi(v.z) * sf); f.w = pk2(bflo(v.w) * sf, bfhi(v.w) * sf);
            b.x = pk2(bflo(v.x) * sb, bfhi(v.x) * sb); b.y = pk2(bflo(v.y) * sb, bfhi(v.y) * sb); b.z = pk2(bflo(v.z) * sb, bfhi(v.z) * sb); b.w = pk2(bflo(v.w) * sb, bfhi(v.w) * sb);
            *(LAS u32x4*)(lds + OKF + r * RK_PITCH + ch * 16) = f; *(LAS u32x4*)(lds + OKB + r * RK_PITCH + ch * 16) = b; }
        __syncthreads();
        f32x4 acc[2][8][2];
#pragma unroll
        for (int d = 0; d < 2; ++d)
#pragma unroll
            for (int mt = 0; mt < 8; ++mt)
#pragma unroll
                for (int nt = 0; nt < 2; ++nt) acc[d][mt][nt] = (f32x4){0.f, 0.f, 0.f, 0.f};
        const int q = fr >> 2, p = fr & 3;
#pragma unroll 1
        for (int ks = 0; ks < 4; ++ks) {
            const int tr0 = 32 * ks + 8 * fq + q;
            bf16x8 Bv[2];
#pragma unroll
            for (int nt = 0; nt < 2; ++nt) { const unsigned ad = lbase + OV + tr0 * RV_PITCH + (32 * w + 16 * nt + 4 * p) * 2; Bv[nt] = tr_frag(ad, ad + 4 * RV_PITCH); }
#pragma unroll
            for (int d = 0; d < 2; ++d) { const unsigned ad = lbase + (d ? OKB : OKF) + tr0 * RK_PITCH + (4 * p) * 2; bf16x8 Ak[8]; tr8(ad, ad + 4 * RK_PITCH, Ak);
#pragma unroll
                for (int mt = 0; mt < 8; ++mt)
#pragma unroll
                    for (int nt = 0; nt < 2; ++nt) acc[d][mt][nt] = mfma16(Ak[mt], Bv[nt], acc[d][mt][nt]); }
        }
#pragma unroll
        for (int d = 0; d < 2; ++d)
#pragma unroll
            for (int nt = 0; nt < 2; ++nt)
#pragma unroll
                for (int mt = 0; mt < 8; ++mt)
                    { u32x2 o; o.x = pk2(acc[d][mt][nt][0], acc[d][mt][nt][1]); o.y = pk2(acc[d][mt][nt][2], acc[d][mt][nt][3]);
                      *(u32x2*)(KV + (((size_t)item * 2 + d) * 256 + 32 * w + 16 * nt + fr) * 128 + 16 * mt + 4 * fq) = o; }
        __syncthreads();
    }
}

struct DilIt { int hh, d, L, i0; size_t rowb; };
DI DilIt dil_decode(int item) {
    DilIt it; const int blk = item & 31; it.hh = (item >> 5) % 12; const int bl = item / (32 * 12);
    const int gi = it.hh >> 2; it.d = gi == 0 ? 1 : (gi == 1 ? 4 : 16); it.L = SEQ / it.d; const int bpc = it.L / 128;
    const int r = blk / bpc, qb = blk % bpc; it.i0 = 128 * qb; it.rowb = (size_t)bl * SEQ + r; return it;
}
DI void dil_issue(const bf16_t* Z, const DilIt& it, int tid, u32x4 (&kraw)[8], u32x4 (&vraw)[8]) {
#pragma unroll
    for (int i = 0; i < 8; ++i) { const int id = tid + 512 * i, kk = id >> 4, ch = id & 15; const int j = it.i0 - 64 + kk; const bool ok = (j >= 0) && (j < it.L);
        kraw[i] = (u32x4){0u, 0u, 0u, 0u}; vraw[i] = (u32x4){0u, 0u, 0u, 0u};
        if (ok) { const bf16_t* zr = Z + (it.rowb + (size_t)j * it.d) * INW; kraw[i] = *(const u32x4*)(zr + ZC_DK + it.hh * 128 + ch * 8); vraw[i] = *(const u32x4*)(zr + ZC_DV + it.hh * 128 + ch * 8); } }
}
DI void dil_issue_q(const bf16_t* Z, const DilIt& it, int w, int fr, int fq, u32x4 (&qraw)[4]) {
    const size_t qrow = it.rowb + (size_t)(it.i0 + 16 * w + fr) * it.d;
#pragma unroll
    for (int ks = 0; ks < 4; ++ks) qraw[ks] = *(const u32x4*)(Z + qrow * INW + ZC_DQ + it.hh * 128 + 32 * ks + 8 * fq);
}
template <bool STORE = true> DI void dil_attn_phase(int l, unsigned char* lds_g, LAS unsigned char* lds) {
    const int tid = opaque_tid(), lane = tid & 63, w = tid >> 6, fr = lane & 15, fq = lane >> 4;
    const unsigned lbase = (unsigned)(size_t)lds_g;
    bf16_t* Z = (bf16_t*)(arg_ws() + WS_Z); float* LSE = (float*)(arg_ws() + WS_LSE);
    const float* bt = (const float*)(arg_ws() + WS_BIAS);
    const float* qn = arg_in(I_QN) + l * 128; const float* kn = arg_in(I_KN) + l * 128;
    constexpr int KP = 272, OK = 0, OV = 256 * KP, OB = 2 * 256 * KP, NITEM = GB * 12 * 32;
    int item = opaque_bid();
    if (item >= NITEM) return;
    u32x4 kraw[8], vraw[8];
    DilIt it = dil_decode(item);
    dil_issue(Z, it, tid, kraw, vraw);
    for (;;) {
        const int hh = it.hh, d = it.d, L = it.L, i0 = it.i0; const size_t rowb = it.rowb;
        u32x4 qraw[4]; dil_issue_q(Z, it, w, fr, fq, qraw);
#pragma unroll
        for (int i = 0; i < 8; ++i) { const int id = tid + 512 * i, kk = id >> 4, ch = id & 15;
            const u32x4 kv = kraw[i];
            float f[8] = {bflo(kv.x), bfhi(kv.x), bflo(kv.y), bfhi(kv.y), bflo(kv.z), bfhi(kv.z), bflo(kv.w), bfhi(kv.w)};
            float ss = 0.f;
#pragma unroll
            for (int e = 0; e < 8; ++e) ss += f[e] * f[e];
            ss += __shfl_xor(ss, 1); ss += __shfl_xor(ss, 2); ss += __shfl_xor(ss, 4); ss += __shfl_xor(ss, 8);
            const float rs = __builtin_amdgcn_rsqf(ss * (1.0f / 128.0f) + EPS);
            const f32x4 g0 = *(const f32x4*)(kn + ch * 8), g1 = *(const f32x4*)(kn + ch * 8 + 4);
            u32x4 ko; ko.x = pk2(f[0] * rs * g0[0], f[1] * rs * g0[1]); ko.y = pk2(f[2] * rs * g0[2], f[3] * rs * g0[3]); ko.z = pk2(f[4] * rs * g1[0], f[5] * rs * g1[1]); ko.w = pk2(f[6] * rs * g1[2], f[7] * rs * g1[3]);
            *(LAS u32x4*)(lds + OK + kk * KP + ch * 16) = ko; *(LAS u32x4*)(lds + OV + kk * KP + ch * 16) = vraw[i];
            asm volatile("" ::: "memory"); }
        if (tid < 129) *(LAS float*)(lds + OB + tid * 4) = bt[hh * 129 + tid];
        const size_t qrow = rowb + (size_t)(i0 + 16 * w + fr) * d;
        bf16x8 Qf[4];
        {
            float ss = 0.f;
#pragma unroll
            for (int ks = 0; ks < 4; ++ks) { const u32x4 v = qraw[ks];
                ss += bflo(v.x) * bflo(v.x) + bfhi(v.x) * bfhi(v.x) + bflo(v.y) * bflo(v.y) + bfhi(v.y) * bfhi(v.y) + bflo(v.z) * bflo(v.z) + bfhi(v.z) * bfhi(v.z) + bflo(v.w) * bflo(v.w) + bfhi(v.w) * bfhi(v.w); }
            ss += __shfl_xor(ss, 16); ss += __shfl_xor(ss, 32);
            const float rs = __builtin_amdgcn_rsqf(ss * (1.0f / 128.0f) + EPS) * 0.08838834764831845f;
#pragma unroll
            for (int ks = 0; ks < 4; ++ks) { const u32x4 v = qraw[ks]; const f32x4 g0 = *(const f32x4*)(qn + 32 * ks + 8 * fq), g1 = *(const f32x4*)(qn + 32 * ks + 8 * fq + 4);
                u32x4 o; o.x = pk2(bflo(v.x) * rs * g0[0], bfhi(v.x) * rs * g0[1]); o.y = pk2(bflo(v.y) * rs * g0[2], bfhi(v.y) * rs * g0[3]);
                o.z = pk2(bflo(v.z) * rs * g1[0], bfhi(v.z) * rs * g1[1]); o.w = pk2(bflo(v.w) * rs * g1[2], bfhi(v.w) * rs * g1[3]); Qf[ks] = as_frag(o); }
        }
        __syncthreads();
        const int nitem = item + (int)gridDim.x; const bool has_next = nitem < NITEM;
        if (has_next) { it = dil_decode(nitem); dil_issue(Z, it, tid, kraw, vraw); }
        f32x4 sc[9];
#pragma unroll
        for (int jt = 0; jt < 9; ++jt) { f32x4 s = (f32x4){0.f, 0.f, 0.f, 0.f};
#pragma unroll
            for (int ks = 0; ks < 4; ++ks) { const bf16x8 kf = *(const LAS bf16x8*)(lds + OK + (16 * w + 16 * jt + fr) * KP + (32 * ks + 8 * fq) * 2); s = mfma16(kf, Qf[ks], s); }
            sc[jt] = s; if (jt % 3 == 2) asm volatile("" ::: "memory"); }
        float mx = -3.0e38f;
        int dlo = 4 * fq - 64 - fr; asm volatile("" : "+v"(dlo));
#pragma unroll
        for (int jt = 0; jt < 9; ++jt)
#pragma unroll
            for (int e = 0; e < 4; ++e) { const int dl = 16 * jt + e + dlo; const int j = i0 + 16 * w + fr + dl;
                const bool ok = (dl >= -64) && (dl <= 64) && (j >= 0) && (j < L);
                const int bi = dl < -64 ? 0 : (dl > 64 ? 128 : dl + 64);
                const float v = ok ? sc[jt][e] + *(const LAS float*)(lds + OB + bi * 4) : -1.0e30f; sc[jt][e] = v; mx = fmaxf(mx, v); }
        mx = fmaxf(mx, __shfl_xor(mx, 16)); mx = fmaxf(mx, __shfl_xor(mx, 32));
        float den = 0.f;
#pragma unroll
        for (int jt = 0; jt < 9; ++jt)
#pragma unroll
            for (int e = 0; e < 4; ++e) { const float pv = fexp2((sc[jt][e] - mx) * 1.44269504f); sc[jt][e] = pv; den += pv; }
        den += __shfl_xor(den, 16); den += __shfl_xor(den, 32);
        f32x4 oc[8];
#pragma unroll
        for (int c = 0; c < 8; ++c) oc[c] = (f32x4){0.f, 0.f, 0.f, 0.f};
        const int q = fr >> 2, p = fr & 3;
#pragma unroll
        for (int kp = 0; kp < 5; ++kp) {
            u32x4 pw; pw.x = pk2(sc[2 * kp][0], sc[2 * kp][1]); pw.y = pk2(sc[2 * kp][2], sc[2 * kp][3]);
            if (kp < 4) { pw.z = pk2(sc[2 * kp + 1 > 8 ? 8 : 2 * kp + 1][0], sc[2 * kp + 1 > 8 ? 8 : 2 * kp + 1][1]); pw.w = pk2(sc[2 * kp + 1 > 8 ? 8 : 2 * kp + 1][2], sc[2 * kp + 1 > 8 ? 8 : 2 * kp + 1][3]); }
            else { pw.z = 0u; pw.w = 0u; }
            const bf16x8 Pf = as_frag(pw);
            const int ra = 16 * w + 32 * kp + 4 * fq + q, rb = kp < 4 ? ra + 16 : ra;
            bf16x8 Vf[8]; tr8(lbase + OV + ra * KP + (4 * p) * 2, lbase + OV + rb * KP + (4 * p) * 2, Vf);
#pragma unroll
            for (int c = 0; c < 8; ++c) oc[c] = mfma16(Vf[c], Pf, oc[c]);
        }
        const float rden = 1.0f / den;
        if (STORE || den == -1.0f) {
#pragma unroll
        for (int c = 0; c < 8; ++c) { u32x2 o; o.x = pk2(oc[c][0] * rden, oc[c][1] * rden); o.y = pk2(oc[c][2] * rden, oc[c][3] * rden);
            *(u32x2*)(Z + qrow * INW + ZC_DQ + hh * 128 + 16 * c + 4 * fq) = o; }
        if (fq == 0) LSE[qrow * 12 + hh] = mx + logf(den);
        }
        if (!has_next) break;
        item = nitem;
        __syncthreads();
    }
    __syncthreads();
}

DI void scan_combine_phase(int l) {
    const int gt = opaque_bid() * NTHREADS + opaque_tid(), NGT = gridDim.x * NTHREADS;
    const u32x2* KV = (const u32x2*)(arg_ws() + WS_KV); u32x2* S = (u32x2*)(arg_ws() + WS_S);
    for (int v = gt; v < GB * 4 * 2 * 8192; v += NGT) {
        const int bh = v >> 14, dir = (v >> 13) & 1, e4 = v & 8191, h = bh & 3;
        const float de = arg_in(I_DEC)[(l * 2 + dir) * 4 + h];
        const float cd = exp2f(log1pf(-exp2f(-de)) * 1.44269504f * 128.0f);
        u32x2 kw[32];
#pragma unroll
        for (int step = 0; step < 32; ++step) { const int n = dir ? 31 - step : step; kw[step] = KV[((size_t)(bh * 32 + n) * 2 + dir) * 8192 + e4]; }
        f32x4 st = (f32x4){0.f, 0.f, 0.f, 0.f};
#pragma unroll
        for (int step = 0; step < 32; ++step) { const int n = dir ? 31 - step : step; const size_t idx = ((size_t)(bh * 32 + n) * 2 + dir) * 8192 + e4;
            u32x2 o; o.x = pk2(st[0], st[1]); o.y = pk2(st[2], st[3]); S[idx] = o;
            const f32x4 kv = (f32x4){bflo(kw[step].x), bfhi(kw[step].x), bflo(kw[step].y), bfhi(kw[step].y)}; st = st * cd + kv; }
    }
    const bf16_t* Z = (const bf16_t*)(arg_ws() + WS_Z); const float* LSE = (const float*)(arg_ws() + WS_LSE); bf16_t* DL = (bf16_t*)(arg_ws() + WS_DL);
    for (int id = gt; id < GT * 64; id += NGT) {
        const int tok = id >> 6, j = (id >> 4) & 3, ch = id & 15;
        const float l0 = LSE[tok * 12 + j], l1 = LSE[tok * 12 + 4 + j], l2 = LSE[tok * 12 + 8 + j];
        const float mx = fmaxf(l0, fmaxf(l1, l2));
        float w0 = __expf(l0 - mx), w1 = __expf(l1 - mx), w2 = __expf(l2 - mx); const float rw = 1.0f / (w0 + w1 + w2); w0 *= rw; w1 *= rw; w2 *= rw;
        const bf16_t* zr = Z + (size_t)tok * INW + ZC_DQ + j * 128 + ch * 8;
        const u32x4 a0 = *(const u32x4*)zr, a1 = *(const u32x4*)(zr + 512), a2 = *(const u32x4*)(zr + 1024);
        u32x4 o;
        o.x = pk2(w0 * bflo(a0.x) + w1 * bflo(a1.x) + w2 * bflo(a2.x), w0 * bfhi(a0.x) + w1 * bfhi(a1.x) + w2 * bfhi(a2.x));
        o.y = pk2(w0 * bflo(a0.y) + w1 * bflo(a1.y) + w2 * bflo(a2.y), w0 * bfhi(a0.y) + w1 * bfhi(a1.y) + w2 * bfhi(a2.y));
        o.z = pk2(w0 * bflo(a0.z) + w1 * bflo(a1.z) + w2 * bflo(a2.z), w0 * bfhi(a0.z) + w1 * bfhi(a1.z) + w2 * bfhi(a2.z));
        o.w = pk2(w0 * bflo(a0.w) + w1 * bflo(a1.w) + w2 * bflo(a2.w), w0 * bfhi(a0.w) + w1 * bfhi(a1.w) + w2 * bfhi(a2.w));
        *(u32x4*)(DL + (size_t)tok * 512 + j * 128 + ch * 8) = o;
    }
}

DI void ret_out_phase(int l, unsigned char* lds_g, LAS unsigned char* lds) {
    const int tid = opaque_tid(), lane = tid & 63, w = tid >> 6, fr = lane & 15, fq = lane >> 4;
    const unsigned lbase = (unsigned)(size_t)lds_g;
    const bf16_t* Z = (const bf16_t*)(arg_ws() + WS_Z); const bf16_t* S = (const bf16_t*)(arg_ws() + WS_S); bf16_t* R = (bf16_t*)(arg_ws() + WS_R);
    const float* rn = arg_in(I_RNORM) + l * 1024;
    constexpr int OQ = 0, OKP = 128 * RK_PITCH, OV = 2 * 128 * RK_PITCH, OT = OV + 128 * RV_PITCH;
    for (int item = opaque_bid(); item < GB * 4 * 32; item += gridDim.x) {
        const int n = item & 31, h = (item >> 5) & 3, bl = item >> 7;
        const size_t row0 = (size_t)bl * SEQ + n * 128;
        const float de_f = arg_in(I_DEC)[(l * 2 + 0) * 4 + h], de_b = arg_in(I_DEC)[(l * 2 + 1) * 4 + h];
        const float l2f = log1pf(-exp2f(-de_f)) * 1.44269504f, l2b = log1pf(-exp2f(-de_b)) * 1.44269504f;
#pragma unroll
        for (int i = 0; i < 8; ++i) { const int id = tid + 512 * i, r = id >> 5, ch = id & 31;
            *(LAS u32x4*)(lds + OV + r * RV_PITCH + ch * 16) = *(const u32x4*)(Z + (row0 + r) * INW + ZC_RV + h * 256 + ch * 8); }
#pragma unroll
        for (int i = 0; i < 4; ++i) { const int id = tid + 512 * i, r = id >> 4, ch = id & 15;
            *(LAS u32x4*)(lds + OQ + r * RK_PITCH + ch * 16) = *(const u32x4*)(Z + (row0 + r) * INW + ZC_RQ + h * 128 + ch * 8);
            *(LAS u32x4*)(lds + OKP + r * RK_PITCH + ch * 16) = *(const u32x4*)(Z + (row0 + r) * INW + ZC_RK + h * 128 + ch * 8); }
        __syncthreads();
        {
            bf16x8 Qf[4];
#pragma unroll
            for (int ks = 0; ks < 4; ++ks) Qf[ks] = *(const LAS bf16x8*)(lds + OQ + (16 * w + fr) * RK_PITCH + (32 * ks + 8 * fq) * 2);
            u32x2 pw[8];
            const int i = 16 * w + fr;
#pragma unroll
            for (int jt = 0; jt < 8; ++jt) { f32x4 s = (f32x4){0.f, 0.f, 0.f, 0.f};
#pragma unroll
                for (int ks = 0; ks < 4; ++ks) { const bf16x8 kf = *(const LAS bf16x8*)(lds + OKP + (16 * jt + fr) * RK_PITCH + (32 * ks + 8 * fq) * 2); s = mfma16(kf, Qf[ks], s); }
                int io = i - 4 * fq; asm volatile("" : "+v"(io));
#pragma unroll
                for (int e = 0; e < 4; ++e) { const int x = io - (16 * jt + e); const float dm = fexp2(x >= 0 ? l2f * (float)x : l2b * (float)(-x)); s[e] *= dm; }
                pw[jt].x = pk2(s[0], s[1]); pw[jt].y = pk2(s[2], s[3]); asm volatile("" ::: "memory"); }
            __syncthreads();
#pragma unroll
            for (int jt = 0; jt < 8; ++jt) *(LAS u32x2*)(lds + OKP + i * RK_PITCH + (16 * jt + 4 * fq) * 2) = pw[jt];
        }
        __syncthreads();
        f32x4 O[2][8];
        {
            const int q = fr >> 2, p = fr & 3;
#pragma unroll 1
            for (int dir = 0; dir < 2; ++dir) {
                const bf16_t* Sd = S + (((size_t)item * 2 + dir) * 256 + 32 * w) * 128;
#pragma unroll
                for (int m = 0; m < 2; ++m) {
                    f32x4 T[8];
#pragma unroll
                    for (int nt = 0; nt < 8; ++nt) T[nt] = (f32x4){0.f, 0.f, 0.f, 0.f};
                    u32x4 Sf4[4];
#pragma unroll
                    for (int ks = 0; ks < 4; ++ks) Sf4[ks] = *(const u32x4*)(Sd + (16 * m + fr) * 128 + 32 * ks + 8 * fq);
                    asm volatile("" ::: "memory");
#pragma unroll
                    for (int ks = 0; ks < 4; ++ks) {
                        const bf16x8 Af = as_frag(Sf4[ks]);
#pragma unroll
                        for (int nt = 0; nt < 8; ++nt) { const bf16x8 qf = *(const LAS bf16x8*)(lds + OQ + (16 * nt + fr) * RK_PITCH + (32 * ks + 8 * fq) * 2); T[nt] = mfma16(Af, qf, T[nt]); }
                        asm volatile("" ::: "memory");
                    }
                    int fro = fr; asm volatile("" : "+v"(fro));
#pragma unroll
                    for (int nt = 0; nt < 8; ++nt) { const int i = 16 * nt + fro; const float sc = dir ? fexp2(l2b * (float)(128 - i)) : fexp2(l2f * (float)(i + 1));
                        if (dir) O[m][nt] += T[nt] * sc; else O[m][nt] = T[nt] * sc; }
                    asm volatile("" ::: "memory");
                }
            }
#pragma unroll 1
            for (int ks = 0; ks < 4; ++ks) {
                bf16x8 Vf[2];
                const int tr0 = 32 * ks + 8 * fq + q;
#pragma unroll
                for (int m = 0; m < 2; ++m) { const unsigned ad = lbase + OV + tr0 * RV_PITCH + (32 * w + 16 * m + 4 * p) * 2; Vf[m] = tr_frag(ad, ad + 4 * RV_PITCH); }
#pragma unroll
                for (int nt = 0; nt < 8; ++nt) { const bf16x8 pf = *(const LAS bf16x8*)(lds + OKP + (16 * nt + fr) * RK_PITCH + (32 * ks + 8 * fq) * 2);
#pragma unroll
                    for (int m = 0; m < 2; ++m) O[m][nt] = mfma16(Vf[m], pf, O[m][nt]); }
            }
        }
#pragma unroll
        for (int nt = 0; nt < 8; ++nt) { float ss = 0.f;
#pragma unroll
            for (int m = 0; m < 2; ++m)
#pragma unroll
                for (int e = 0; e < 4; ++e) ss += O[m][nt][e] * O[m][nt][e];
            ss += __shfl_xor(ss, 16); ss += __shfl_xor(ss, 32);
            if (fq == 0) *(LAS float*)(lds + OT + (w * 128 + 16 * nt + fr) * 4) = ss; }
        __syncthreads();
#pragma unroll
        for (int nt = 0; nt < 8; ++nt) { const int i = 16 * nt + fr; float tot = 0.f;
#pragma unroll
            for (int ww = 0; ww < 8; ++ww) tot += *(const LAS float*)(lds + OT + (ww * 128 + i) * 4);
            const float rinv = __builtin_amdgcn_rsqf(tot * (1.0f / 256.0f) + EPS);
#pragma unroll
            for (int m = 0; m < 2; ++m) { const int dv = h * 256 + 32 * w + 16 * m + 4 * fq;
                const u32x2 gz = *(const u32x2*)(Z + (row0 + i) * INW + ZC_RG + dv); const f32x4 gn = *(const f32x4*)(rn + dv);
                const float o0 = O[m][nt][0] * rinv * gn[0] * fsilu(bflo(gz.x)), o1 = O[m][nt][1] * rinv * gn[1] * fsilu(bfhi(gz.x));
                const float o2 = O[m][nt][2] * rinv * gn[2] * fsilu(bflo(gz.y)), o3 = O[m][nt][3] * rinv * gn[3] * fsilu(bfhi(gz.y));
                u32x2 o; o.x = pk2(o0, o1); o.y = pk2(o2, o3);
                *(u32x2*)(R + (row0 + i) * 1024 + dv) = o; }
            asm volatile("" ::: "memory"); }
        __syncthreads();
    }
}

#ifndef PHMASK
#define PHMASK 0xffff
#endif
#define PH(k) ((PHMASK >> (k)) & 1)

#define XB_TMO      128
#define XB_XCNT(j)  (256  + 64 * (j))
#define XB_XSUB(j)  (1280 + 64 * (j))
#define XB_XGEN(j)  (2304 + 64 * (j))
#define XB_TOP      3328
#define XB_TOPGEN   3392
#define XCD_BAR_WORDS 3456
#define XB_SPIN_CAP (1u << 22)
DI unsigned xb_ld(unsigned* p)              { return __hip_atomic_load(p, __ATOMIC_RELAXED, __HIP_MEMORY_SCOPE_AGENT); }
DI unsigned xb_add(unsigned* p, unsigned v) { return __hip_atomic_fetch_add(p, v, __ATOMIC_RELAXED, __HIP_MEMORY_SCOPE_AGENT); }
DI unsigned xb_xcc_id() { return (unsigned)__builtin_amdgcn_s_getreg((3 << 11) | 20) & 0xFu; }
#define XB_SPIN(cond, bar) do { unsigned _sp = 0; while (cond) { __builtin_amdgcn_s_sleep(1); \
    if ((++_sp & 255u) == 0u) { if (xb_ld(&(bar)[XB_TMO])) break; if (_sp > XB_SPIN_CAP) { atomicAdd(&(bar)[XB_TMO], 1u); break; } } } } while (0)
DI void xcd_barrier_complete(unsigned* bar, unsigned x, unsigned& nloc, unsigned& nx) {
    const unsigned G = gridDim.x * gridDim.y * gridDim.z;
    unsigned sum, cnt, mine, sp = 0u;
    for (;;) {
        sum = 0u; cnt = 0u; mine = 0u;
#pragma unroll
        for (unsigned j = 0; j < 16; ++j) { const unsigned c = xb_ld(&bar[XB_XCNT(j)]); sum += c; cnt += (c > 0u) ? 1u : 0u; mine = (j == x) ? c : mine; }
        if (sum == G) break;
        __builtin_amdgcn_s_sleep(1);
        if ((++sp & 255u) == 0u) { if (xb_ld(&bar[XB_TMO])) break; if (sp > XB_SPIN_CAP) { atomicAdd(&bar[XB_TMO], 1u); break; } }
    }
    nloc = mine > 0u ? mine : 1u; nx = cnt > 0u ? cnt : 1u;
}
DI void xcd_barrier(unsigned* bar, volatile LAS unsigned* st) {
    asm volatile("s_waitcnt vmcnt(0)" ::: "memory");
    __syncthreads();
    if (threadIdx.x == 0) {
        __builtin_amdgcn_s_waitcnt(0);
        const unsigned x = xb_xcc_id();
        unsigned nloc = st[0], nx = st[1];
        if (nloc == 0u) { xcd_barrier_complete(bar, x, nloc, nx); st[0] = nloc; st[1] = nx; }
        const unsigned old = xb_add(&bar[XB_XSUB(x)], 1u);
        const unsigned gen = old / nloc;
        if (old + 1u == (gen + 1u) * nloc) {
            __builtin_amdgcn_fence(__ATOMIC_RELEASE, "agent");
            asm volatile("s_waitcnt vmcnt(0)" ::: "memory");
            const unsigned og = xb_add(&bar[XB_TOP], 1u);
            const unsigned tg = og / nx;
            if (og + 1u == (tg + 1u) * nx) xb_add(&bar[XB_TOPGEN], 1u);
            else XB_SPIN(xb_ld(&bar[XB_TOPGEN]) == tg, bar);
            __builtin_amdgcn_fence(__ATOMIC_ACQUIRE, "agent");
            xb_add(&bar[XB_XGEN(x)], 1u);
            asm volatile("s_waitcnt vmcnt(0)" ::: "memory");
        } else {
            XB_SPIN(xb_ld(&bar[XB_XGEN(x)]) == gen, bar);
            __builtin_amdgcn_fence(__ATOMIC_ACQUIRE, "agent");
            asm volatile("s_waitcnt vmcnt(0)" ::: "memory");
        }
    }
    __syncthreads();
}

DI void ph_win(LAS unsigned char* lds, int l, int g) {
    unsigned char* ws = arg_ws(); const size_t rb = (size_t)g * GT;
    pg8::Gemm gm{(const bf16_t*)(ws + WS_XB) + rb * D, (const bf16_t*)(ws + WS_W + (size_t)l * LW + OW_IN), GT, INW, D}; pg8::StaticOrder S; S.init(GT, INW, gridDim.x, opaque_bid());
    pg8::EpiZ E{(bf16_t*)(ws + WS_Z), (const float*)(ws + WS_SLOT) + rb * 16, (const float*)(ws + WS_ROPE), (const float*)(ws + WS_ROPE) + SEQ * 64}; pg8::gemm_phase(lds, gm, S, E);
}
DI void ph_post1(LAS unsigned char* lds, int l) {
    unsigned char* ws = arg_ws();
    pg8::Gemm gm{(const bf16_t*)(ws + WS_R), (const bf16_t*)(ws + WS_W + (size_t)l * LW + OW_RO), GT, D, D}; pg8::StaticOrder S; S.init(GT, D, gridDim.x, opaque_bid());
    pg8::EpiGate<false> E{(const bf16_t*)(ws + WS_Z) + ZC_GR, arg_in(I_BG) + l * 2048, (float*)(ws + WS_Y1), (bf16_t*)(ws + WS_MB)}; pg8::gemm_phase(lds, gm, S, E);
}
DI void ph_post2(LAS unsigned char* lds, int l) {
    unsigned char* ws = arg_ws();
    pg8::Gemm gm{(const bf16_t*)(ws + WS_DL), (const bf16_t*)(ws + WS_W + (size_t)l * LW + OW_DO), GT, D, 512}; pg8::StaticOrder S; S.init(GT, D, gridDim.x, opaque_bid());
    pg8::EpiGate<true> E{(const bf16_t*)(ws + WS_Z) + ZC_GD, arg_in(I_BG) + l * 2048 + 1024, (float*)(ws + WS_Y1), (bf16_t*)(ws + WS_MB)}; pg8::gemm_phase(lds, gm, S, E);
}
DI void ph_out(LAS unsigned char* lds, int l, int g) {
    unsigned char* ws = arg_ws(); const size_t rb = (size_t)g * GT;
    pg8::Gemm gm{(const bf16_t*)(ws + WS_MB), (const bf16_t*)(ws + WS_W + (size_t)l * LW + OW_OUT), GT, D, D}; pg8::StaticOrder S; S.init(GT, D, gridDim.x, opaque_bid());
    pg8::EpiRes E{arg_out() + rb * D, (bf16_t*)(ws + WS_XB) + rb * D, (float*)(ws + WS_SLOT) + rb * 16, 1.0f}; pg8::gemm_phase(lds, gm, S, E);
}
DI void ph_gu(LAS unsigned char* lds, int l, int half) {
    unsigned char* ws = arg_ws();
    pg8::Gemm gm{(const bf16_t*)(ws + WS_XB), (const bf16_t*)(ws + WS_W + (size_t)l * LW + (half ? OW_GU2 : OW_GU1)), NTOK, 5632, D}; pg8::StaticOrder S; S.init(NTOK, 5632, gridDim.x, opaque_bid());
    pg8::EpiSwiGLU E{(bf16_t*)(ws + WS_H), (const float*)(ws + WS_SLOT)}; pg8::gemm_phase(lds, gm, S, E);
}
DI void ph_down(LAS unsigned char* lds, int l, int half) {
    unsigned char* ws = arg_ws();
    pg8::Gemm gm{(const bf16_t*)(ws + WS_H), (const bf16_t*)(ws + WS_W + (size_t)l * LW + (half ? OW_D2 : OW_D1)), NTOK, D, FF}; pg8::StaticOrder S; S.init(NTOK, D, gridDim.x, opaque_bid());
    pg8::EpiRes E{arg_out(), (bf16_t*)(ws + WS_XB), (float*)(ws + WS_SLOT), 0.5f}; pg8::gemm_phase(lds, gm, S, E);
}

__global__ void __launch_bounds__(NTHREADS, 2) mega_fwd(Args a) {
    extern __shared__ __attribute__((aligned(16))) unsigned char lds_g[];
    LAS unsigned char* lds = (LAS unsigned char*)lds_g;
    cg::grid_group grid = cg::this_grid();
    volatile LAS unsigned* bst = (volatile LAS unsigned*)(lds + LDS_BYTES - 16);
    if (threadIdx.x < 4) bst[threadIdx.x] = 0u;
    __syncthreads();
    if (threadIdx.x == 0) (void)xb_add((unsigned*)arg_ws() + XB_XCNT(xb_xcc_id()), 1u);
#define GSYNC() xcd_barrier((unsigned*)arg_ws(), bst)
    if (PH(0)) prep_phase(lds);
    grid.sync();
#pragma unroll 1
    for (int l = 0; l < DEPTH; ++l) {
#pragma unroll 1
        for (int half = 0; half < 2; ++half) {
            if (half == 1) {
#pragma unroll 1
                for (int g = 0; g < NGRP; ++g) {
                    if (PH(1)) ph_win(lds, l, g);
                    GSYNC();
                    if (PH(2)) ret_kv_phase(l, lds_g, lds);
                    if (PH(3)) dil_attn_phase(l, lds_g, lds);
                    GSYNC();
                    if (PH(4)) scan_combine_phase(l);
                    GSYNC();
                    if (PH(5)) ret_out_phase(l, lds_g, lds);
                    GSYNC();
                    if (PH(6)) ph_post1(lds, l);
                    if (PH(7)) ph_post2(lds, l);
                    GSYNC();
                    if (PH(8)) ph_out(lds, l, g);
                }
                GSYNC();
            }
            if (PH(9)) ph_gu(lds, l, half);
            GSYNC();
            if (PH(10)) ph_down(lds, l, half);
            if (l != DEPTH - 1 || half != 1) GSYNC();
        }
    }
}

extern "C" void kernel_launch(void* const* d_in, const int* in_sizes, int n_in, void* d_out, int out_size, void* d_ws, size_t ws_size, hipStream_t stream) {
    static int grid = 0;
    if (grid == 0) {
        if (n_in != 20 || out_size != NTOK * D || ws_size < WS_H + (size_t)NTOK * FF * 2 || ws_size < WS_END) { fprintf(stderr, "kernel_launch: unexpected shapes / workspace (n_in %d out %d ws %zu)\n", n_in, out_size, ws_size); grid = -1; return; }
        int dev = 0, cus = 0, per_cu = 0;
        if (hipGetDevice(&dev) != hipSuccess || hipDeviceGetAttribute(&cus, hipDeviceAttributeMultiprocessorCount, dev) != hipSuccess) { grid = -1; return; }
        if (hipFuncSetAttribute((const void*)mega_fwd, hipFuncAttributeMaxDynamicSharedMemorySize, LDS_BYTES) != hipSuccess) { fprintf(stderr, "kernel_launch: hipFuncSetAttribute failed\n"); grid = -1; return; }
        if (hipOccupancyMaxActiveBlocksPerMultiprocessor(&per_cu, (const void*)mega_fwd, NTHREADS, LDS_BYTES) != hipSuccess || per_cu < 1) { fprintf(stderr, "kernel_launch: occupancy query failed (%d)\n", per_cu); (void)hipGetLastError(); per_cu = 1; }
        grid = cus * per_cu;
    }
    if (grid < 0) return;
    if (hipMemsetAsync(d_ws, 0, 16384, stream) != hipSuccess) { fprintf(stderr, "kernel_launch: memset failed\n"); return; }
    Args a{};
    for (int i = 0; i < 20; ++i) a.in[i] = (const float*)d_in[i];
    a.out = (float*)d_out; a.ws = (unsigned char*)d_ws;
    void* args[] = {&a};
    hipError_t e = hipLaunchCooperativeKernel((const void*)mega_fwd, dim3(grid), dim3(NTHREADS), args, LDS_BYTES, stream);
    if (e != hipSuccess) fprintf(stderr, "kernel_launch: cooperative launch failed: %s (grid %d)\n", hipGetErrorString(e), grid);
}
```

```cpp
#include <hip/hip_runtime.h>
#include <hip/hip_cooperative_groups.h>
#include <cstdio>
#include <cstdint>
namespace cg = cooperative_groups;

#define DI __device__ __forceinline__
#define LAS __attribute__((address_space(3)))
typedef unsigned short bf16_t;
typedef short bf16x8 __attribute__((ext_vector_type(8)));
typedef short s16x4 __attribute__((ext_vector_type(4)));
typedef float f32x4 __attribute__((ext_vector_type(4)));
typedef unsigned u32x4 __attribute__((ext_vector_type(4)));
typedef unsigned u32x2 __attribute__((ext_vector_type(2)));

constexpr int D = 1024, FF = 2816, SEQ = 4096, NBATCH = 16, NTOK = NBATCH * SEQ, DEPTH = 4, INW = 9728;
constexpr int GB = 4, GT = GB * SEQ, NGRP = NBATCH / GB;
constexpr int ZC_RQ = 0, ZC_RK = 512, ZC_RV = 1024, ZC_RG = 2048, ZC_DQ = 3072, ZC_DK = 4608, ZC_DV = 6144, ZC_GR = 7680, ZC_GD = 8704;
constexpr float EPS = 1e-6f;
constexpr int NTHREADS = 512;
constexpr int LDS_BYTES = 147456;

constexpr size_t MiB = 1u << 20;
constexpr size_t WS_ROPE = 1 * MiB;
constexpr size_t WS_BIAS = 3 * MiB;
constexpr size_t WS_SLOT = 4 * MiB;
constexpr size_t WS_W = 8 * MiB;
constexpr size_t OW_GU1 = 0, OW_D1 = OW_GU1 + (size_t)5632 * 1024 * 2, OW_IN = OW_D1 + (size_t)1024 * 2816 * 2, OW_RO = OW_IN + (size_t)INW * 1024 * 2,
                 OW_DO = OW_RO + (size_t)1024 * 1024 * 2, OW_OUT = OW_DO + (size_t)1024 * 512 * 2, OW_GU2 = OW_OUT + (size_t)1024 * 1024 * 2,
                 OW_D2 = OW_GU2 + (size_t)5632 * 1024 * 2, LW = OW_D2 + (size_t)1024 * 2816 * 2;
static_assert(LW == 57 * MiB, "layer weight bytes");
constexpr size_t WS_XB = WS_W + DEPTH * LW;
constexpr size_t WS_BIG = WS_XB + (size_t)NTOK * D * 2;
constexpr size_t WS_H = WS_BIG;
constexpr size_t WS_Z = WS_BIG;
constexpr size_t WS_KV = WS_Z + (size_t)GT * INW * 2;
constexpr size_t WS_Y1 = WS_KV;
constexpr size_t WS_MB = WS_KV + (size_t)GT * D * 4;
constexpr size_t WS_S = WS_KV + (size_t)512 * 2 * 32768 * 4;
constexpr size_t WS_R = WS_S + (size_t)512 * 2 * 32768 * 2;
constexpr size_t WS_DL = WS_R + (size_t)GT * 1024 * 2;
constexpr size_t WS_LSE = WS_DL + (size_t)GT * 512 * 2;
constexpr size_t WS_END = WS_LSE + (size_t)GT * 12 * 4;
static_assert(WS_H + (size_t)NTOK * FF * 2 <= ((size_t)1 << 30) && WS_END <= ((size_t)1 << 30), "workspace fits 1 GiB");

DI int opaque_tid() { int t = threadIdx.x; asm volatile("" : "+v"(t)); return t; }
DI int opaque_bid() { int t = blockIdx.x; asm volatile("" : "+s"(t)); return t; }
DI unsigned pk2(float lo, float hi) { unsigned r; asm("v_cvt_pk_bf16_f32 %0, %1, %2" : "=v"(r) : "v"(lo), "v"(hi)); return r; }
DI float bflo(unsigned u) { return __uint_as_float(u << 16); }
DI float bfhi(unsigned u) { return __uint_as_float(u & 0xffff0000u); }
DI float fexp2(float x) { return __builtin_amdgcn_exp2f(x); }
DI float frcp(float x) { return __builtin_amdgcn_rcpf(x); }
DI float fsigmoid(float x) { return frcp(1.0f + fexp2(-1.44269504f * x)); }
DI float fsilu(float x) { return x * fsigmoid(x); }
DI bf16x8 as_frag(u32x4 v) { return __builtin_bit_cast(bf16x8, v); }
DI f32x4 mfma16(bf16x8 a, bf16x8 b, f32x4 c) { return __builtin_amdgcn_mfma_f32_16x16x32_bf16(a, b, c, 0, 0, 0); }
DI bf16x8 tr_frag(unsigned a0, unsigned a1) {
    s16x4 lo, hi;
    asm volatile("ds_read_b64_tr_b16 %0, %2\n\tds_read_b64_tr_b16 %1, %3\n\ts_waitcnt lgkmcnt(0)" : "=&v"(lo), "=&v"(hi) : "v"(a0), "v"(a1) : "memory");
    bf16x8 r; r[0] = lo[0]; r[1] = lo[1]; r[2] = lo[2]; r[3] = lo[3]; r[4] = hi[0]; r[5] = hi[1]; r[6] = hi[2]; r[7] = hi[3]; return r;
}
DI void tr4(unsigned a0, unsigned a1, bf16x8& o0, bf16x8& o1, bf16x8& o2, bf16x8& o3) {
    s16x4 l0, l1, l2, l3, h0, h1, h2, h3;
    asm volatile(
        "ds_read_b64_tr_b16 %0, %8\n\tds_read_b64_tr_b16 %4, %9\n\t"
        "ds_read_b64_tr_b16 %1, %8 offset:32\n\tds_read_b64_tr_b16 %5, %9 offset:32\n\t"
        "ds_read_b64_tr_b16 %2, %8 offset:64\n\tds_read_b64_tr_b16 %6, %9 offset:64\n\t"
        "ds_read_b64_tr_b16 %3, %8 offset:96\n\tds_read_b64_tr_b16 %7, %9 offset:96\n\t"
        "s_waitcnt lgkmcnt(0)"
        : "=&v"(l0), "=&v"(l1), "=&v"(l2), "=&v"(l3), "=&v"(h0), "=&v"(h1), "=&v"(h2), "=&v"(h3)
        : "v"(a0), "v"(a1) : "memory");
#define TR_PACK(o, lo, hi) o[0] = lo[0]; o[1] = lo[1]; o[2] = lo[2]; o[3] = lo[3]; o[4] = hi[0]; o[5] = hi[1]; o[6] = hi[2]; o[7] = hi[3];
    TR_PACK(o0, l0, h0) TR_PACK(o1, l1, h1) TR_PACK(o2, l2, h2) TR_PACK(o3, l3, h3)
#undef TR_PACK
}
DI void tr8(unsigned a0, unsigned a1, bf16x8 (&out)[8]) {
    tr4(a0, a1, out[0], out[1], out[2], out[3]);
    tr4(a0 + 128u, a1 + 128u, out[4], out[5], out[6], out[7]);
}
DI float row_scale(const float* slots, int row, int fq) {
    const f32x4 s = *(const f32x4*)(slots + (size_t)row * 16 + 4 * fq);
    float t = (s[0] + s[1]) + (s[2] + s[3]);
    t += __shfl_xor(t, 16); t += __shfl_xor(t, 32);
    return __builtin_amdgcn_rsqf(t * (1.0f / D) + EPS);
}

namespace pg8 {
constexpr int BM = 256, BK = 64, HALF = 128, HTB = HALF * BK * 2, STAGE_BYTES = 8 * HTB, NXCD = 8, WGM = 4;
__host__ __device__ __forceinline__ int lds_byte(int r, int c) { const int st = (r >> 4) * 2 + (c >> 5), rr = r & 15, cc = c & 31, ob = rr * 64 + cc * 2; return st * 1024 + (ob ^ (((ob >> 9) & 1) << 5)); }
__host__ __device__ __forceinline__ void stage_rc(int b, int& R, int& C) { const int st = b / 1024, sb = b % 1024, swz = sb ^ (((sb >> 9) & 1) << 5); R = (st >> 1) * 16 + swz / 64; C = (st & 1) * 32 + (swz % 64) / 2; }
__host__ __device__ __forceinline__ int perm32(int rho) { const int n = rho >> 4, i = rho & 15; return 8 * (i >> 2) + 4 * n + (i & 3); }
struct Unit { int pm, pn; };
struct Gemm { const bf16_t* A; const bf16_t* Bt; int M, N, K; };
struct StaticOrder {
    int nM, nN, nwg, G, c;
    DI void init(int M, int N, int G_, int c_) { nM = M / BM; nN = N / BM; nwg = nM * nN; G = G_; c = c_; }
    DI bool next(int i, Unit& u) const {
        const long L = (long)i * G + c; if (L >= nwg) return false;
        int wgid = (int)L; { const int q = nwg / NXCD, r = nwg % NXCD, xcd = wgid % NXCD, off = wgid / NXCD; wgid = (xcd < r ? xcd * (q + 1) : r * (q + 1) + (xcd - r) * q) + off; }
        const int nig = WGM * nN, gid = wgid / nig, fm = gid * WGM, gsz = (nM - fm) < WGM ? (nM - fm) : WGM;
        u.pm = fm + ((wgid % nig) % gsz); u.pn = (wgid % nig) / gsz; return true;
    }
};
template <class Epi>
DI void gemm_phase(LAS unsigned char* lds, const Gemm g, const StaticOrder& S, const Epi& E) {
    const int tid = opaque_tid(), wid = __builtin_amdgcn_readfirstlane(tid >> 6), lane = tid & 63, wr = wid >> 2, wc = wid & 3, fr = lane & 15, fq = lane >> 4;
    const int K = g.K, nt = K / BK;
    unsigned voffA[2], voffB[2];
#pragma unroll
    for (int i = 0; i < 2; ++i) { int R, C; stage_rc(tid * 16 + i * 8192, R, C); const int Rb = Epi::PERM ? ((R & ~31) + perm32(R & 31)) : R;
        voffA[i] = (unsigned)(R * K + C) * 2u; voffB[i] = (unsigned)(Rb * K + C) * 2u; }
    const size_t kstep = (size_t)(BK * 2);
    const size_t hstep = (size_t)HALF * K * 2;
    const size_t tstep = 2 * hstep;
    const unsigned ldsw = (unsigned)wid * 1024u;
    const int aoff = lds_byte(wr * 64 + fr, fq * 8), boff = lds_byte(wc * 32 + fr, fq * 8);
#define PG8_SA(b, h) (((b) * 2 + (h)) * HTB)
#define PG8_SB(b, h) ((4 + (b) * 2 + (h)) * HTB)
#define PG8_STAGE(bufoff, gbase, voff) do { _Pragma("unroll") for (int _i = 0; _i < 2; ++_i) \
        __builtin_amdgcn_global_load_lds((const unsigned*)((const char*)(gbase) + (voff)[_i]), (LAS unsigned*)(lds + (bufoff) + ldsw + _i * 8192), 16, 0, 0); } while (0)
#define PG8_LDA(dst, b, h) do { _Pragma("unroll") for (int m = 0; m < 4; ++m) _Pragma("unroll") for (int k = 0; k < 2; ++k) dst[m][k] = *(const LAS bf16x8*)(lds + PG8_SA(b, h) + aoff + m * 2048 + k * 1024); } while (0)
#define PG8_LDB(dst, b, h) do { _Pragma("unroll") for (int n = 0; n < 2; ++n) _Pragma("unroll") for (int k = 0; k < 2; ++k) dst[n][k] = *(const LAS bf16x8*)(lds + PG8_SB(b, h) + boff + n * 2048 + k * 1024); } while (0)
#define PG8_MMA(ai, bj, At, Bt) do { __builtin_amdgcn_s_setprio(1); _Pragma("unroll") for (int m = 0; m < 4; ++m) _Pragma("unroll") for (int n = 0; n < 2; ++n) _Pragma("unroll") for (int k = 0; k < 2; ++k) \
        acc[ai][bj][m][n] = __builtin_amdgcn_mfma_f32_16x16x32_bf16(Bt[n][k], At[m][k], acc[ai][bj][m][n], 0, 0, 0); __builtin_amdgcn_s_setprio(0); } while (0)
#define PG8_WAIT_V(n) asm volatile("s_waitcnt vmcnt(" #n ")" ::: "memory")
#define PG8_WAIT_L(n) asm volatile("s_waitcnt lgkmcnt(" #n ")" ::: "memory")
#define PG8_BAR __builtin_amdgcn_s_barrier()
#define PG8_SCHED __builtin_amdgcn_sched_barrier(0)
    Unit cur, nxt; int ui = 0;
    if (!S.next(0, cur)) return;
    f32x4 acc[2][2][4][2];
#pragma unroll
    for (int a = 0; a < 2; ++a)
#pragma unroll
        for (int b = 0; b < 2; ++b)
#pragma unroll
            for (int m = 0; m < 4; ++m)
#pragma unroll
                for (int n = 0; n < 2; ++n) acc[a][b][m][n] = (f32x4){0.f, 0.f, 0.f, 0.f};
    bf16x8 At[4][2], B0[2][2], B1[2][2];
    const char* cA = (const char*)g.A + (size_t)cur.pm * tstep; const char* cB = (const char*)g.Bt + (size_t)cur.pn * tstep;
    PG8_STAGE(PG8_SB(0, 0), cB, voffB); PG8_STAGE(PG8_SB(0, 1), cB + hstep, voffB); PG8_STAGE(PG8_SA(0, 0), cA, voffA); PG8_STAGE(PG8_SA(0, 1), cA + hstep, voffA);
    if (wr == 1) PG8_BAR;
    PG8_WAIT_V(2); PG8_BAR;
    PG8_STAGE(PG8_SB(1, 0), cB + kstep, voffB); PG8_STAGE(PG8_SA(1, 0), cA + kstep, voffA); PG8_STAGE(PG8_SB(1, 1), cB + hstep + kstep, voffB);
    PG8_WAIT_V(6); PG8_BAR;
    for (;;) {
        const bool has_next = S.next(ui + 1, nxt);
        const char* nA = has_next ? (const char*)g.A + (size_t)nxt.pm * tstep : cA; const char* nB = has_next ? (const char*)g.Bt + (size_t)nxt.pn * tstep : cB;
        for (int t = 0; t < nt; t += 2) {
            const bool last = (t == nt - 2);
            const char* a1 = cA + (size_t)(t + 1) * kstep;
            const char* a2 = last ? nA : cA + (size_t)(t + 2) * kstep; const char* b2 = last ? nB : cB + (size_t)(t + 2) * kstep;
            const char* a3 = a2 + kstep; const char* b3 = b2 + kstep;
            PG8_LDB(B0, 0, 0); PG8_LDB(B1, 0, 1); PG8_SCHED; PG8_LDA(At, 0, 0); PG8_STAGE(PG8_SA(1, 1), a1 + hstep, voffA);
            PG8_WAIT_V(8); PG8_WAIT_L(0); PG8_BAR; PG8_MMA(0, 0, At, B0); PG8_MMA(0, 1, At, B1); PG8_BAR; PG8_SCHED;
            PG8_LDA(At, 0, 1); PG8_STAGE(PG8_SB(0, 0), b2, voffB); PG8_STAGE(PG8_SB(0, 1), b2 + hstep, voffB); PG8_STAGE(PG8_SA(0, 0), a2, voffA);
            PG8_WAIT_V(8); PG8_WAIT_L(0); PG8_BAR; PG8_MMA(1, 0, At, B0); PG8_MMA(1, 1, At, B1); PG8_BAR; PG8_SCHED;
            PG8_LDB(B0, 1, 0); PG8_LDB(B1, 1, 1); PG8_SCHED; PG8_LDA(At, 1, 0); PG8_STAGE(PG8_SA(0, 1), a2 + hstep, voffA);
            PG8_WAIT_V(8); PG8_WAIT_L(0); PG8_BAR; PG8_MMA(0, 0, At, B0); PG8_MMA(0, 1, At, B1); PG8_BAR; PG8_SCHED;
            PG8_LDA(At, 1, 1); PG8_STAGE(PG8_SB(1, 0), b3, voffB); PG8_STAGE(PG8_SB(1, 1), b3 + hstep, voffB); PG8_STAGE(PG8_SA(1, 0), a3, voffA);
            PG8_WAIT_V(8); PG8_WAIT_L(0); PG8_BAR; PG8_MMA(1, 0, At, B0); PG8_MMA(1, 1, At, B1); PG8_BAR; PG8_SCHED;
        }
        if (wr == 0) PG8_BAR;
        E(acc, cur, wr, wc, fr, fq);
        if (!has_next) break;
#pragma unroll
        for (int a = 0; a < 2; ++a)
#pragma unroll
            for (int b = 0; b < 2; ++b)
#pragma unroll
                for (int m = 0; m < 4; ++m)
#pragma unroll
                    for (int n = 0; n < 2; ++n) acc[a][b][m][n] = (f32x4){0.f, 0.f, 0.f, 0.f};
        cur = nxt; cA = nA; cB = nB; ++ui;
        if (wr == 1) PG8_BAR;
    }
    PG8_WAIT_V(0);
    PG8_BAR;
#undef PG8_SA
#undef PG8_SB
#undef PG8_STAGE
#undef PG8_LDA
#undef PG8_LDB
#undef PG8_MMA
#undef PG8_WAIT_V
#undef PG8_WAIT_L
#undef PG8_BAR
#undef PG8_SCHED
}

struct EpiSwiGLU {
    static constexpr bool PERM = true;
    bf16_t* H; const float* slots;
    DI void operator()(const f32x4 (&acc)[2][2][4][2], const Unit& u, int wr, int wc, int fr, int fq) const {
        const int col0 = u.pn * 128 + wc * 32 + 8 * fq;
        const int rowb = u.pm * BM + wr * 64 + fr;
        f32x4 sl[2][4];
#pragma unroll
        for (int ai = 0; ai < 2; ++ai)
#pragma unroll
            for (int m = 0; m < 4; ++m) sl[ai][m] = *(const f32x4*)(slots + (size_t)(rowb + ai * HALF + m * 16) * 16 + 4 * fq);
        asm volatile("" ::: "memory");
#pragma unroll
        for (int ai = 0; ai < 2; ++ai)
#pragma unroll
            for (int m = 0; m < 4; ++m) {
                const int row = rowb + ai * HALF + m * 16;
                float t = (sl[ai][m][0] + sl[ai][m][1]) + (sl[ai][m][2] + sl[ai][m][3]);
                t += __shfl_xor(t, 16); t += __shfl_xor(t, 32);
                const float rs = __builtin_amdgcn_rsqf(t * (1.0f / D) + EPS);
                float h[8];
#pragma unroll
                for (int n = 0; n < 2; ++n)
#pragma unroll
                    for (int j = 0; j < 4; ++j) { const float gv = acc[ai][0][m][n][j] * rs, uv = acc[ai][1][m][n][j] * rs; h[n * 4 + j] = fsilu(gv) * uv; }
                u32x4 w; w.x = pk2(h[0], h[1]); w.y = pk2(h[2], h[3]); w.z = pk2(h[4], h[5]); w.w = pk2(h[6], h[7]);
                *(u32x4*)(H + (size_t)row * FF + col0) = w;
            }
    }
};
struct EpiRes {
    static constexpr bool PERM = false;
    float* x; bf16_t* xb; float* slots; float s;
    DI void operator()(const f32x4 (&acc)[2][2][4][2], const Unit& u, int wr, int wc, int fr, int fq) const {
        const int col0 = u.pn * BM + wc * 32 + 4 * fq;
#pragma unroll
        for (int ai = 0; ai < 2; ++ai) {
            const int rowa = u.pm * BM + ai * HALF + wr * 64 + fr;
            f32x4 xo[4][2][2];
#pragma unroll
            for (int m = 0; m < 4; ++m)
#pragma unroll
                for (int bj = 0; bj < 2; ++bj)
#pragma unroll
                    for (int n = 0; n < 2; ++n) xo[m][bj][n] = *(const f32x4*)(x + (size_t)(rowa + m * 16) * D + col0 + bj * HALF + n * 16);
            asm volatile("" ::: "memory");
#pragma unroll
            for (int m = 0; m < 4; ++m) {
                const int row = rowa + m * 16;
                float* xr = x + (size_t)row * D + col0; bf16_t* br = xb + (size_t)row * D + col0;
                float ss = 0.f;
#pragma unroll
                for (int bj = 0; bj < 2; ++bj)
#pragma unroll
                    for (int n = 0; n < 2; ++n) {
                        const f32x4 xn = xo[m][bj][n] + acc[ai][bj][m][n] * s;
                        *(f32x4*)(xr + bj * HALF + n * 16) = xn;
                        u32x2 w; w.x = pk2(xn[0], xn[1]); w.y = pk2(xn[2], xn[3]);
                        *(u32x2*)(br + bj * HALF + n * 16) = w;
                        ss += (xn[0] * xn[0] + xn[1] * xn[1]) + (xn[2] * xn[2] + xn[3] * xn[3]);
                    }
                ss += __shfl_xor(ss, 16); ss += __shfl_xor(ss, 32);
                if (fq == 0) slots[(size_t)row * 16 + u.pn * 4 + wc] = ss;
            }
            asm volatile("" ::: "memory");
        }
    }
};
struct EpiZ {
    static constexpr bool PERM = true;
    bf16_t* Z; const float* slots; const float* cs; const float* sn;
    DI void operator()(const f32x4 (&acc)[2][2][4][2], const Unit& u, int wr, int wc, int fr, int fq) const {
        const int col0 = u.pn * BM + wc * 32 + 8 * fq;
        const bool rope = u.pn < 4; const float ksc = (u.pn >= 2) ? 0.08838834764831845f : 1.0f;
        const int fi = 4 * (4 * wc + fq);
        const int rowb = u.pm * BM + wr * 64 + fr;
        f32x4 sl[2][4];
#pragma unroll
        for (int ai = 0; ai < 2; ++ai)
#pragma unroll
            for (int m = 0; m < 4; ++m) sl[ai][m] = *(const f32x4*)(slots + (size_t)(rowb + ai * HALF + m * 16) * 16 + 4 * fq);
        asm volatile("" ::: "memory");
#pragma unroll
        for (int ai = 0; ai < 2; ++ai) {
            f32x4 c4[4], s4[4];
#pragma unroll
            for (int m = 0; m < 4; ++m) { c4[m] = (f32x4){1.f, 1.f, 1.f, 1.f}; s4[m] = (f32x4){0.f, 0.f, 0.f, 0.f}; }
            if (rope) {
#pragma unroll
                for (int m = 0; m < 4; ++m) { const int pos = (rowb + ai * HALF + m * 16) & (SEQ - 1); c4[m] = *(const f32x4*)(cs + pos * 64 + fi); s4[m] = *(const f32x4*)(sn + pos * 64 + fi); }
            }
            asm volatile("" ::: "memory");
#pragma unroll
            for (int m = 0; m < 4; ++m) {
                const int row = rowb + ai * HALF + m * 16;
                float t = (sl[ai][m][0] + sl[ai][m][1]) + (sl[ai][m][2] + sl[ai][m][3]);
                t += __shfl_xor(t, 16); t += __shfl_xor(t, 32);
                const float rs = __builtin_amdgcn_rsqf(t * (1.0f / D) + EPS);
#pragma unroll
                for (int bj = 0; bj < 2; ++bj) {
                    f32x4 v0 = acc[ai][bj][m][0] * rs, v1 = acc[ai][bj][m][1] * rs;
                    if (rope) { const f32x4 o0 = (v0 * c4[m] - v1 * s4[m]) * ksc, o1 = (v0 * s4[m] + v1 * c4[m]) * ksc; v0 = o0; v1 = o1; }
                    u32x4 w; w.x = pk2(v0[0], v0[1]); w.y = pk2(v0[2], v0[3]); w.z = pk2(v1[0], v1[1]); w.w = pk2(v1[2], v1[3]);
                    *(u32x4*)(Z + (size_t)row * INW + col0 + bj * HALF) = w;
                }
            }
            asm volatile("" ::: "memory");
        }
    }
};
template <bool SECOND> struct EpiGate {
    static constexpr bool PERM = true;
    const bf16_t* Zg; const float* bg; float* Y1; bf16_t* Mb;
    DI void operator()(const f32x4 (&acc)[2][2][4][2], const Unit& u, int wr, int wc, int fr, int fq) const {
        const int col0 = u.pn * BM + wc * 32 + 8 * fq;
        const int rowb = u.pm * BM + wr * 64 + fr;
        f32x4 bb[2][2];
#pragma unroll
        for (int bj = 0; bj < 2; ++bj) { bb[bj][0] = *(const f32x4*)(bg + col0 + bj * HALF); bb[bj][1] = *(const f32x4*)(bg + col0 + bj * HALF + 4); }
#pragma unroll
        for (int ai = 0; ai < 2; ++ai)
#pragma unroll
            for (int mp = 0; mp < 2; ++mp) {
                u32x4 zg[2][2]; f32x4 y0[2][2], y1[2][2];
#pragma unroll
                for (int mm = 0; mm < 2; ++mm)
#pragma unroll
                    for (int bj = 0; bj < 2; ++bj) { const int row = rowb + ai * HALF + (2 * mp + mm) * 16, col = col0 + bj * HALF;
                        zg[mm][bj] = *(const u32x4*)(Zg + (size_t)row * INW + col);
                        if (SECOND) { y0[mm][bj] = *(const f32x4*)(Y1 + (size_t)row * D + col); y1[mm][bj] = *(const f32x4*)(Y1 + (size_t)row * D + col + 4); } }
                asm volatile("" ::: "memory");
#pragma unroll
                for (int mm = 0; mm < 2; ++mm)
#pragma unroll
                    for (int bj = 0; bj < 2; ++bj) { const int m = 2 * mp + mm; const int row = rowb + ai * HALF + m * 16, col = col0 + bj * HALF;
                        const u32x4 z = zg[mm][bj]; const f32x4 b0 = bb[bj][0], b1 = bb[bj][1];
                        f32x4 g0, g1;
                        g0[0] = fsigmoid(bflo(z.x) + b0[0]); g0[1] = fsigmoid(bfhi(z.x) + b0[1]); g0[2] = fsigmoid(bflo(z.y) + b0[2]); g0[3] = fsigmoid(bfhi(z.y) + b0[3]);
                        g1[0] = fsigmoid(bflo(z.z) + b1[0]); g1[1] = fsigmoid(bfhi(z.z) + b1[1]); g1[2] = fsigmoid(bflo(z.w) + b1[2]); g1[3] = fsigmoid(bfhi(z.w) + b1[3]);
                        f32x4 v0 = g0 * acc[ai][bj][m][0], v1 = g1 * acc[ai][bj][m][1];
                        if (!SECOND) { float* yp = Y1 + (size_t)row * D + col; *(f32x4*)yp = v0; *(f32x4*)(yp + 4) = v1; }
                        else { v0 += y0[mm][bj]; v1 += y1[mm][bj];
                            u32x4 w; w.x = pk2(v0[0], v0[1]); w.y = pk2(v0[2], v0[3]); w.z = pk2(v1[0], v1[1]); w.w = pk2(v1[2], v1[3]);
                            *(u32x4*)(Mb + (size_t)row * D + col) = w; } }
                asm volatile("" ::: "memory");
            }
    }
};
}

struct Args { const float* in[20]; float* out; unsigned char* ws; };
typedef void* const __attribute__((address_space(4)))* kargp_t;
DI void* karg(int i) { kargp_t p = (kargp_t)__builtin_amdgcn_kernarg_segment_ptr(); asm volatile("" : "+s"(p)); return p[i]; }
DI const float* arg_in(int i) { return (const float*)karg(i); }
DI float* arg_out() { return (float*)karg(20); }
DI unsigned char* arg_ws() { return (unsigned char*)karg(21); }
enum { I_X = 0, I_RELB, I_NF1, I_G1, I_U1, I_D1, I_NMIX, I_WIN, I_BG, I_DEC, I_RNORM, I_WRO, I_QN, I_KN, I_WDO, I_WOUT, I_NF2, I_G2, I_U2, I_D2 };

DI int sigma_rope(int p) { return ((p & 4) ? 64 : 0) + 4 * (p >> 3) + (p & 3); }
DI void conv_item(int kind, const float* src, const float* src2, int ldsrc, const float* gain, int K, int N, bf16_t* Bt, LAS float* scr, int item, int lane) {
    const int nblk = N / 32, kb = item / nblk, nb = item % nblk, k0 = 64 * kb, n0 = 32 * nb;
    const int n = n0 + (lane & 31);
    const float* sp;
    if (kind == 1) { const int tile = n >> 8, r = n & 255; sp = (r < 128 ? src : src2) + tile * 128 + (r & 127); }
    else if (kind == 2) { sp = src + (n < 1024 ? (n & ~127) + sigma_rope(n & 127) : n); }
    else sp = src + n;
    float vv[32];
#pragma unroll
    for (int i = 0; i < 32; ++i) { const int kk = 2 * i + (lane >> 5); vv[i] = sp[(size_t)(k0 + kk) * ldsrc]; }
    if (gain) {
#pragma unroll
        for (int i = 0; i < 32; ++i) { const int kk = 2 * i + (lane >> 5); vv[i] *= gain[k0 + kk]; } }
#pragma unroll
    for (int i = 0; i < 32; ++i) { const int kk = 2 * i + (lane >> 5); scr[kk * 33 + (lane & 31)] = vv[i]; }
    asm volatile("s_waitcnt lgkmcnt(0)" ::: "memory");
    const int c = lane & 7;
#pragma unroll
    for (int j = 0; j < 4; ++j) { const int nn = (lane >> 3) + 8 * j; const LAS float* s = scr + (8 * c) * 33 + nn;
        u32x4 o; o.x = pk2(s[0 * 33], s[1 * 33]); o.y = pk2(s[2 * 33], s[3 * 33]); o.z = pk2(s[4 * 33], s[5 * 33]); o.w = pk2(s[6 * 33], s[7 * 33]);
        *(u32x4*)(Bt + (size_t)(n0 + nn) * K + k0 + 8 * c) = o; }
    asm volatile("s_waitcnt lgkmcnt(0)" ::: "memory");
}
DI int t5_bucket(int rel) {
    const int n = rel < 0 ? -rel : rel; int ret = rel > 0 ? 16 : 0;
    const float nf = (float)(n < 1 ? 1 : n);
    int large = 8 + (int)(logf(nf / 8.0f) / logf(128.0f) * 8.0f);
    large = large < 15 ? large : 15;
    return ret + (n < 8 ? n : large);
}
DI void prep_phase(LAS unsigned char* lds) {
    const int tid = opaque_tid(), lane = tid & 63, wave = tid >> 6;
    const int gw = opaque_bid() * 8 + wave, NGW = gridDim.x * 8;
    const int gt = opaque_bid() * NTHREADS + tid, NGT = gridDim.x * NTHREADS;
    unsigned char* ws = arg_ws();
    {
        bf16_t* xb = (bf16_t*)(ws + WS_XB); float* slots = (float*)(ws + WS_SLOT);
        for (int row = gw; row < NTOK; row += NGW) {
            const f32x4* xr = (const f32x4*)(arg_in(I_X) + (size_t)row * D) + lane;
            f32x4* orow = (f32x4*)(arg_out() + (size_t)row * D) + lane;
            u32x2* brow = (u32x2*)(xb + (size_t)row * D) + lane;
            float ss = 0.f;
#pragma unroll
            for (int j = 0; j < 4; ++j) { const f32x4 v = xr[64 * j]; orow[64 * j] = v; u32x2 w; w.x = pk2(v[0], v[1]); w.y = pk2(v[2], v[3]); brow[64 * j] = w;
                ss += (v[0] * v[0] + v[1] * v[1]) + (v[2] * v[2] + v[3] * v[3]); }
#pragma unroll
            for (int o = 1; o < 64; o <<= 1) ss += __shfl_xor(ss, o);
            if (lane < 16) slots[(size_t)row * 16 + lane] = lane == 0 ? ss : 0.f;
        }
    }
    {
        float* cs = (float*)(ws + WS_ROPE); float* sn = cs + SEQ * 64;
        for (int i = gt; i < SEQ * 64; i += NGT) { const int pos = i >> 6, f = i & 63;
            const float inv = powf(10000.0f, -(float)f / 64.0f); const float ang = (float)pos * inv; cs[i] = cosf(ang); sn[i] = sinf(ang); }
    }
    {
        float* bt = (float*)(ws + WS_BIAS);
        for (int i = gt; i < 12 * 129; i += NGT) { const int hh = i / 129, dl = i % 129 - 64; const int gi = hh >> 2, d = gi == 0 ? 1 : (gi == 1 ? 4 : 16);
            bt[i] = arg_in(I_RELB)[t5_bucket(dl * d) * 12 + hh]; }
    }
    {
        LAS float* scr = (LAS float*)(lds + wave * 16384);
        constexpr int I_GU = 16 * 176, I_DN = 44 * 32, I_IN = 16 * 304, I_RO = 16 * 32, I_DO = 8 * 32, I_OU = 16 * 32;
        constexpr int PER_LAYER = 2 * I_GU + 2 * I_DN + I_IN + I_RO + I_DO + I_OU;
        for (int it = gw; it < DEPTH * PER_LAYER; it += NGW) {
            const int l = it / PER_LAYER; int r = it % PER_LAYER;
            unsigned char* wl = ws + WS_W + (size_t)l * LW;
            if (r < I_GU) { conv_item(1, arg_in(I_G1) + (size_t)l * D * FF, arg_in(I_U1) + (size_t)l * D * FF, FF, arg_in(I_NF1) + l * D, D, 5632, (bf16_t*)(wl + OW_GU1), scr, r, lane); continue; } r -= I_GU;
            if (r < I_GU) { conv_item(1, arg_in(I_G2) + (size_t)l * D * FF, arg_in(I_U2) + (size_t)l * D * FF, FF, arg_in(I_NF2) + l * D, D, 5632, (bf16_t*)(wl + OW_GU2), scr, r, lane); continue; } r -= I_GU;
            if (r < I_DN) { conv_item(0, arg_in(I_D1) + (size_t)l * FF * D, nullptr, D, nullptr, FF, D, (bf16_t*)(wl + OW_D1), scr, r, lane); continue; } r -= I_DN;
            if (r < I_DN) { conv_item(0, arg_in(I_D2) + (size_t)l * FF * D, nullptr, D, nullptr, FF, D, (bf16_t*)(wl + OW_D2), scr, r, lane); continue; } r -= I_DN;
            if (r < I_IN) { conv_item(2, arg_in(I_WIN) + (size_t)l * D * INW, nullptr, INW, arg_in(I_NMIX) + l * D, D, INW, (bf16_t*)(wl + OW_IN), scr, r, lane); continue; } r -= I_IN;
            if (r < I_RO) { conv_item(0, arg_in(I_WRO) + (size_t)l * D * D, nullptr, D, nullptr, D, D, (bf16_t*)(wl + OW_RO), scr, r, lane); continue; } r -= I_RO;
            if (r < I_DO) { conv_item(0, arg_in(I_WDO) + (size_t)l * 512 * D, nullptr, D, nullptr, 512, D, (bf16_t*)(wl + OW_DO), scr, r, lane); continue; } r -= I_DO;
            conv_item(0, arg_in(I_WOUT) + (size_t)l * D * D, nullptr, D, nullptr, D, D, (bf16_t*)(wl + OW_OUT), scr, r, lane);
        }
    }
}

constexpr int RV_PITCH = 528, RK_PITCH = 272;
DI void ret_kv_phase(int l, unsigned char* lds_g, LAS unsigned char* lds) {
    const int tid = opaque_tid(), lane = tid & 63, w = tid >> 6, fr = lane & 15, fq = lane >> 4;
    const unsigned lbase = (unsigned)(size_t)lds_g;
    const bf16_t* Z = (const bf16_t*)(arg_ws() + WS_Z); bf16_t* KV = (bf16_t*)(arg_ws() + WS_KV);
    constexpr int OV = 0, OKF = 128 * RV_PITCH, OKB = OKF + 128 * RK_PITCH;
    for (int item = opaque_bid(); item < GB * 4 * 32; item += gridDim.x) {
        const int n = item & 31, h = (item >> 5) & 3, bl = item >> 7;
        const size_t row0 = (size_t)bl * SEQ + n * 128;
        const float de_f = arg_in(I_DEC)[(l * 2 + 0) * 4 + h], de_b = arg_in(I_DEC)[(l * 2 + 1) * 4 + h];
        const float l2f = log1pf(-exp2f(-de_f)) * 1.44269504f, l2b = log1pf(-exp2f(-de_b)) * 1.44269504f;
#pragma unroll
        for (int i = 0; i < 8; ++i) { const int id = tid + 512 * i, r = id >> 5, ch = id & 31;
            const u32x4 v = *(const u32x4*)(Z + (row0 + r) * INW + ZC_RV + h * 256 + ch * 8);
            *(LAS u32x4*)(lds + OV + r * RV_PITCH + ch * 16) = v; }
#pragma unroll
        for (int i = 0; i < 4; ++i) { const int id = tid + 512 * i, r = id >> 4, ch = id & 15;
            const u32x4 v = *(const u32x4*)(Z + (row0 + r) * INW + ZC_RK + h * 128 + ch * 8);
            const float sf = fexp2(l2f * (float)(127 - r)), sb = fexp2(l2b * (float)r);
            u32x4 f, b;
            f.x = pk2(bflo(v.x) * sf, bfhi(v.x) * sf); f.y = pk2(bflo(v.y) * sf, bfhi(v.y) * sf); f.z = pk2(bflo(v.z) * sf, bfhi(v.z) * sf); f.w = pk2(bflo(v.w) * sf, bfhi(v.w) * sf);
            b.x = pk2(bflo(v.x) * sb, bfhi(v.x) * sb); b.y = pk2(bflo(v.y) * sb, bfhi(v.y) * sb); b.z = pk2(bflo(v.z) * sb, bfhi(v.z) * sb); b.w = pk2(bflo(v.w) * sb, bfhi(v.w) * sb);
            *(LAS u32x4*)(lds + OKF + r * RK_PITCH + ch * 16) = f; *(LAS u32x4*)(lds + OKB + r * RK_PITCH + ch * 16) = b; }
        __syncthreads();
        f32x4 acc[2][8][2];
#pragma unroll
        for (int d = 0; d < 2; ++d)
#pragma unroll
            for (int mt = 0; mt < 8; ++mt)
#pragma unroll
                for (int nt = 0; nt < 2; ++nt) acc[d][mt][nt] = (f32x4){0.f, 0.f, 0.f, 0.f};
        const int q = fr >> 2, p = fr & 3;
#pragma unroll 1
        for (int ks = 0; ks < 4; ++ks) {
            const int tr0 = 32 * ks + 8 * fq + q;
            bf16x8 Bv[2];
#pragma unroll
            for (int nt = 0; nt < 2; ++nt) { const unsigned ad = lbase + OV + tr0 * RV_PITCH + (32 * w + 16 * nt + 4 * p) * 2; Bv[nt] = tr_frag(ad, ad + 4 * RV_PITCH); }
#pragma unroll
            for (int d = 0; d < 2; ++d) { const unsigned ad = lbase + (d ? OKB : OKF) + tr0 * RK_PITCH + (4 * p) * 2; bf16x8 Ak[8]; tr8(ad, ad + 4 * RK_PITCH, Ak);
#pragma unroll
                for (int mt = 0; mt < 8; ++mt)
#pragma unroll
                    for (int nt = 0; nt < 2; ++nt) acc[d][mt][nt] = mfma16(Ak[mt], Bv[nt], acc[d][mt][nt]); }
        }
#pragma unroll
        for (int d = 0; d < 2; ++d)
#pragma unroll
            for (int nt = 0; nt < 2; ++nt)
#pragma unroll
                for (int mt = 0; mt < 8; ++mt)
                    { u32x2 o; o.x = pk2(acc[d][mt][nt][0], acc[d][mt][nt][1]); o.y = pk2(acc[d][mt][nt][2], acc[d][mt][nt][3]);
                      *(u32x2*)(KV + (((size_t)item * 2 + d) * 256 + 32 * w + 16 * nt + fr) * 128 + 16 * mt + 4 * fq) = o; }
        __syncthreads();
    }
}

struct DilIt { int hh, d, L, i0; size_t rowb; };
DI DilIt dil_decode(int item) {
    DilIt it; const int blk = item & 31; it.hh = (item >> 5) % 12; const int bl = item / (32 * 12);
    const int gi = it.hh >> 2; it.d = gi == 0 ? 1 : (gi == 1 ? 4 : 16); it.L = SEQ / it.d; const int bpc = it.L / 128;
    const int r = blk / bpc, qb = blk % bpc; it.i0 = 128 * qb; it.rowb = (size_t)bl * SEQ + r; return it;
}
DI void dil_issue(const bf16_t* Z, const DilIt& it, int tid, u32x4 (&kraw)[8], u32x4 (&vraw)[8]) {
#pragma unroll
    for (int i = 0; i < 8; ++i) { const int id = tid + 512 * i, kk = id >> 4, ch = id & 15; const int j = it.i0 - 64 + kk; const bool ok = (j >= 0) && (j < it.L);
        kraw[i] = (u32x4){0u, 0u, 0u, 0u}; vraw[i] = (u32x4){0u, 0u, 0u, 0u};
        if (ok) { const bf16_t* zr = Z + (it.rowb + (size_t)j * it.d) * INW; kraw[i] = *(const u32x4*)(zr + ZC_DK + it.hh * 128 + ch * 8); vraw[i] = *(const u32x4*)(zr + ZC_DV + it.hh * 128 + ch * 8); } }
}
DI void dil_issue_q(const bf16_t* Z, const DilIt& it, int w, int fr, int fq, u32x4 (&qraw)[4]) {
    const size_t qrow = it.rowb + (size_t)(it.i0 + 16 * w + fr) * it.d;
#pragma unroll
    for (int ks = 0; ks < 4; ++ks) qraw[ks] = *(const u32x4*)(Z + qrow * INW + ZC_DQ + it.hh * 128 + 32 * ks + 8 * fq);
}
template <bool STORE = true> DI void dil_attn_phase(int l, unsigned char* lds_g, LAS unsigned char* lds) {
    const int tid = opaque_tid(), lane = tid & 63, w = tid >> 6, fr = lane & 15, fq = lane >> 4;
    const unsigned lbase = (unsigned)(size_t)lds_g;
    bf16_t* Z = (bf16_t*)(arg_ws() + WS_Z); float* LSE = (float*)(arg_ws() + WS_LSE);
    const float* bt = (const float*)(arg_ws() + WS_BIAS);
    const float* qn = arg_in(I_QN) + l * 128; const float* kn = arg_in(I_KN) + l * 128;
    constexpr int KP = 272, OK = 0, OV = 256 * KP, OB = 2 * 256 * KP, NITEM = GB * 12 * 32;
    int item; { const int bx = opaque_bid(), G = (int)gridDim.x; item = (G % 8 == 0) ? (bx % 8) * (G / 8) + bx / 8 : bx; }
    if (item >= NITEM) return;
    u32x4 kraw[8], vraw[8];
    DilIt it = dil_decode(item);
    dil_issue(Z, it, tid, kraw, vraw);
    for (;;) {
        const int hh = it.hh, d = it.d, L = it.L, i0 = it.i0; const size_t rowb = it.rowb;
        u32x4 qraw[4]; dil_issue_q(Z, it, w, fr, fq, qraw);
#pragma unroll
        for (int i = 0; i < 8; ++i) { const int id = tid + 512 * i, kk = id >> 4, ch = id & 15;
            const u32x4 kv = kraw[i];
            float f[8] = {bflo(kv.x), bfhi(kv.x), bflo(kv.y), bfhi(kv.y), bflo(kv.z), bfhi(kv.z), bflo(kv.w), bfhi(kv.w)};
            float ss = 0.f;
#pragma unroll
            for (int e = 0; e < 8; ++e) ss += f[e] * f[e];
            ss += __shfl_xor(ss, 1); ss += __shfl_xor(ss, 2); ss += __shfl_xor(ss, 4); ss += __shfl_xor(ss, 8);
            const float rs = __builtin_amdgcn_rsqf(ss * (1.0f / 128.0f) + EPS);
            const f32x4 g0 = *(const f32x4*)(kn + ch * 8), g1 = *(const f32x4*)(kn + ch * 8 + 4);
            u32x4 ko; ko.x = pk2(f[0] * rs * g0[0], f[1] * rs * g0[1]); ko.y = pk2(f[2] * rs * g0[2], f[3] * rs * g0[3]); ko.z = pk2(f[4] * rs * g1[0], f[5] * rs * g1[1]); ko.w = pk2(f[6] * rs * g1[2], f[7] * rs * g1[3]);
            *(LAS u32x4*)(lds + OK + kk * KP + ch * 16) = ko; *(LAS u32x4*)(lds + OV + kk * KP + ch * 16) = vraw[i];
            asm volatile("" ::: "memory"); }
        if (tid < 129) *(LAS float*)(lds + OB + tid * 4) = bt[hh * 129 + tid];
        const size_t qrow = rowb + (size_t)(i0 + 16 * w + fr) * d;
        bf16x8 Qf[4];
        {
            float ss = 0.f;
#pragma unroll
            for (int ks = 0; ks < 4; ++ks) { const u32x4 v = qraw[ks];
                ss += bflo(v.x) * bflo(v.x) + bfhi(v.x) * bfhi(v.x) + bflo(v.y) * bflo(v.y) + bfhi(v.y) * bfhi(v.y) + bflo(v.z) * bflo(v.z) + bfhi(v.z) * bfhi(v.z) + bflo(v.w) * bflo(v.w) + bfhi(v.w) * bfhi(v.w); }
            ss += __shfl_xor(ss, 16); ss += __shfl_xor(ss, 32);
            const float rs = __builtin_amdgcn_rsqf(ss * (1.0f / 128.0f) + EPS) * 0.08838834764831845f;
#pragma unroll
            for (int ks = 0; ks < 4; ++ks) { const u32x4 v = qraw[ks]; const f32x4 g0 = *(const f32x4*)(qn + 32 * ks + 8 * fq), g1 = *(const f32x4*)(qn + 32 * ks + 8 * fq + 4);
                u32x4 o; o.x = pk2(bflo(v.x) * rs * g0[0], bfhi(v.x) * rs * g0[1]); o.y = pk2(bflo(v.y) * rs * g0[2], bfhi(v.y) * rs * g0[3]);
                o.z = pk2(bflo(v.z) * rs * g1[0], bfhi(v.z) * rs * g1[1]); o.w = pk2(bflo(v.w) * rs * g1[2], bfhi(v.w) * rs * g1[3]); Qf[ks] = as_frag(o); }
        }
        __syncthreads();
        const int nitem = item + (int)gridDim.x; const bool has_next = nitem < NITEM;
        if (has_next) { it = dil_decode(nitem); dil_issue(Z, it, tid, kraw, vraw); }
        f32x4 sc[9];
#pragma unroll
        for (int jt = 0; jt < 9; ++jt) { f32x4 s = (f32x4){0.f, 0.f, 0.f, 0.f};
#pragma unroll
            for (int ks = 0; ks < 4; ++ks) { const bf16x8 kf = *(const LAS bf16x8*)(lds + OK + (16 * w + 16 * jt + fr) * KP + (32 * ks + 8 * fq) * 2); s = mfma16(kf, Qf[ks], s); }
            sc[jt] = s; if (jt % 3 == 2) asm volatile("" ::: "memory"); }
        float mx = -3.0e38f;
        int dlo = 4 * fq - 64 - fr; asm volatile("" : "+v"(dlo));
#pragma unroll
        for (int jt = 0; jt < 9; ++jt)
#pragma unroll
            for (int e = 0; e < 4; ++e) { const int dl = 16 * jt + e + dlo; const int j = i0 + 16 * w + fr + dl;
                const bool ok = (dl >= -64) && (dl <= 64) && (j >= 0) && (j < L);
                const int bi = dl < -64 ? 0 : (dl > 64 ? 128 : dl + 64);
                const float v = ok ? sc[jt][e] + *(const LAS float*)(lds + OB + bi * 4) : -1.0e30f; sc[jt][e] = v; mx = fmaxf(mx, v); }
        mx = fmaxf(mx, __shfl_xor(mx, 16)); mx = fmaxf(mx, __shfl_xor(mx, 32));
        float den = 0.f;
#pragma unroll
        for (int jt = 0; jt < 9; ++jt)
#pragma unroll
            for (int e = 0; e < 4; ++e) { const float pv = fexp2((sc[jt][e] - mx) * 1.44269504f); sc[jt][e] = pv; den += pv; }
        den += __shfl_xor(den, 16); den += __shfl_xor(den, 32);
        f32x4 oc[8];
#pragma unroll
        for (int c = 0; c < 8; ++c) oc[c] = (f32x4){0.f, 0.f, 0.f, 0.f};
        const int q = fr >> 2, p = fr & 3;
#pragma unroll
        for (int kp = 0; kp < 5; ++kp) {
            u32x4 pw; pw.x = pk2(sc[2 * kp][0], sc[2 * kp][1]); pw.y = pk2(sc[2 * kp][2], sc[2 * kp][3]);
            if (kp < 4) { pw.z = pk2(sc[2 * kp + 1 > 8 ? 8 : 2 * kp + 1][0], sc[2 * kp + 1 > 8 ? 8 : 2 * kp + 1][1]); pw.w = pk2(sc[2 * kp + 1 > 8 ? 8 : 2 * kp + 1][2], sc[2 * kp + 1 > 8 ? 8 : 2 * kp + 1][3]); }
            else { pw.z = 0u; pw.w = 0u; }
            const bf16x8 Pf = as_frag(pw);
            const int ra = 16 * w + 32 * kp + 4 * fq + q, rb = kp < 4 ? ra + 16 : ra;
            bf16x8 Vf[8]; tr8(lbase + OV + ra * KP + (4 * p) * 2, lbase + OV + rb * KP + (4 * p) * 2, Vf);
#pragma unroll
            for (int c = 0; c < 8; ++c) oc[c] = mfma16(Vf[c], Pf, oc[c]);
        }
        const float rden = 1.0f / den;
        if (STORE || den == -1.0f) {
#pragma unroll
        for (int c = 0; c < 8; ++c) { u32x2 o; o.x = pk2(oc[c][0] * rden, oc[c][1] * rden); o.y = pk2(oc[c][2] * rden, oc[c][3] * rden);
            *(u32x2*)(Z + qrow * INW + ZC_DQ + hh * 128 + 16 * c + 4 * fq) = o; }
        if (fq == 0) LSE[qrow * 12 + hh] = mx + logf(den);
        }
        if (!has_next) break;
        item = nitem;
        __syncthreads();
    }
    __syncthreads();
}

DI void scan_combine_phase(int l) {
    const int gt = opaque_bid() * NTHREADS + opaque_tid(), NGT = gridDim.x * NTHREADS;
    const u32x2* KV = (const u32x2*)(arg_ws() + WS_KV); u32x2* S = (u32x2*)(arg_ws() + WS_S);
    for (int v = gt; v < GB * 4 * 2 * 8192; v += NGT) {
        const int bh = v >> 14, dir = (v >> 13) & 1, e4 = v & 8191, h = bh & 3;
        const float de = arg_in(I_DEC)[(l * 2 + dir) * 4 + h];
        const float cd = exp2f(log1pf(-exp2f(-de)) * 1.44269504f * 128.0f);
        u32x2 kw[32];
#pragma unroll
        for (int step = 0; step < 32; ++step) { const int n = dir ? 31 - step : step; kw[step] = KV[((size_t)(bh * 32 + n) * 2 + dir) * 8192 + e4]; }
        f32x4 st = (f32x4){0.f, 0.f, 0.f, 0.f};
#pragma unroll
        for (int step = 0; step < 32; ++step) { const int n = dir ? 31 - step : step; const size_t idx = ((size_t)(bh * 32 + n) * 2 + dir) * 8192 + e4;
            u32x2 o; o.x = pk2(st[0], st[1]); o.y = pk2(st[2], st[3]); S[idx] = o;
            const f32x4 kv = (f32x4){bflo(kw[step].x), bfhi(kw[step].x), bflo(kw[step].y), bfhi(kw[step].y)}; st = st * cd + kv; }
    }
    const bf16_t* Z = (const bf16_t*)(arg_ws() + WS_Z); const float* LSE = (const float*)(arg_ws() + WS_LSE); bf16_t* DL = (bf16_t*)(arg_ws() + WS_DL);
    for (int id = gt; id < GT * 64; id += NGT) {
        const int tok = id >> 6, j = (id >> 4) & 3, ch = id & 15;
        const float l0 = LSE[tok * 12 + j], l1 = LSE[tok * 12 + 4 + j], l2 = LSE[tok * 12 + 8 + j];
        const float mx = fmaxf(l0, fmaxf(l1, l2));
        float w0 = __expf(l0 - mx), w1 = __expf(l1 - mx), w2 = __expf(l2 - mx); const float rw = 1.0f / (w0 + w1 + w2); w0 *= rw; w1 *= rw; w2 *= rw;
        const bf16_t* zr = Z + (size_t)tok * INW + ZC_DQ + j * 128 + ch * 8;
        const u32x4 a0 = *(const u32x4*)zr, a1 = *(const u32x4*)(zr + 512), a2 = *(const u32x4*)(zr + 1024);
        u32x4 o;
        o.x = pk2(w0 * bflo(a0.x) + w1 * bflo(a1.x) + w2 * bflo(a2.x), w0 * bfhi(a0.x) + w1 * bfhi(a1.x) + w2 * bfhi(a2.x));
        o.y = pk2(w0 * bflo(a0.y) + w1 * bflo(a1.y) + w2 * bflo(a2.y), w0 * bfhi(a0.y) + w1 * bfhi(a1.y) + w2 * bfhi(a2.y));
        o.z = pk2(w0 * bflo(a0.z) + w1 * bflo(a1.z) + w2 * bflo(a2.z), w0 * bfhi(a0.z) + w1 * bfhi(a1.z) + w2 * bfhi(a2.z));
        o.w = pk2(w0 * bflo(a0.w) + w1 * bflo(a1.w) + w2 * bflo(a2.w), w0 * bfhi(a0.w) + w1 * bfhi(a1.w) + w2 * bfhi(a2.w));
        *(u32x4*)(DL + (size_t)tok * 512 + j * 128 + ch * 8) = o;
    }
}

DI void ret_out_phase(int l, unsigned char* lds_g, LAS unsigned char* lds) {
    const int tid = opaque_tid(), lane = tid & 63, w = tid >> 6, fr = lane & 15, fq = lane >> 4;
    const unsigned lbase = (unsigned)(size_t)lds_g;
    const bf16_t* Z = (const bf16_t*)(arg_ws() + WS_Z); const bf16_t* S = (const bf16_t*)(arg_ws() + WS_S); bf16_t* R = (bf16_t*)(arg_ws() + WS_R);
    const float* rn = arg_in(I_RNORM) + l * 1024;
    constexpr int OQ = 0, OKP = 128 * RK_PITCH, OV = 2 * 128 * RK_PITCH, OT = OV + 128 * RV_PITCH;
    for (int item = opaque_bid(); item < GB * 4 * 32; item += gridDim.x) {
        const int n = item & 31, h = (item >> 5) & 3, bl = item >> 7;
        const size_t row0 = (size_t)bl * SEQ + n * 128;
        const float de_f = arg_in(I_DEC)[(l * 2 + 0) * 4 + h], de_b = arg_in(I_DEC)[(l * 2 + 1) * 4 + h];
        const float l2f = log1pf(-exp2f(-de_f)) * 1.44269504f, l2b = log1pf(-exp2f(-de_b)) * 1.44269504f;
#pragma unroll
        for (int i = 0; i < 8; ++i) { const int id = tid + 512 * i, r = id >> 5, ch = id & 31;
            *(LAS u32x4*)(lds + OV + r * RV_PITCH + ch * 16) = *(const u32x4*)(Z + (row0 + r) * INW + ZC_RV + h * 256 + ch * 8); }
#pragma unroll
        for (int i = 0; i < 4; ++i) { const int id = tid + 512 * i, r = id >> 4, ch = id & 15;
            *(LAS u32x4*)(lds + OQ + r * RK_PITCH + ch * 16) = *(const u32x4*)(Z + (row0 + r) * INW + ZC_RQ + h * 128 + ch * 8);
            *(LAS u32x4*)(lds + OKP + r * RK_PITCH + ch * 16) = *(const u32x4*)(Z + (row0 + r) * INW + ZC_RK + h * 128 + ch * 8); }
        __syncthreads();
        {
            bf16x8 Qf[4];
#pragma unroll
            for (int ks = 0; ks < 4; ++ks) Qf[ks] = *(const LAS bf16x8*)(lds + OQ + (16 * w + fr) * RK_PITCH + (32 * ks + 8 * fq) * 2);
            u32x2 pw[8];
            const int i = 16 * w + fr;
#pragma unroll
            for (int jt = 0; jt < 8; ++jt) { f32x4 s = (f32x4){0.f, 0.f, 0.f, 0.f};
#pragma unroll
                for (int ks = 0; ks < 4; ++ks) { const bf16x8 kf = *(const LAS bf16x8*)(lds + OKP + (16 * jt + fr) * RK_PITCH + (32 * ks + 8 * fq) * 2); s = mfma16(kf, Qf[ks], s); }
                int io = i - 4 * fq; asm volatile("" : "+v"(io));
#pragma unroll
                for (int e = 0; e < 4; ++e) { const int x = io - (16 * jt + e); const float dm = fexp2(x >= 0 ? l2f * (float)x : l2b * (float)(-x)); s[e] *= dm; }
                pw[jt].x = pk2(s[0], s[1]); pw[jt].y = pk2(s[2], s[3]); asm volatile("" ::: "memory"); }
            __syncthreads();
#pragma unroll
            for (int jt = 0; jt < 8; ++jt) *(LAS u32x2*)(lds + OKP + i * RK_PITCH + (16 * jt + 4 * fq) * 2) = pw[jt];
        }
        __syncthreads();
        f32x4 O[2][8];
        {
            const int q = fr >> 2, p = fr & 3;
#pragma unroll 1
            for (int dir = 0; dir < 2; ++dir) {
                const bf16_t* Sd = S + (((size_t)item * 2 + dir) * 256 + 32 * w) * 128;
#pragma unroll
                for (int m = 0; m < 2; ++m) {
                    f32x4 T[8];
#pragma unroll
                    for (int nt = 0; nt < 8; ++nt) T[nt] = (f32x4){0.f, 0.f, 0.f, 0.f};
                    u32x4 Sf4[4];
#pragma unroll
                    for (int ks = 0; ks < 4; ++ks) Sf4[ks] = *(const u32x4*)(Sd + (16 * m + fr) * 128 + 32 * ks + 8 * fq);
                    asm volatile("" ::: "memory");
#pragma unroll
                    for (int ks = 0; ks < 4; ++ks) {
                        const bf16x8 Af = as_frag(Sf4[ks]);
#pragma unroll
                        for (int nt = 0; nt < 8; ++nt) { const bf16x8 qf = *(const LAS bf16x8*)(lds + OQ + (16 * nt + fr) * RK_PITCH + (32 * ks + 8 * fq) * 2); T[nt] = mfma16(Af, qf, T[nt]); }
                        asm volatile("" ::: "memory");
                    }
                    int fro = fr; asm volatile("" : "+v"(fro));
#pragma unroll
                    for (int nt = 0; nt < 8; ++nt) { const int i = 16 * nt + fro; const float sc = dir ? fexp2(l2b * (float)(128 - i)) : fexp2(l2f * (float)(i + 1));
                        if (dir) O[m][nt] += T[nt] * sc; else O[m][nt] = T[nt] * sc; }
                    asm volatile("" ::: "memory");
                }
            }
#pragma unroll 1
            for (int ks = 0; ks < 4; ++ks) {
                bf16x8 Vf[2];
                const int tr0 = 32 * ks + 8 * fq + q;
#pragma unroll
                for (int m = 0; m < 2; ++m) { const unsigned ad = lbase + OV + tr0 * RV_PITCH + (32 * w + 16 * m + 4 * p) * 2; Vf[m] = tr_frag(ad, ad + 4 * RV_PITCH); }
#pragma unroll
                for (int nt = 0; nt < 8; ++nt) { const bf16x8 pf = *(const LAS bf16x8*)(lds + OKP + (16 * nt + fr) * RK_PITCH + (32 * ks + 8 * fq) * 2);
#pragma unroll
                    for (int m = 0; m < 2; ++m) O[m][nt] = mfma16(Vf[m], pf, O[m][nt]); }
            }
        }
#pragma unroll
        for (int nt = 0; nt < 8; ++nt) { float ss = 0.f;
#pragma unroll
            for (int m = 0; m < 2; ++m)
#pragma unroll
                for (int e = 0; e < 4; ++e) ss += O[m][nt][e] * O[m][nt][e];
            ss += __shfl_xor(ss, 16); ss += __shfl_xor(ss, 32);
            if (fq == 0) *(LAS float*)(lds + OT + (w * 128 + 16 * nt + fr) * 4) = ss; }
        __syncthreads();
#pragma unroll
        for (int nt = 0; nt < 8; ++nt) { const int i = 16 * nt + fr; float tot = 0.f;
#pragma unroll
            for (int ww = 0; ww < 8; ++ww) tot += *(const LAS float*)(lds + OT + (ww * 128 + i) * 4);
            const float rinv = __builtin_amdgcn_rsqf(tot * (1.0f / 256.0f) + EPS);
#pragma unroll
            for (int m = 0; m < 2; ++m) { const int dv = h * 256 + 32 * w + 16 * m + 4 * fq;
                const u32x2 gz = *(const u32x2*)(Z + (row0 + i) * INW + ZC_RG + dv); const f32x4 gn = *(const f32x4*)(rn + dv);
                const float o0 = O[m][nt][0] * rinv * gn[0] * fsilu(bflo(gz.x)), o1 = O[m][nt][1] * rinv * gn[1] * fsilu(bfhi(gz.x));
                const float o2 = O[m][nt][2] * rinv * gn[2] * fsilu(bflo(gz.y)), o3 = O[m][nt][3] * rinv * gn[3] * fsilu(bfhi(gz.y));
                u32x2 o; o.x = pk2(o0, o1); o.y = pk2(o2, o3);
                *(u32x2*)(R + (row0 + i) * 1024 + dv) = o; }
            asm volatile("" ::: "memory"); }
        __syncthreads();
    }
}

#ifndef PHMASK
#define PHMASK 0xffff
#endif
#define PH(k) ((PHMASK >> (k)) & 1)

#define XB_TMO      128
#define XB_XCNT(j)  (256  + 64 * (j))
#define XB_XSUB(j)  (1280 + 64 * (j))
#define XB_XGEN(j)  (2304 + 64 * (j))
#define XB_TOP      3328
#define XB_TOPGEN   3392
#define XCD_BAR_WORDS 3456
#define XB_SPIN_CAP (1u << 22)
DI unsigned xb_ld(unsigned* p)              { return __hip_atomic_load(p, __ATOMIC_RELAXED, __HIP_MEMORY_SCOPE_AGENT); }
DI unsigned xb_add(unsigned* p, unsigned v) { return __hip_atomic_fetch_add(p, v, __ATOMIC_RELAXED, __HIP_MEMORY_SCOPE_AGENT); }
DI unsigned xb_xcc_id() { return (unsigned)__builtin_amdgcn_s_getreg((3 << 11) | 20) & 0xFu; }
#define XB_SPIN(cond, bar) do { unsigned _sp = 0; while (cond) { __builtin_amdgcn_s_sleep(1); \
    if ((++_sp & 255u) == 0u) { if (xb_ld(&(bar)[XB_TMO])) break; if (_sp > XB_SPIN_CAP) { atomicAdd(&(bar)[XB_TMO], 1u); break; } } } } while (0)
DI void xcd_barrier_complete(unsigned* bar, unsigned x, unsigned& nloc, unsigned& nx) {
    const unsigned G = gridDim.x * gridDim.y * gridDim.z;
    unsigned sum, cnt, mine, sp = 0u;
    for (;;) {
        sum = 0u; cnt = 0u; mine = 0u;
#pragma unroll
        for (unsigned j = 0; j < 16; ++j) { const unsigned c = xb_ld(&bar[XB_XCNT(j)]); sum += c; cnt += (c > 0u) ? 1u : 0u; mine = (j == x) ? c : mine; }
        if (sum == G) break;
        __builtin_amdgcn_s_sleep(1);
        if ((++sp & 255u) == 0u) { if (xb_ld(&bar[XB_TMO])) break; if (sp > XB_SPIN_CAP) { atomicAdd(&bar[XB_TMO], 1u); break; } }
    }
    nloc = mine > 0u ? mine : 1u; nx = cnt > 0u ? cnt : 1u;
}
DI void xcd_barrier(unsigned* bar, volatile LAS unsigned* st) {
    asm volatile("s_waitcnt vmcnt(0)" ::: "memory");
    __syncthreads();
    if (threadIdx.x == 0) {
        __builtin_amdgcn_s_waitcnt(0);
        const unsigned x = xb_xcc_id();
        unsigned nloc = st[0], nx = st[1];
        if (nloc == 0u) { xcd_barrier_complete(bar, x, nloc, nx); st[0] = nloc; st[1] = nx; }
        const unsigned old = xb_add(&bar[XB_XSUB(x)], 1u);
        const unsigned gen = old / nloc;
        if (old + 1u == (gen + 1u) * nloc) {
            __builtin_amdgcn_fence(__ATOMIC_RELEASE, "agent");
            asm volatile("s_waitcnt vmcnt(0)" ::: "memory");
            const unsigned og = xb_add(&bar[XB_TOP], 1u);
            const unsigned tg = og / nx;
            if (og + 1u == (tg + 1u) * nx) xb_add(&bar[XB_TOPGEN], 1u);
            else XB_SPIN(xb_ld(&bar[XB_TOPGEN]) == tg, bar);
            __builtin_amdgcn_fence(__ATOMIC_ACQUIRE, "agent");
            xb_add(&bar[XB_XGEN(x)], 1u);
            asm volatile("s_waitcnt vmcnt(0)" ::: "memory");
        } else {
            XB_SPIN(xb_ld(&bar[XB_XGEN(x)]) == gen, bar);
            __builtin_amdgcn_fence(__ATOMIC_ACQUIRE, "agent");
            asm volatile("s_waitcnt vmcnt(0)" ::: "memory");
        }
    }
    __syncthreads();
}

DI void ph_win(LAS unsigned char* lds, int l, int g) {
    unsigned char* ws = arg_ws(); const size_t rb = (size_t)g * GT;
    pg8::Gemm gm{(const bf16_t*)(ws + WS_XB) + rb * D, (const bf16_t*)(ws + WS_W + (size_t)l * LW + OW_IN), GT, INW, D}; pg8::StaticOrder S; S.init(GT, INW, gridDim.x, opaque_bid());
    pg8::EpiZ E{(bf16_t*)(ws + WS_Z), (const float*)(ws + WS_SLOT) + rb * 16, (const float*)(ws + WS_ROPE), (const float*)(ws + WS_ROPE) + SEQ * 64}; pg8::gemm_phase(lds, gm, S, E);
}
DI void ph_post1(LAS unsigned char* lds, int l) {
    unsigned char* ws = arg_ws();
    pg8::Gemm gm{(const bf16_t*)(ws + WS_R), (const bf16_t*)(ws + WS_W + (size_t)l * LW + OW_RO), GT, D, D}; pg8::StaticOrder S; S.init(GT, D, gridDim.x, opaque_bid());
    pg8::EpiGate<false> E{(const bf16_t*)(ws + WS_Z) + ZC_GR, arg_in(I_BG) + l * 2048, (float*)(ws + WS_Y1), (bf16_t*)(ws + WS_MB)}; pg8::gemm_phase(lds, gm, S, E);
}
DI void ph_post2(LAS unsigned char* lds, int l) {
    unsigned char* ws = arg_ws();
    pg8::Gemm gm{(const bf16_t*)(ws + WS_DL), (const bf16_t*)(ws + WS_W + (size_t)l * LW + OW_DO), GT, D, 512}; pg8::StaticOrder S; S.init(GT, D, gridDim.x, opaque_bid());
    pg8::EpiGate<true> E{(const bf16_t*)(ws + WS_Z) + ZC_GD, arg_in(I_BG) + l * 2048 + 1024, (float*)(ws + WS_Y1), (bf16_t*)(ws + WS_MB)}; pg8::gemm_phase(lds, gm, S, E);
}
DI void ph_out(LAS unsigned char* lds, int l, int g) {
    unsigned char* ws = arg_ws(); const size_t rb = (size_t)g * GT;
    pg8::Gemm gm{(const bf16_t*)(ws + WS_MB), (const bf16_t*)(ws + WS_W + (size_t)l * LW + OW_OUT), GT, D, D}; pg8::StaticOrder S; S.init(GT, D, gridDim.x, opaque_bid());
    pg8::EpiRes E{arg_out() + rb * D, (bf16_t*)(ws + WS_XB) + rb * D, (float*)(ws + WS_SLOT) + rb * 16, 1.0f}; pg8::gemm_phase(lds, gm, S, E);
}
DI void ph_gu(LAS unsigned char* lds, int l, int half) {
    unsigned char* ws = arg_ws();
    pg8::Gemm gm{(const bf16_t*)(ws + WS_XB), (const bf16_t*)(ws + WS_W + (size_t)l * LW + (half ? OW_GU2 : OW_GU1)), NTOK, 5632, D}; pg8::StaticOrder S; S.init(NTOK, 5632, gridDim.x, opaque_bid());
    pg8::EpiSwiGLU E{(bf16_t*)(ws + WS_H), (const float*)(ws + WS_SLOT)}; pg8::gemm_phase(lds, gm, S, E);
}
DI void ph_down(LAS unsigned char* lds, int l, int half) {
    unsigned char* ws = arg_ws();
    pg8::Gemm gm{(const bf16_t*)(ws + WS_H), (const bf16_t*)(ws + WS_W + (size_t)l * LW + (half ? OW_D2 : OW_D1)), NTOK, D, FF}; pg8::StaticOrder S; S.init(NTOK, D, gridDim.x, opaque_bid());
    pg8::EpiRes E{arg_out(), (bf16_t*)(ws + WS_XB), (float*)(ws + WS_SLOT), 0.5f}; pg8::gemm_phase(lds, gm, S, E);
}

__global__ void __launch_bounds__(NTHREADS, 2) mega_fwd(Args a) {
    extern __shared__ __attribute__((aligned(16))) unsigned char lds_g[];
    LAS unsigned char* lds = (LAS unsigned char*)lds_g;
    cg::grid_group grid = cg::this_grid();
    volatile LAS unsigned* bst = (volatile LAS unsigned*)(lds + LDS_BYTES - 16);
    if (threadIdx.x < 4) bst[threadIdx.x] = 0u;
    __syncthreads();
    if (threadIdx.x == 0) (void)xb_add((unsigned*)arg_ws() + XB_XCNT(xb_xcc_id()), 1u);
#define GSYNC() xcd_barrier((unsigned*)arg_ws(), bst)
    if (PH(0)) prep_phase(lds);
    grid.sync();
#pragma unroll 1
    for (int l = 0; l < DEPTH; ++l) {
#pragma unroll 1
        for (int half = 0; half < 2; ++half) {
            if (half == 1) {
#pragma unroll 1
                for (int g = 0; g < NGRP; ++g) {
                    if (PH(1)) ph_win(lds, l, g);
                    GSYNC();
                    if (PH(2)) ret_kv_phase(l, lds_g, lds);
                    if (PH(3)) dil_attn_phase(l, lds_g, lds);
                    GSYNC();
                    if (PH(4)) scan_combine_phase(l);
                    GSYNC();
                    if (PH(5)) ret_out_phase(l, lds_g, lds);
                    GSYNC();
                    if (PH(6)) ph_post1(lds, l);
                    if (PH(7)) ph_post2(lds, l);
                    GSYNC();
                    if (PH(8)) ph_out(lds, l, g);
                }
                GSYNC();
            }
            if (PH(9)) ph_gu(lds, l, half);
            GSYNC();
            if (PH(10)) ph_down(lds, l, half);
            if (l != DEPTH - 1 || half != 1) GSYNC();
        }
    }
}

extern "C" void kernel_launch(void* const* d_in, const int* in_sizes, int n_in, void* d_out, int out_size, void* d_ws, size_t ws_size, hipStream_t stream) {
    static int grid = 0;
    if (grid == 0) {
        if (n_in != 20 || out_size != NTOK * D || ws_size < WS_H + (size_t)NTOK * FF * 2 || ws_size < WS_END) { fprintf(stderr, "kernel_launch: unexpected shapes / workspace (n_in %d out %d ws %zu)\n", n_in, out_size, ws_size); grid = -1; return; }
        int dev = 0, cus = 0, per_cu = 0;
        if (hipGetDevice(&dev) != hipSuccess || hipDeviceGetAttribute(&cus, hipDeviceAttributeMultiprocessorCount, dev) != hipSuccess) { grid = -1; return; }
        if (hipFuncSetAttribute((const void*)mega_fwd, hipFuncAttributeMaxDynamicSharedMemorySize, LDS_BYTES) != hipSuccess) { fprintf(stderr, "kernel_launch: hipFuncSetAttribute failed\n"); grid = -1; return; }
        if (hipOccupancyMaxActiveBlocksPerMultiprocessor(&per_cu, (const void*)mega_fwd, NTHREADS, LDS_BYTES) != hipSuccess || per_cu < 1) { fprintf(stderr, "kernel_launch: occupancy query failed (%d)\n", per_cu); (void)hipGetLastError(); per_cu = 1; }
        grid = cus * per_cu;
    }
    if (grid < 0) return;
    if (hipMemsetAsync(d_ws, 0, 16384, stream) != hipSuccess) { fprintf(stderr, "kernel_launch: memset failed\n"); return; }
    Args a{};
    for (int i = 0; i < 20; ++i) a.in[i] = (const float*)d_in[i];
    a.out = (float*)d_out; a.ws = (unsigned char*)d_ws;
    void* args[] = {&a};
    hipError_t e = hipLaunchCooperativeKernel((const void*)mega_fwd, dim3(grid), dim3(NTHREADS), args, LDS_BYTES, stream);
    if (e != hipSuccess) fprintf(stderr, "kernel_launch: cooperative launch failed: %s (grid %d)\n", hipGetErrorString(e), grid);
}
```

```cpp
#include <hip/hip_runtime.h>
#include <hip/hip_cooperative_groups.h>
#include <cstdio>
#include <cstdint>
namespace cg = cooperative_groups;

#define DI __device__ __forceinline__
#define LAS __attribute__((address_space(3)))
typedef unsigned short bf16_t;
typedef short bf16x8 __attribute__((ext_vector_type(8)));
typedef short s16x4 __attribute__((ext_vector_type(4)));
typedef float f32x4 __attribute__((ext_vector_type(4)));
typedef unsigned u32x4 __attribute__((ext_vector_type(4)));
typedef unsigned u32x2 __attribute__((ext_vector_type(2)));

constexpr int D = 1024, FF = 2816, SEQ = 4096, NBATCH = 16, NTOK = NBATCH * SEQ, DEPTH = 4, INW = 9728;
constexpr int GB = 4, GT = GB * SEQ, NGRP = NBATCH / GB;
constexpr int ZC_RQ = 0, ZC_RK = 512, ZC_RV = 1024, ZC_RG = 2048, ZC_DQ = 3072, ZC_DK = 4608, ZC_DV = 6144, ZC_GR = 7680, ZC_GD = 8704;
constexpr float EPS = 1e-6f;
constexpr int NTHREADS = 512;
constexpr int LDS_BYTES = 147456;

constexpr size_t MiB = 1u << 20;
constexpr size_t WS_ROPE = 1 * MiB;
constexpr size_t WS_BIAS = 3 * MiB;
constexpr size_t WS_SLOT = 4 * MiB;
constexpr size_t WS_W = 8 * MiB;
constexpr size_t OW_GU1 = 0, OW_D1 = OW_GU1 + (size_t)5632 * 1024 * 2, OW_IN = OW_D1 + (size_t)1024 * 2816 * 2, OW_RO = OW_IN + (size_t)INW * 1024 * 2,
                 OW_DO = OW_RO + (size_t)1024 * 1024 * 2, OW_OUT = OW_DO + (size_t)1024 * 512 * 2, OW_GU2 = OW_OUT + (size_t)1024 * 1024 * 2,
                 OW_D2 = OW_GU2 + (size_t)5632 * 1024 * 2, LW = OW_D2 + (size_t)1024 * 2816 * 2;
static_assert(LW == 57 * MiB, "layer weight bytes");
constexpr size_t WS_XB = WS_W + DEPTH * LW;
constexpr size_t WS_BIG = WS_XB + (size_t)NTOK * D * 2;
constexpr size_t WS_H = WS_BIG;
constexpr size_t WS_Z = WS_BIG;
constexpr size_t WS_KV = WS_Z + (size_t)GT * INW * 2;
constexpr size_t WS_Y1 = WS_KV;
constexpr size_t WS_MB = WS_KV + (size_t)GT * D * 4;
constexpr size_t WS_S = WS_KV + (size_t)512 * 2 * 32768 * 4;
constexpr size_t WS_R = WS_S + (size_t)512 * 2 * 32768 * 2;
constexpr size_t WS_DL = WS_R + (size_t)GT * 1024 * 2;
constexpr size_t WS_LSE = WS_DL + (size_t)GT * 512 * 2;
constexpr size_t WS_END = WS_LSE + (size_t)GT * 12 * 4;
static_assert(WS_H + (size_t)NTOK * FF * 2 <= ((size_t)1 << 30) && WS_END <= ((size_t)1 << 30), "workspace fits 1 GiB");

DI int opaque_tid() { int t = threadIdx.x; asm volatile("" : "+v"(t)); return t; }
DI int opaque_bid() { int t = blockIdx.x; asm volatile("" : "+s"(t)); return t; }
DI unsigned pk2(float lo, float hi) { unsigned r; asm("v_cvt_pk_bf16_f32 %0, %1, %2" : "=v"(r) : "v"(lo), "v"(hi)); return r; }
DI float bflo(unsigned u) { return __uint_as_float(u << 16); }
DI float bfhi(unsigned u) { return __uint_as_float(u & 0xffff0000u); }
DI float fexp2(float x) { return __builtin_amdgcn_exp2f(x); }
DI float frcp(float x) { return __builtin_amdgcn_rcpf(x); }
DI float fsigmoid(float x) { return frcp(1.0f + fexp2(-1.44269504f * x)); }
DI float fsilu(float x) { return x * fsigmoid(x); }
DI bf16x8 as_frag(u32x4 v) { return __builtin_bit_cast(bf16x8, v); }
DI f32x4 mfma16(bf16x8 a, bf16x8 b, f32x4 c) { return __builtin_amdgcn_mfma_f32_16x16x32_bf16(a, b, c, 0, 0, 0); }
DI bf16x8 tr_frag(unsigned a0, unsigned a1) {
    s16x4 lo, hi;
    asm volatile("ds_read_b64_tr_b16 %0, %2\n\tds_read_b64_tr_b16 %1, %3\n\ts_waitcnt lgkmcnt(0)" : "=&v"(lo), "=&v"(hi) : "v"(a0), "v"(a1) : "memory");
    bf16x8 r; r[0] = lo[0]; r[1] = lo[1]; r[2] = lo[2]; r[3] = lo[3]; r[4] = hi[0]; r[5] = hi[1]; r[6] = hi[2]; r[7] = hi[3]; return r;
}
DI void tr4(unsigned a0, unsigned a1, bf16x8& o0, bf16x8& o1, bf16x8& o2, bf16x8& o3) {
    s16x4 l0, l1, l2, l3, h0, h1, h2, h3;
    asm volatile(
        "ds_read_b64_tr_b16 %0, %8\n\tds_read_b64_tr_b16 %4, %9\n\t"
        "ds_read_b64_tr_b16 %1, %8 offset:32\n\tds_read_b64_tr_b16 %5, %9 offset:32\n\t"
        "ds_read_b64_tr_b16 %2, %8 offset:64\n\tds_read_b64_tr_b16 %6, %9 offset:64\n\t"
        "ds_read_b64_tr_b16 %3, %8 offset:96\n\tds_read_b64_tr_b16 %7, %9 offset:96\n\t"
        "s_waitcnt lgkmcnt(0)"
        : "=&v"(l0), "=&v"(l1), "=&v"(l2), "=&v"(l3), "=&v"(h0), "=&v"(h1), "=&v"(h2), "=&v"(h3)
        : "v"(a0), "v"(a1) : "memory");
#define TR_PACK(o, lo, hi) o[0] = lo[0]; o[1] = lo[1]; o[2] = lo[2]; o[3] = lo[3]; o[4] = hi[0]; o[5] = hi[1]; o[6] = hi[2]; o[7] = hi[3];
    TR_PACK(o0, l0, h0) TR_PACK(o1, l1, h1) TR_PACK(o2, l2, h2) TR_PACK(o3, l3, h3)
#undef TR_PACK
}
DI void tr8(unsigned a0, unsigned a1, bf16x8 (&out)[8]) {
    tr4(a0, a1, out[0], out[1], out[2], out[3]);
    tr4(a0 + 128u, a1 + 128u, out[4], out[5], out[6], out[7]);
}
DI float row_scale(const float* slots, int row, int fq) {
    const f32x4 s = *(const f32x4*)(slots + (size_t)row * 16 + 4 * fq);
    float t = (s[0] + s[1]) + (s[2] + s[3]);
    t += __shfl_xor(t, 16); t += __shfl_xor(t, 32);
    return __builtin_amdgcn_rsqf(t * (1.0f / D) + EPS);
}

namespace pg8 {
constexpr int BM = 256, BK = 64, HALF = 128, HTB = HALF * BK * 2, STAGE_BYTES = 8 * HTB, NXCD = 8, WGM = 4;
__host__ __device__ __forceinline__ int lds_byte(int r, int c) { const int st = (r >> 4) * 2 + (c >> 5), rr = r & 15, cc = c & 31, ob = rr * 64 + cc * 2; return st * 1024 + (ob ^ (((ob >> 9) & 1) << 5)); }
__host__ __device__ __forceinline__ void stage_rc(int b, int& R, int& C) { const int st = b / 1024, sb = b % 1024, swz = sb ^ (((sb >> 9) & 1) << 5); R = (st >> 1) * 16 + swz / 64; C = (st & 1) * 32 + (swz % 64) / 2; }
__host__ __device__ __forceinline__ int perm32(int rho) { const int n = rho >> 4, i = rho & 15; return 8 * (i >> 2) + 4 * n + (i & 3); }
struct Unit { int pm, pn; };
struct Gemm { const bf16_t* A; const bf16_t* Bt; int M, N, K; };
struct StaticOrder {
    int nM, nN, nwg, G, c;
    DI void init(int M, int N, int G_, int c_) { nM = M / BM; nN = N / BM; nwg = nM * nN; G = G_; c = c_; }
    DI bool next(int i, Unit& u) const {
        const long L = (long)i * G + c; if (L >= nwg) return false;
        int wgid = (int)L; { const int q = nwg / NXCD, r = nwg % NXCD, xcd = wgid % NXCD, off = wgid / NXCD; wgid = (xcd < r ? xcd * (q + 1) : r * (q + 1) + (xcd - r) * q) + off; }
        const int nig = WGM * nN, gid = wgid / nig, fm = gid * WGM, gsz = (nM - fm) < WGM ? (nM - fm) : WGM;
        u.pm = fm + ((wgid % nig) % gsz); u.pn = (wgid % nig) / gsz; return true;
    }
};
template <class Epi>
DI void gemm_phase(LAS unsigned char* lds, const Gemm g, const StaticOrder& S, const Epi& E) {
    const int tid = opaque_tid(), wid = __builtin_amdgcn_readfirstlane(tid >> 6), lane = tid & 63, wr = wid >> 2, wc = wid & 3, fr = lane & 15, fq = lane >> 4;
    const int K = g.K, nt = K / BK;
    unsigned voffA[2], voffB[2];
#pragma unroll
    for (int i = 0; i < 2; ++i) { int R, C; stage_rc(tid * 16 + i * 8192, R, C); const int Rb = Epi::PERM ? ((R & ~31) + perm32(R & 31)) : R;
        voffA[i] = (unsigned)(R * K + C) * 2u; voffB[i] = (unsigned)(Rb * K + C) * 2u; }
    const size_t kstep = (size_t)(BK * 2);
    const size_t hstep = (size_t)HALF * K * 2;
    const size_t tstep = 2 * hstep;
    const unsigned ldsw = (unsigned)wid * 1024u;
    const int aoff = lds_byte(wr * 64 + fr, fq * 8), boff = lds_byte(wc * 32 + fr, fq * 8);
#define PG8_SA(b, h) (((b) * 2 + (h)) * HTB)
#define PG8_SB(b, h) ((4 + (b) * 2 + (h)) * HTB)
#define PG8_STAGE(bufoff, gbase, voff) do { _Pragma("unroll") for (int _i = 0; _i < 2; ++_i) \
        __builtin_amdgcn_global_load_lds((const unsigned*)((const char*)(gbase) + (voff)[_i]), (LAS unsigned*)(lds + (bufoff) + ldsw + _i * 8192), 16, 0, 0); } while (0)
#define PG8_LDA(dst, b, h) do { _Pragma("unroll") for (int m = 0; m < 4; ++m) _Pragma("unroll") for (int k = 0; k < 2; ++k) dst[m][k] = *(const LAS bf16x8*)(lds + PG8_SA(b, h) + aoff + m * 2048 + k * 1024); } while (0)
#define PG8_LDB(dst, b, h) do { _Pragma("unroll") for (int n = 0; n < 2; ++n) _Pragma("unroll") for (int k = 0; k < 2; ++k) dst[n][k] = *(const LAS bf16x8*)(lds + PG8_SB(b, h) + boff + n * 2048 + k * 1024); } while (0)
#define PG8_MMA(ai, bj, At, Bt) do { __builtin_amdgcn_s_setprio(1); _Pragma("unroll") for (int m = 0; m < 4; ++m) _Pragma("unroll") for (int n = 0; n < 2; ++n) _Pragma("unroll") for (int k = 0; k < 2; ++k) \
        acc[ai][bj][m][n] = __builtin_amdgcn_mfma_f32_16x16x32_bf16(Bt[n][k], At[m][k], acc[ai][bj][m][n], 0, 0, 0); __builtin_amdgcn_s_setprio(0); } while (0)
#define PG8_WAIT_V(n) asm volatile("s_waitcnt vmcnt(" #n ")" ::: "memory")
#define PG8_WAIT_L(n) asm volatile("s_waitcnt lgkmcnt(" #n ")" ::: "memory")
#define PG8_BAR __builtin_amdgcn_s_barrier()
#define PG8_SCHED __builtin_amdgcn_sched_barrier(0)
    Unit cur, nxt; int ui = 0;
    if (!S.next(0, cur)) return;
    f32x4 acc[2][2][4][2];
#pragma unroll
    for (int a = 0; a < 2; ++a)
#pragma unroll
        for (int b = 0; b < 2; ++b)
#pragma unroll
            for (int m = 0; m < 4; ++m)
#pragma unroll
                for (int n = 0; n < 2; ++n) acc[a][b][m][n] = (f32x4){0.f, 0.f, 0.f, 0.f};
    bf16x8 At[4][2], B0[2][2], B1[2][2];
    const char* cA = (const char*)g.A + (size_t)cur.pm * tstep; const char* cB = (const char*)g.Bt + (size_t)cur.pn * tstep;
    PG8_STAGE(PG8_SB(0, 0), cB, voffB); PG8_STAGE(PG8_SB(0, 1), cB + hstep, voffB); PG8_STAGE(PG8_SA(0, 0), cA, voffA); PG8_STAGE(PG8_SA(0, 1), cA + hstep, voffA);
    if (wr == 1) PG8_BAR;
    PG8_WAIT_V(2); PG8_BAR;
    PG8_STAGE(PG8_SB(1, 0), cB + kstep, voffB); PG8_STAGE(PG8_SA(1, 0), cA + kstep, voffA); PG8_STAGE(PG8_SB(1, 1), cB + hstep + kstep, voffB);
    PG8_WAIT_V(6); PG8_BAR;
    for (;;) {
        const bool has_next = S.next(ui + 1, nxt);
        const char* nA = has_next ? (const char*)g.A + (size_t)nxt.pm * tstep : cA; const char* nB = has_next ? (const char*)g.Bt + (size_t)nxt.pn * tstep : cB;
        for (int t = 0; t < nt; t += 2) {
            const bool last = (t == nt - 2);
            const char* a1 = cA + (size_t)(t + 1) * kstep;
            const char* a2 = last ? nA : cA + (size_t)(t + 2) * kstep; const char* b2 = last ? nB : cB + (size_t)(t + 2) * kstep;
            const char* a3 = a2 + kstep; const char* b3 = b2 + kstep;
            PG8_LDB(B0, 0, 0); PG8_LDB(B1, 0, 1); PG8_SCHED; PG8_LDA(At, 0, 0); PG8_STAGE(PG8_SA(1, 1), a1 + hstep, voffA);
            PG8_WAIT_V(8); PG8_WAIT_L(0); PG8_BAR; PG8_MMA(0, 0, At, B0); PG8_MMA(0, 1, At, B1); PG8_BAR; PG8_SCHED;
            PG8_LDA(At, 0, 1); PG8_STAGE(PG8_SB(0, 0), b2, voffB); PG8_STAGE(PG8_SB(0, 1), b2 + hstep, voffB); PG8_STAGE(PG8_SA(0, 0), a2, voffA);
            PG8_WAIT_V(8); PG8_WAIT_L(0); PG8_BAR; PG8_MMA(1, 0, At, B0); PG8_MMA(1, 1, At, B1); PG8_BAR; PG8_SCHED;
            PG8_LDB(B0, 1, 0); PG8_LDB(B1, 1, 1); PG8_SCHED; PG8_LDA(At, 1, 0); PG8_STAGE(PG8_SA(0, 1), a2 + hstep, voffA);
            PG8_WAIT_V(8); PG8_WAIT_L(0); PG8_BAR; PG8_MMA(0, 0, At, B0); PG8_MMA(0, 1, At, B1); PG8_BAR; PG8_SCHED;
            PG8_LDA(At, 1, 1); PG8_STAGE(PG8_SB(1, 0), b3, voffB); PG8_STAGE(PG8_SB(1, 1), b3 + hstep, voffB); PG8_STAGE(PG8_SA(1, 0), a3, voffA);
            PG8_WAIT_V(8); PG8_WAIT_L(0); PG8_BAR; PG8_MMA(1, 0, At, B0); PG8_MMA(1, 1, At, B1); PG8_BAR; PG8_SCHED;
        }
        if (wr == 0) PG8_BAR;
        E(acc, cur, wr, wc, fr, fq);
        if (!has_next) break;
#pragma unroll
        for (int a = 0; a < 2; ++a)
#pragma unroll
            for (int b = 0; b < 2; ++b)
#pragma unroll
                for (int m = 0; m < 4; ++m)
#pragma unroll
                    for (int n = 0; n < 2; ++n) acc[a][b][m][n] = (f32x4){0.f, 0.f, 0.f, 0.f};
        cur = nxt; cA = nA; cB = nB; ++ui;
        if (wr == 1) PG8_BAR;
    }
    PG8_WAIT_V(0);
    PG8_BAR;
#undef PG8_SA
#undef PG8_SB
#undef PG8_STAGE
#undef PG8_LDA
#undef PG8_LDB
#undef PG8_MMA
#undef PG8_WAIT_V
#undef PG8_WAIT_L
#undef PG8_BAR
#undef PG8_SCHED
}

struct EpiSwiGLU {
    static constexpr bool PERM = true;
    bf16_t* H; const float* slots;
    DI void operator()(const f32x4 (&acc)[2][2][4][2], const Unit& u, int wr, int wc, int fr, int fq) const {
        const int col0 = u.pn * 128 + wc * 32 + 8 * fq;
        const int rowb = u.pm * BM + wr * 64 + fr;
        f32x4 sl[2][4];
#pragma unroll
        for (int ai = 0; ai < 2; ++ai)
#pragma unroll
            for (int m = 0; m < 4; ++m) sl[ai][m] = *(const f32x4*)(slots + (size_t)(rowb + ai * HALF + m * 16) * 16 + 4 * fq);
        asm volatile("" ::: "memory");
#pragma unroll
        for (int ai = 0; ai < 2; ++ai)
#pragma unroll
            for (int m = 0; m < 4; ++m) {
                const int row = rowb + ai * HALF + m * 16;
                float t = (sl[ai][m][0] + sl[ai][m][1]) + (sl[ai][m][2] + sl[ai][m][3]);
                t += __shfl_xor(t, 16); t += __shfl_xor(t, 32);
                const float rs = __builtin_amdgcn_rsqf(t * (1.0f / D) + EPS);
                float h[8];
#pragma unroll
                for (int n = 0; n < 2; ++n)
#pragma unroll
                    for (int j = 0; j < 4; ++j) { const float gv = acc[ai][0][m][n][j] * rs, uv = acc[ai][1][m][n][j] * rs; h[n * 4 + j] = fsilu(gv) * uv; }
                u32x4 w; w.x = pk2(h[0], h[1]); w.y = pk2(h[2], h[3]); w.z = pk2(h[4], h[5]); w.w = pk2(h[6], h[7]);
                *(u32x4*)(H + (size_t)row * FF + col0) = w;
            }
    }
};
struct EpiRes {
    static constexpr bool PERM = false;
    float* x; bf16_t* xb; float* slots; float s;
    DI void operator()(const f32x4 (&acc)[2][2][4][2], const Unit& u, int wr, int wc, int fr, int fq) const {
        const int col0 = u.pn * BM + wc * 32 + 4 * fq;
#pragma unroll
        for (int ai = 0; ai < 2; ++ai) {
            const int rowa = u.pm * BM + ai * HALF + wr * 64 + fr;
            f32x4 xo[4][2][2];
#pragma unroll
            for (int m = 0; m < 4; ++m)
#pragma unroll
                for (int bj = 0; bj < 2; ++bj)
#pragma unroll
                    for (int n = 0; n < 2; ++n) xo[m][bj][n] = *(const f32x4*)(x + (size_t)(rowa + m * 16) * D + col0 + bj * HALF + n * 16);
            asm volatile("" ::: "memory");
#pragma unroll
            for (int m = 0; m < 4; ++m) {
                const int row = rowa + m * 16;
                float* xr = x + (size_t)row * D + col0; bf16_t* br = xb + (size_t)row * D + col0;
                float ss = 0.f;
#pragma unroll
                for (int bj = 0; bj < 2; ++bj)
#pragma unroll
                    for (int n = 0; n < 2; ++n) {
                        const f32x4 xn = xo[m][bj][n] + acc[ai][bj][m][n] * s;
                        *(f32x4*)(xr + bj * HALF + n * 16) = xn;
                        u32x2 w; w.x = pk2(xn[0], xn[1]); w.y = pk2(xn[2], xn[3]);
                        *(u32x2*)(br + bj * HALF + n * 16) = w;
                        ss += (xn[0] * xn[0] + xn[1] * xn[1]) + (xn[2] * xn[2] + xn[3] * xn[3]);
                    }
                ss += __shfl_xor(ss, 16); ss += __shfl_xor(ss, 32);
                if (fq == 0) slots[(size_t)row * 16 + u.pn * 4 + wc] = ss;
            }
            asm volatile("" ::: "memory");
        }
    }
};
struct EpiZ {
    static constexpr bool PERM = true;
    bf16_t* Z; const float* slots; const float* cs; const float* sn;
    DI void operator()(const f32x4 (&acc)[2][2][4][2], const Unit& u, int wr, int wc, int fr, int fq) const {
        const int col0 = u.pn * BM + wc * 32 + 8 * fq;
        const bool rope = u.pn < 4; const float ksc = (u.pn >= 2) ? 0.08838834764831845f : 1.0f;
        const int fi = 4 * (4 * wc + fq);
        const int rowb = u.pm * BM + wr * 64 + fr;
        f32x4 sl[2][4];
#pragma unroll
        for (int ai = 0; ai < 2; ++ai)
#pragma unroll
            for (int m = 0; m < 4; ++m) sl[ai][m] = *(const f32x4*)(slots + (size_t)(rowb + ai * HALF + m * 16) * 16 + 4 * fq);
        asm volatile("" ::: "memory");
#pragma unroll
        for (int ai = 0; ai < 2; ++ai) {
            f32x4 c4[4], s4[4];
#pragma unroll
            for (int m = 0; m < 4; ++m) { c4[m] = (f32x4){1.f, 1.f, 1.f, 1.f}; s4[m] = (f32x4){0.f, 0.f, 0.f, 0.f}; }
            if (rope) {
#pragma unroll
                for (int m = 0; m < 4; ++m) { const int pos = (rowb + ai * HALF + m * 16) & (SEQ - 1); c4[m] = *(const f32x4*)(cs + pos * 64 + fi); s4[m] = *(const f32x4*)(sn + pos * 64 + fi); }
            }
            asm volatile("" ::: "memory");
#pragma unroll
            for (int m = 0; m < 4; ++m) {
                const int row = rowb + ai * HALF + m * 16;
                float t = (sl[ai][m][0] + sl[ai][m][1]) + (sl[ai][m][2] + sl[ai][m][3]);
                t += __shfl_xor(t, 16); t += __shfl_xor(t, 32);
                const float rs = __builtin_amdgcn_rsqf(t * (1.0f / D) + EPS);
#pragma unroll
                for (int bj = 0; bj < 2; ++bj) {
                    f32x4 v0 = acc[ai][bj][m][0] * rs, v1 = acc[ai][bj][m][1] * rs;
                    if (rope) { const f32x4 o0 = (v0 * c4[m] - v1 * s4[m]) * ksc, o1 = (v0 * s4[m] + v1 * c4[m]) * ksc; v0 = o0; v1 = o1; }
                    u32x4 w; w.x = pk2(v0[0], v0[1]); w.y = pk2(v0[2], v0[3]); w.z = pk2(v1[0], v1[1]); w.w = pk2(v1[2], v1[3]);
                    *(u32x4*)(Z + (size_t)row * INW + col0 + bj * HALF) = w;
                }
            }
            asm volatile("" ::: "memory");
        }
    }
};
template <bool SECOND> struct EpiGate {
    static constexpr bool PERM = true;
    const bf16_t* Zg; const float* bg; bf16_t* Y1; bf16_t* Mb;
    DI void operator()(const f32x4 (&acc)[2][2][4][2], const Unit& u, int wr, int wc, int fr, int fq) const {
        const int col0 = u.pn * BM + wc * 32 + 8 * fq;
        const int rowb = u.pm * BM + wr * 64 + fr;
        f32x4 bb[2][2];
#pragma unroll
        for (int bj = 0; bj < 2; ++bj) { bb[bj][0] = *(const f32x4*)(bg + col0 + bj * HALF); bb[bj][1] = *(const f32x4*)(bg + col0 + bj * HALF + 4); }
#pragma unroll
        for (int ai = 0; ai < 2; ++ai)
#pragma unroll
            for (int mp = 0; mp < 2; ++mp) {
                u32x4 zg[2][2], yv[2][2];
#pragma unroll
                for (int mm = 0; mm < 2; ++mm)
#pragma unroll
                    for (int bj = 0; bj < 2; ++bj) { const int row = rowb + ai * HALF + (2 * mp + mm) * 16, col = col0 + bj * HALF;
                        zg[mm][bj] = *(const u32x4*)(Zg + (size_t)row * INW + col);
                        if (SECOND) yv[mm][bj] = *(const u32x4*)(Y1 + (size_t)row * D + col); }
                asm volatile("" ::: "memory");
#pragma unroll
                for (int mm = 0; mm < 2; ++mm)
#pragma unroll
                    for (int bj = 0; bj < 2; ++bj) { const int m = 2 * mp + mm; const int row = rowb + ai * HALF + m * 16, col = col0 + bj * HALF;
                        const u32x4 z = zg[mm][bj]; const f32x4 b0 = bb[bj][0], b1 = bb[bj][1];
                        f32x4 g0, g1;
                        g0[0] = fsigmoid(bflo(z.x) + b0[0]); g0[1] = fsigmoid(bfhi(z.x) + b0[1]); g0[2] = fsigmoid(bflo(z.y) + b0[2]); g0[3] = fsigmoid(bfhi(z.y) + b0[3]);
                        g1[0] = fsigmoid(bflo(z.z) + b1[0]); g1[1] = fsigmoid(bfhi(z.z) + b1[1]); g1[2] = fsigmoid(bflo(z.w) + b1[2]); g1[3] = fsigmoid(bfhi(z.w) + b1[3]);
                        f32x4 v0 = g0 * acc[ai][bj][m][0], v1 = g1 * acc[ai][bj][m][1];
                        if (SECOND) { const u32x4 y = yv[mm][bj];
                            v0[0] += bflo(y.x); v0[1] += bfhi(y.x); v0[2] += bflo(y.y); v0[3] += bfhi(y.y); v1[0] += bflo(y.z); v1[1] += bfhi(y.z); v1[2] += bflo(y.w); v1[3] += bfhi(y.w); }
                        u32x4 w; w.x = pk2(v0[0], v0[1]); w.y = pk2(v0[2], v0[3]); w.z = pk2(v1[0], v1[1]); w.w = pk2(v1[2], v1[3]);
                        *(u32x4*)((SECOND ? Mb : Y1) + (size_t)row * D + col) = w; }
                asm volatile("" ::: "memory");
            }
    }
};
}

struct Args { const float* in[20]; float* out; unsigned char* ws; };
typedef void* const __attribute__((address_space(4)))* kargp_t;
DI void* karg(int i) { kargp_t p = (kargp_t)__builtin_amdgcn_kernarg_segment_ptr(); asm volatile("" : "+s"(p)); return p[i]; }
DI const float* arg_in(int i) { return (const float*)karg(i); }
DI float* arg_out() { return (float*)karg(20); }
DI unsigned char* arg_ws() { return (unsigned char*)karg(21); }
enum { I_X = 0, I_RELB, I_NF1, I_G1, I_U1, I_D1, I_NMIX, I_WIN, I_BG, I_DEC, I_RNORM, I_WRO, I_QN, I_KN, I_WDO, I_WOUT, I_NF2, I_G2, I_U2, I_D2 };

DI int sigma_rope(int p) { return ((p & 4) ? 64 : 0) + 4 * (p >> 3) + (p & 3); }
DI void conv_item(int kind, const float* src, const float* src2, int ldsrc, const float* gain, int K, int N, bf16_t* Bt, LAS float* scr, int item, int lane) {
    const int nblk = N / 32, kb = item / nblk, nb = item % nblk, k0 = 64 * kb, n0 = 32 * nb;
    const int n = n0 + (lane & 31);
    const float* sp;
    if (kind == 1) { const int tile = n >> 8, r = n & 255; sp = (r < 128 ? src : src2) + tile * 128 + (r & 127); }
    else if (kind == 2) { sp = src + (n < 1024 ? (n & ~127) + sigma_rope(n & 127) : n); }
    else sp = src + n;
    float vv[32];
#pragma unroll
    for (int i = 0; i < 32; ++i) { const int kk = 2 * i + (lane >> 5); vv[i] = sp[(size_t)(k0 + kk) * ldsrc]; }
    if (gain) {
#pragma unroll
        for (int i = 0; i < 32; ++i) { const int kk = 2 * i + (lane >> 5); vv[i] *= gain[k0 + kk]; } }
#pragma unroll
    for (int i = 0; i < 32; ++i) { const int kk = 2 * i + (lane >> 5); scr[kk * 33 + (lane & 31)] = vv[i]; }
    asm volatile("s_waitcnt lgkmcnt(0)" ::: "memory");
    const int c = lane & 7;
#pragma unroll
    for (int j = 0; j < 4; ++j) { const int nn = (lane >> 3) + 8 * j; const LAS float* s = scr + (8 * c) * 33 + nn;
        u32x4 o; o.x = pk2(s[0 * 33], s[1 * 33]); o.y = pk2(s[2 * 33], s[3 * 33]); o.z = pk2(s[4 * 33], s[5 * 33]); o.w = pk2(s[6 * 33], s[7 * 33]);
        *(u32x4*)(Bt + (size_t)(n0 + nn) * K + k0 + 8 * c) = o; }
    asm volatile("s_waitcnt lgkmcnt(0)" ::: "memory");
}
DI int t5_bucket(int rel) {
    const int n = rel < 0 ? -rel : rel; int ret = rel > 0 ? 16 : 0;
    const float nf = (float)(n < 1 ? 1 : n);
    int large = 8 + (int)(logf(nf / 8.0f) / logf(128.0f) * 8.0f);
    large = large < 15 ? large : 15;
    return ret + (n < 8 ? n : large);
}
DI void prep_phase(LAS unsigned char* lds) {
    const int tid = opaque_tid(), lane = tid & 63, wave = tid >> 6;
    const int gw = opaque_bid() * 8 + wave, NGW = gridDim.x * 8;
    const int gt = opaque_bid() * NTHREADS + tid, NGT = gridDim.x * NTHREADS;
    unsigned char* ws = arg_ws();
    {
        bf16_t* xb = (bf16_t*)(ws + WS_XB); float* slots = (float*)(ws + WS_SLOT);
        for (int row = gw; row < NTOK; row += NGW) {
            const f32x4* xr = (const f32x4*)(arg_in(I_X) + (size_t)row * D) + lane;
            f32x4* orow = (f32x4*)(arg_out() + (size_t)row * D) + lane;
            u32x2* brow = (u32x2*)(xb + (size_t)row * D) + lane;
            float ss = 0.f;
#pragma unroll
            for (int j = 0; j < 4; ++j) { const f32x4 v = xr[64 * j]; orow[64 * j] = v; u32x2 w; w.x = pk2(v[0], v[1]); w.y = pk2(v[2], v[3]); brow[64 * j] = w;
                ss += (v[0] * v[0] + v[1] * v[1]) + (v[2] * v[2] + v[3] * v[3]); }
#pragma unroll
            for (int o = 1; o < 64; o <<= 1) ss += __shfl_xor(ss, o);
            if (lane < 16) slots[(size_t)row * 16 + lane] = lane == 0 ? ss : 0.f;
        }
    }
    {
        float* cs = (float*)(ws + WS_ROPE); float* sn = cs + SEQ * 64;
        for (int i = gt; i < SEQ * 64; i += NGT) { const int pos = i >> 6, f = i & 63;
            const float inv = powf(10000.0f, -(float)f / 64.0f); const float ang = (float)pos * inv; cs[i] = cosf(ang); sn[i] = sinf(ang); }
    }
    {
        float* bt = (float*)(ws + WS_BIAS);
        for (int i = gt; i < 12 * 129; i += NGT) { const int hh = i / 129, dl = i % 129 - 64; const int gi = hh >> 2, d = gi == 0 ? 1 : (gi == 1 ? 4 : 16);
            bt[i] = arg_in(I_RELB)[t5_bucket(dl * d) * 12 + hh]; }
    }
    {
        LAS float* scr = (LAS float*)(lds + wave * 16384);
        constexpr int I_GU = 16 * 176, I_DN = 44 * 32, I_IN = 16 * 304, I_RO = 16 * 32, I_DO = 8 * 32, I_OU = 16 * 32;
        constexpr int PER_LAYER = 2 * I_GU + 2 * I_DN + I_IN + I_RO + I_DO + I_OU;
        for (int it = gw; it < DEPTH * PER_LAYER; it += NGW) {
            const int l = it / PER_LAYER; int r = it % PER_LAYER;
            unsigned char* wl = ws + WS_W + (size_t)l * LW;
            if (r < I_GU) { conv_item(1, arg_in(I_G1) + (size_t)l * D * FF, arg_in(I_U1) + (size_t)l * D * FF, FF, arg_in(I_NF1) + l * D, D, 5632, (bf16_t*)(wl + OW_GU1), scr, r, lane); continue; } r -= I_GU;
            if (r < I_GU) { conv_item(1, arg_in(I_G2) + (size_t)l * D * FF, arg_in(I_U2) + (size_t)l * D * FF, FF, arg_in(I_NF2) + l * D, D, 5632, (bf16_t*)(wl + OW_GU2), scr, r, lane); continue; } r -= I_GU;
            if (r < I_DN) { conv_item(0, arg_in(I_D1) + (size_t)l * FF * D, nullptr, D, nullptr, FF, D, (bf16_t*)(wl + OW_D1), scr, r, lane); continue; } r -= I_DN;
            if (r < I_DN) { conv_item(0, arg_in(I_D2) + (size_t)l * FF * D, nullptr, D, nullptr, FF, D, (bf16_t*)(wl + OW_D2), scr, r, lane); continue; } r -= I_DN;
            if (r < I_IN) { conv_item(2, arg_in(I_WIN) + (size_t)l * D * INW, nullptr, INW, arg_in(I_NMIX) + l * D, D, INW, (bf16_t*)(wl + OW_IN), scr, r, lane); continue; } r -= I_IN;
            if (r < I_RO) { conv_item(0, arg_in(I_WRO) + (size_t)l * D * D, nullptr, D, nullptr, D, D, (bf16_t*)(wl + OW_RO), scr, r, lane); continue; } r -= I_RO;
            if (r < I_DO) { conv_item(0, arg_in(I_WDO) + (size_t)l * 512 * D, nullptr, D, nullptr, 512, D, (bf16_t*)(wl + OW_DO), scr, r, lane); continue; } r -= I_DO;
            conv_item(0, arg_in(I_WOUT) + (size_t)l * D * D, nullptr, D, nullptr, D, D, (bf16_t*)(wl + OW_OUT), scr, r, lane);
        }
    }
}

constexpr int RV_PITCH = 528, RK_PITCH = 272;
DI void ret_kv_phase(int l, unsigned char* lds_g, LAS unsigned char* lds) {
    const int tid = opaque_tid(), lane = tid & 63, w = tid >> 6, fr = lane & 15, fq = lane >> 4;
    const unsigned lbase = (unsigned)(size_t)lds_g;
    const bf16_t* Z = (const bf16_t*)(arg_ws() + WS_Z); bf16_t* KV = (bf16_t*)(arg_ws() + WS_KV);
    constexpr int OV = 0, OKF = 128 * RV_PITCH, OKB = OKF + 128 * RK_PITCH;
    for (int item = opaque_bid(); item < GB * 4 * 32; item += gridDim.x) {
        const int n = item & 31, h = (item >> 5) & 3, bl = item >> 7;
        const size_t row0 = (size_t)bl * SEQ + n * 128;
        const float de_f = arg_in(I_DEC)[(l * 2 + 0) * 4 + h], de_b = arg_in(I_DEC)[(l * 2 + 1) * 4 + h];
        const float l2f = log1pf(-exp2f(-de_f)) * 1.44269504f, l2b = log1pf(-exp2f(-de_b)) * 1.44269504f;
#pragma unroll
        for (int i = 0; i < 8; ++i) { const int id = tid + 512 * i, r = id >> 5, ch = id & 31;
            const u32x4 v = *(const u32x4*)(Z + (row0 + r) * INW + ZC_RV + h * 256 + ch * 8);
            *(LAS u32x4*)(lds + OV + r * RV_PITCH + ch * 16) = v; }
#pragma unroll
        for (int i = 0; i < 4; ++i) { const int id = tid + 512 * i, r = id >> 4, ch = id & 15;
            const u32x4 v = *(const u32x4*)(Z + (row0 + r) * INW + ZC_RK + h * 128 + ch * 8);
            const float sf = fexp2(l2f * (float)(127 - r)), sb = fexp2(l2b * (float)r);
            u32x4 f, b;
            f.x = pk2(bflo(v.x) * sf, bfhi(v.x) * sf); f.y = pk2(bflo(v.y) * sf, bfhi(v.y) * sf); f.z = pk2(bflo(v.z) * sf, bfhi(v.z) * sf); f.w = pk2(bflo(v.w) * sf, bfhi(v.w) * sf);
            b.x = pk2(bflo(v.x) * sb, bfhi(v.x) * sb); b.y = pk2(bflo(v.y) * sb, bfhi(v.y) * sb); b.z = pk2(bflo(v.z) * sb, bfhi(v.z) * sb); b.w = pk2(bflo(v.w) * sb, bfhi(v.w) * sb);
            *(LAS u32x4*)(lds + OKF + r * RK_PITCH + ch * 16) = f; *(LAS u32x4*)(lds + OKB + r * RK_PITCH + ch * 16) = b; }
        __syncthreads();
        f32x4 acc[2][8][2];
#pragma unroll
        for (int d = 0; d < 2; ++d)
#pragma unroll
            for (int mt = 0; mt < 8; ++mt)
#pragma unroll
                for (int nt = 0; nt < 2; ++nt) acc[d][mt][nt] = (f32x4){0.f, 0.f, 0.f, 0.f};
        const int q = fr >> 2, p = fr & 3;
#pragma unroll 1
        for (int ks = 0; ks < 4; ++ks) {
            const int tr0 = 32 * ks + 8 * fq + q;
            bf16x8 Bv[2];
#pragma unroll
            for (int nt = 0; nt < 2; ++nt) { const unsigned ad = lbase + OV + tr0 * RV_PITCH + (32 * w + 16 * nt + 4 * p) * 2; Bv[nt] = tr_frag(ad, ad + 4 * RV_PITCH); }
#pragma unroll
            for (int d = 0; d < 2; ++d) { const unsigned ad = lbase + (d ? OKB : OKF) + tr0 * RK_PITCH + (4 * p) * 2; bf16x8 Ak[8]; tr8(ad, ad + 4 * RK_PITCH, Ak);
#pragma unroll
                for (int mt = 0; mt < 8; ++mt)
#pragma unroll
                    for (int nt = 0; nt < 2; ++nt) acc[d][mt][nt] = mfma16(Ak[mt], Bv[nt], acc[d][mt][nt]); }
        }
#pragma unroll
        for (int d = 0; d < 2; ++d)
#pragma unroll
            for (int nt = 0; nt < 2; ++nt)
#pragma unroll
                for (int mt = 0; mt < 8; ++mt)
                    { u32x2 o; o.x = pk2(acc[d][mt][nt][0], acc[d][mt][nt][1]); o.y = pk2(acc[d][mt][nt][2], acc[d][mt][nt][3]);
                      *(u32x2*)(KV + (((size_t)item * 2 + d) * 256 + 32 * w + 16 * nt + fr) * 128 + 16 * mt + 4 * fq) = o; }
        __syncthreads();
    }
}

struct DilIt { int hh, d, L, i0; size_t rowb; };
DI DilIt dil_decode(int item) {
    DilIt it; const int blk = item & 31; it.hh = (item >> 5) % 12; const int bl = item / (32 * 12);
    const int gi = it.hh >> 2; it.d = gi == 0 ? 1 : (gi == 1 ? 4 : 16); it.L = SEQ / it.d; const int bpc = it.L / 128;
    const int r = blk / bpc, qb = blk % bpc; it.i0 = 128 * qb; it.rowb = (size_t)bl * SEQ + r; return it;
}
DI void dil_issue(const bf16_t* Z, const DilIt& it, int tid, u32x4 (&kraw)[8], u32x4 (&vraw)[8]) {
#pragma unroll
    for (int i = 0; i < 8; ++i) { const int id = tid + 512 * i, kk = id >> 4, ch = id & 15; const int j = it.i0 - 64 + kk; const bool ok = (j >= 0) && (j < it.L);
        kraw[i] = (u32x4){0u, 0u, 0u, 0u}; vraw[i] = (u32x4){0u, 0u, 0u, 0u};
        if (ok) { const bf16_t* zr = Z + (it.rowb + (size_t)j * it.d) * INW; kraw[i] = *(const u32x4*)(zr + ZC_DK + it.hh * 128 + ch * 8); vraw[i] = *(const u32x4*)(zr + ZC_DV + it.hh * 128 + ch * 8); } }
}
DI void dil_issue_q(const bf16_t* Z, const DilIt& it, int w, int fr, int fq, u32x4 (&qraw)[4]) {
    const size_t qrow = it.rowb + (size_t)(it.i0 + 16 * w + fr) * it.d;
#pragma unroll
    for (int ks = 0; ks < 4; ++ks) qraw[ks] = *(const u32x4*)(Z + qrow * INW + ZC_DQ + it.hh * 128 + 32 * ks + 8 * fq);
}
template <bool STORE = true> DI void dil_attn_phase(int l, unsigned char* lds_g, LAS unsigned char* lds) {
    const int tid = opaque_tid(), lane = tid & 63, w = tid >> 6, fr = lane & 15, fq = lane >> 4;
    const unsigned lbase = (unsigned)(size_t)lds_g;
    bf16_t* Z = (bf16_t*)(arg_ws() + WS_Z); float* LSE = (float*)(arg_ws() + WS_LSE);
    const float* bt = (const float*)(arg_ws() + WS_BIAS);
    const float* qn = arg_in(I_QN) + l * 128; const float* kn = arg_in(I_KN) + l * 128;
    constexpr int KP = 272, OK = 0, OV = 256 * KP, OB = 2 * 256 * KP, NITEM = GB * 12 * 32;
    int item; { const int bx = opaque_bid(), G = (int)gridDim.x; item = (G % 8 == 0) ? (bx % 8) * (G / 8) + bx / 8 : bx; }
    if (item >= NITEM) return;
    u32x4 kraw[8], vraw[8];
    DilIt it = dil_decode(item);
    dil_issue(Z, it, tid, kraw, vraw);
    for (;;) {
        const int hh = it.hh, d = it.d, L = it.L, i0 = it.i0; const size_t rowb = it.rowb;
        u32x4 qraw[4]; dil_issue_q(Z, it, w, fr, fq, qraw);
#pragma unroll
        for (int i = 0; i < 8; ++i) { const int id = tid + 512 * i, kk = id >> 4, ch = id & 15;
            const u32x4 kv = kraw[i];
            float f[8] = {bflo(kv.x), bfhi(kv.x), bflo(kv.y), bfhi(kv.y), bflo(kv.z), bfhi(kv.z), bflo(kv.w), bfhi(kv.w)};
            float ss = 0.f;
#pragma unroll
            for (int e = 0; e < 8; ++e) ss += f[e] * f[e];
            ss += __shfl_xor(ss, 1); ss += __shfl_xor(ss, 2); ss += __shfl_xor(ss, 4); ss += __shfl_xor(ss, 8);
            const float rs = __builtin_amdgcn_rsqf(ss * (1.0f / 128.0f) + EPS);
            const f32x4 g0 = *(const f32x4*)(kn + ch * 8), g1 = *(const f32x4*)(kn + ch * 8 + 4);
            u32x4 ko; ko.x = pk2(f[0] * rs * g0[0], f[1] * rs * g0[1]); ko.y = pk2(f[2] * rs * g0[2], f[3] * rs * g0[3]); ko.z = pk2(f[4] * rs * g1[0], f[5] * rs * g1[1]); ko.w = pk2(f[6] * rs * g1[2], f[7] * rs * g1[3]);
            *(LAS u32x4*)(lds + OK + kk * KP + ch * 16) = ko; *(LAS u32x4*)(lds + OV + kk * KP + ch * 16) = vraw[i];
            asm volatile("" ::: "memory"); }
        if (tid < 129) *(LAS float*)(lds + OB + tid * 4) = bt[hh * 129 + tid];
        const size_t qrow = rowb + (size_t)(i0 + 16 * w + fr) * d;
        bf16x8 Qf[4];
        {
            float ss = 0.f;
#pragma unroll
            for (int ks = 0; ks < 4; ++ks) { const u32x4 v = qraw[ks];
                ss += bflo(v.x) * bflo(v.x) + bfhi(v.x) * bfhi(v.x) + bflo(v.y) * bflo(v.y) + bfhi(v.y) * bfhi(v.y) + bflo(v.z) * bflo(v.z) + bfhi(v.z) * bfhi(v.z) + bflo(v.w) * bflo(v.w) + bfhi(v.w) * bfhi(v.w); }
            ss += __shfl_xor(ss, 16); ss += __shfl_xor(ss, 32);
            const float rs = __builtin_amdgcn_rsqf(ss * (1.0f / 128.0f) + EPS) * 0.08838834764831845f;
#pragma unroll
            for (int ks = 0; ks < 4; ++ks) { const u32x4 v = qraw[ks]; const f32x4 g0 = *(const f32x4*)(qn + 32 * ks + 8 * fq), g1 = *(const f32x4*)(qn + 32 * ks + 8 * fq + 4);
                u32x4 o; o.x = pk2(bflo(v.x) * rs * g0[0], bfhi(v.x) * rs * g0[1]); o.y = pk2(bflo(v.y) * rs * g0[2], bfhi(v.y) * rs * g0[3]);
                o.z = pk2(bflo(v.z) * rs * g1[0], bfhi(v.z) * rs * g1[1]); o.w = pk2(bflo(v.w) * rs * g1[2], bfhi(v.w) * rs * g1[3]); Qf[ks] = as_frag(o); }
        }
        __syncthreads();
        const int nitem = item + (int)gridDim.x; const bool has_next = nitem < NITEM;
        if (has_next) { it = dil_decode(nitem); dil_issue(Z, it, tid, kraw, vraw); }
        f32x4 sc[9];
#pragma unroll
        for (int jt = 0; jt < 9; ++jt) { f32x4 s = (f32x4){0.f, 0.f, 0.f, 0.f};
#pragma unroll
            for (int ks = 0; ks < 4; ++ks) { const bf16x8 kf = *(const LAS bf16x8*)(lds + OK + (16 * w + 16 * jt + fr) * KP + (32 * ks + 8 * fq) * 2); s = mfma16(kf, Qf[ks], s); }
            sc[jt] = s; if (jt % 3 == 2) asm volatile("" ::: "memory"); }
        float mx = -3.0e38f;
        int dlo = 4 * fq - 64 - fr; asm volatile("" : "+v"(dlo));
#pragma unroll
        for (int jt = 0; jt < 9; ++jt)
#pragma unroll
            for (int e = 0; e < 4; ++e) { const int dl = 16 * jt + e + dlo; const int j = i0 + 16 * w + fr + dl;
                const bool ok = (dl >= -64) && (dl <= 64) && (j >= 0) && (j < L);
                const int bi = dl < -64 ? 0 : (dl > 64 ? 128 : dl + 64);
                const float v = ok ? sc[jt][e] + *(const LAS float*)(lds + OB + bi * 4) : -1.0e30f; sc[jt][e] = v; mx = fmaxf(mx, v); }
        mx = fmaxf(mx, __shfl_xor(mx, 16)); mx = fmaxf(mx, __shfl_xor(mx, 32));
        float den = 0.f;
#pragma unroll
        for (int jt = 0; jt < 9; ++jt)
#pragma unroll
            for (int e = 0; e < 4; ++e) { const float pv = fexp2((sc[jt][e] - mx) * 1.44269504f); sc[jt][e] = pv; den += pv; }
        den += __shfl_xor(den, 16); den += __shfl_xor(den, 32);
        f32x4 oc[8];
#pragma unroll
        for (int c = 0; c < 8; ++c) oc[c] = (f32x4){0.f, 0.f, 0.f, 0.f};
        const int q = fr >> 2, p = fr & 3;
#pragma unroll
        for (int kp = 0; kp < 5; ++kp) {
            u32x4 pw; pw.x = pk2(sc[2 * kp][0], sc[2 * kp][1]); pw.y = pk2(sc[2 * kp][2], sc[2 * kp][3]);
            if (kp < 4) { pw.z = pk2(sc[2 * kp + 1 > 8 ? 8 : 2 * kp + 1][0], sc[2 * kp + 1 > 8 ? 8 : 2 * kp + 1][1]); pw.w = pk2(sc[2 * kp + 1 > 8 ? 8 : 2 * kp + 1][2], sc[2 * kp + 1 > 8 ? 8 : 2 * kp + 1][3]); }
            else { pw.z = 0u; pw.w = 0u; }
            const bf16x8 Pf = as_frag(pw);
            const int ra = 16 * w + 32 * kp + 4 * fq + q, rb = kp < 4 ? ra + 16 : ra;
            bf16x8 Vf[8]; tr8(lbase + OV + ra * KP + (4 * p) * 2, lbase + OV + rb * KP + (4 * p) * 2, Vf);
#pragma unroll
            for (int c = 0; c < 8; ++c) oc[c] = mfma16(Vf[c], Pf, oc[c]);
        }
        const float rden = 1.0f / den;
        if (STORE || den == -1.0f) {
#pragma unroll
        for (int c = 0; c < 8; ++c) { u32x2 o; o.x = pk2(oc[c][0] * rden, oc[c][1] * rden); o.y = pk2(oc[c][2] * rden, oc[c][3] * rden);
            *(u32x2*)(Z + qrow * INW + ZC_DQ + hh * 128 + 16 * c + 4 * fq) = o; }
        if (fq == 0) LSE[qrow * 12 + hh] = mx + logf(den);
        }
        if (!has_next) break;
        item = nitem;
        __syncthreads();
    }
    __syncthreads();
}

DI void scan_combine_phase(int l) {
    const int gt = opaque_bid() * NTHREADS + opaque_tid(), NGT = gridDim.x * NTHREADS;
    const u32x2* KV = (const u32x2*)(arg_ws() + WS_KV); u32x2* S = (u32x2*)(arg_ws() + WS_S);
    for (int v = gt; v < GB * 4 * 2 * 8192; v += NGT) {
        const int bh = v >> 14, dir = (v >> 13) & 1, e4 = v & 8191, h = bh & 3;
        const float de = arg_in(I_DEC)[(l * 2 + dir) * 4 + h];
        const float cd = exp2f(log1pf(-exp2f(-de)) * 1.44269504f * 128.0f);
        u32x2 kw[32];
#pragma unroll
        for (int step = 0; step < 32; ++step) { const int n = dir ? 31 - step : step; kw[step] = KV[((size_t)(bh * 32 + n) * 2 + dir) * 8192 + e4]; }
        f32x4 st = (f32x4){0.f, 0.f, 0.f, 0.f};
#pragma unroll
        for (int step = 0; step < 32; ++step) { const int n = dir ? 31 - step : step; const size_t idx = ((size_t)(bh * 32 + n) * 2 + dir) * 8192 + e4;
            u32x2 o; o.x = pk2(st[0], st[1]); o.y = pk2(st[2], st[3]); S[idx] = o;
            const f32x4 kv = (f32x4){bflo(kw[step].x), bfhi(kw[step].x), bflo(kw[step].y), bfhi(kw[step].y)}; st = st * cd + kv; }
    }
    const bf16_t* Z = (const bf16_t*)(arg_ws() + WS_Z); const float* LSE = (const float*)(arg_ws() + WS_LSE); bf16_t* DL = (bf16_t*)(arg_ws() + WS_DL);
    for (int id = gt; id < GT * 64; id += NGT) {
        const int tok = id >> 6, j = (id >> 4) & 3, ch = id & 15;
        const float l0 = LSE[tok * 12 + j], l1 = LSE[tok * 12 + 4 + j], l2 = LSE[tok * 12 + 8 + j];
        const float mx = fmaxf(l0, fmaxf(l1, l2));
        float w0 = __expf(l0 - mx), w1 = __expf(l1 - mx), w2 = __expf(l2 - mx); const float rw = 1.0f / (w0 + w1 + w2); w0 *= rw; w1 *= rw; w2 *= rw;
        const bf16_t* zr = Z + (size_t)tok * INW + ZC_DQ + j * 128 + ch * 8;
        const u32x4 a0 = *(const u32x4*)zr, a1 = *(const u32x4*)(zr + 512), a2 = *(const u32x4*)(zr + 1024);
        u32x4 o;
        o.x = pk2(w0 * bflo(a0.x) + w1 * bflo(a1.x) + w2 * bflo(a2.x), w0 * bfhi(a0.x) + w1 * bfhi(a1.x) + w2 * bfhi(a2.x));
        o.y = pk2(w0 * bflo(a0.y) + w1 * bflo(a1.y) + w2 * bflo(a2.y), w0 * bfhi(a0.y) + w1 * bfhi(a1.y) + w2 * bfhi(a2.y));
        o.z = pk2(w0 * bflo(a0.z) + w1 * bflo(a1.z) + w2 * bflo(a2.z), w0 * bfhi(a0.z) + w1 * bfhi(a1.z) + w2 * bfhi(a2.z));
        o.w = pk2(w0 * bflo(a0.w) + w1 * bflo(a1.w) + w2 * bflo(a2.w), w0 * bfhi(a0.w) + w1 * bfhi(a1.w) + w2 * bfhi(a2.w));
        *(u32x4*)(DL + (size_t)tok * 512 + j * 128 + ch * 8) = o;
    }
}

DI void ret_out_phase(int l, unsigned char* lds_g, LAS unsigned char* lds) {
    const int tid = opaque_tid(), lane = tid & 63, w = tid >> 6, fr = lane & 15, fq = lane >> 4;
    const unsigned lbase = (unsigned)(size_t)lds_g;
    const bf16_t* Z = (const bf16_t*)(arg_ws() + WS_Z); const bf16_t* S = (const bf16_t*)(arg_ws() + WS_S); bf16_t* R = (bf16_t*)(arg_ws() + WS_R);
    const float* rn = arg_in(I_RNORM) + l * 1024;
    constexpr int OQ = 0, OKP = 128 * RK_PITCH, OV = 2 * 128 * RK_PITCH, OT = OV + 128 * RV_PITCH;
    for (int item = opaque_bid(); item < GB * 4 * 32; item += gridDim.x) {
        const int n = item & 31, h = (item >> 5) & 3, bl = item >> 7;
        const size_t row0 = (size_t)bl * SEQ + n * 128;
        const float de_f = arg_in(I_DEC)[(l * 2 + 0) * 4 + h], de_b = arg_in(I_DEC)[(l * 2 + 1) * 4 + h];
        const float l2f = log1pf(-exp2f(-de_f)) * 1.44269504f, l2b = log1pf(-exp2f(-de_b)) * 1.44269504f;
#pragma unroll
        for (int i = 0; i < 8; ++i) { const int id = tid + 512 * i, r = id >> 5, ch = id & 31;
            *(LAS u32x4*)(lds + OV + r * RV_PITCH + ch * 16) = *(const u32x4*)(Z + (row0 + r) * INW + ZC_RV + h * 256 + ch * 8); }
#pragma unroll
        for (int i = 0; i < 4; ++i) { const int id = tid + 512 * i, r = id >> 4, ch = id & 15;
            *(LAS u32x4*)(lds + OQ + r * RK_PITCH + ch * 16) = *(const u32x4*)(Z + (row0 + r) * INW + ZC_RQ + h * 128 + ch * 8);
            *(LAS u32x4*)(lds + OKP + r * RK_PITCH + ch * 16) = *(const u32x4*)(Z + (row0 + r) * INW + ZC_RK + h * 128 + ch * 8); }
        __syncthreads();
        {
            bf16x8 Qf[4];
#pragma unroll
            for (int ks = 0; ks < 4; ++ks) Qf[ks] = *(const LAS bf16x8*)(lds + OQ + (16 * w + fr) * RK_PITCH + (32 * ks + 8 * fq) * 2);
            u32x2 pw[8];
            const int i = 16 * w + fr;
#pragma unroll
            for (int jt = 0; jt < 8; ++jt) { f32x4 s = (f32x4){0.f, 0.f, 0.f, 0.f};
#pragma unroll
                for (int ks = 0; ks < 4; ++ks) { const bf16x8 kf = *(const LAS bf16x8*)(lds + OKP + (16 * jt + fr) * RK_PITCH + (32 * ks + 8 * fq) * 2); s = mfma16(kf, Qf[ks], s); }
                int io = i - 4 * fq; asm volatile("" : "+v"(io));
#pragma unroll
                for (int e = 0; e < 4; ++e) { const int x = io - (16 * jt + e); const float dm = fexp2(x >= 0 ? l2f * (float)x : l2b * (float)(-x)); s[e] *= dm; }
                pw[jt].x = pk2(s[0], s[1]); pw[jt].y = pk2(s[2], s[3]); asm volatile("" ::: "memory"); }
            __syncthreads();
#pragma unroll
            for (int jt = 0; jt < 8; ++jt) *(LAS u32x2*)(lds + OKP + i * RK_PITCH + (16 * jt + 4 * fq) * 2) = pw[jt];
        }
        __syncthreads();
        f32x4 O[2][8];
        {
            const int q = fr >> 2, p = fr & 3;
#pragma unroll 1
            for (int dir = 0; dir < 2; ++dir) {
                const bf16_t* Sd = S + (((size_t)item * 2 + dir) * 256 + 32 * w) * 128;
#pragma unroll
                for (int m = 0; m < 2; ++m) {
                    f32x4 T[8];
#pragma unroll
                    for (int nt = 0; nt < 8; ++nt) T[nt] = (f32x4){0.f, 0.f, 0.f, 0.f};
                    u32x4 Sf4[4];
#pragma unroll
                    for (int ks = 0; ks < 4; ++ks) Sf4[ks] = *(const u32x4*)(Sd + (16 * m + fr) * 128 + 32 * ks + 8 * fq);
                    asm volatile("" ::: "memory");
#pragma unroll
                    for (int ks = 0; ks < 4; ++ks) {
                        const bf16x8 Af = as_frag(Sf4[ks]);
#pragma unroll
                        for (int nt = 0; nt < 8; ++nt) { const bf16x8 qf = *(const LAS bf16x8*)(lds + OQ + (16 * nt + fr) * RK_PITCH + (32 * ks + 8 * fq) * 2); T[nt] = mfma16(Af, qf, T[nt]); }
                        asm volatile("" ::: "memory");
                    }
                    int fro = fr; asm volatile("" : "+v"(fro));
#pragma unroll
                    for (int nt = 0; nt < 8; ++nt) { const int i = 16 * nt + fro; const float sc = dir ? fexp2(l2b * (float)(128 - i)) : fexp2(l2f * (float)(i + 1));
                        if (dir) O[m][nt] += T[nt] * sc; else O[m][nt] = T[nt] * sc; }
                    asm volatile("" ::: "memory");
                }
            }
#pragma unroll 1
            for (int ks = 0; ks < 4; ++ks) {
                bf16x8 Vf[2];
                const int tr0 = 32 * ks + 8 * fq + q;
#pragma unroll
                for (int m = 0; m < 2; ++m) { const unsigned ad = lbase + OV + tr0 * RV_PITCH + (32 * w + 16 * m + 4 * p) * 2; Vf[m] = tr_frag(ad, ad + 4 * RV_PITCH); }
#pragma unroll
                for (int nt = 0; nt < 8; ++nt) { const bf16x8 pf = *(const LAS bf16x8*)(lds + OKP + (16 * nt + fr) * RK_PITCH + (32 * ks + 8 * fq) * 2);
#pragma unroll
                    for (int m = 0; m < 2; ++m) O[m][nt] = mfma16(Vf[m], pf, O[m][nt]); }
            }
        }
#pragma unroll
        for (int nt = 0; nt < 8; ++nt) { float ss = 0.f;
#pragma unroll
            for (int m = 0; m < 2; ++m)
#pragma unroll
                for (int e = 0; e < 4; ++e) ss += O[m][nt][e] * O[m][nt][e];
            ss += __shfl_xor(ss, 16); ss += __shfl_xor(ss, 32);
            if (fq == 0) *(LAS float*)(lds + OT + (w * 128 + 16 * nt + fr) * 4) = ss; }
        __syncthreads();
#pragma unroll
        for (int nt = 0; nt < 8; ++nt) { const int i = 16 * nt + fr; float tot = 0.f;
#pragma unroll
            for (int ww = 0; ww < 8; ++ww) tot += *(const LAS float*)(lds + OT + (ww * 128 + i) * 4);
            const float rinv = __builtin_amdgcn_rsqf(tot * (1.0f / 256.0f) + EPS);
#pragma unroll
            for (int m = 0; m < 2; ++m) { const int dv = h * 256 + 32 * w + 16 * m + 4 * fq;
                const u32x2 gz = *(const u32x2*)(Z + (row0 + i) * INW + ZC_RG + dv); const f32x4 gn = *(const f32x4*)(rn + dv);
                const float o0 = O[m][nt][0] * rinv * gn[0] * fsilu(bflo(gz.x)), o1 = O[m][nt][1] * rinv * gn[1] * fsilu(bfhi(gz.x));
                const float o2 = O[m][nt][2] * rinv * gn[2] * fsilu(bflo(gz.y)), o3 = O[m][nt][3] * rinv * gn[3] * fsilu(bfhi(gz.y));
                u32x2 o; o.x = pk2(o0, o1); o.y = pk2(o2, o3);
                *(u32x2*)(R + (row0 + i) * 1024 + dv) = o; }
            asm volatile("" ::: "memory"); }
        __syncthreads();
    }
}

#ifndef PHMASK
#define PHMASK 0xffff
#endif
#define PH(k) ((PHMASK >> (k)) & 1)

#define XB_TMO      128
#define XB_XCNT(j)  (256  + 64 * (j))
#define XB_XSUB(j)  (1280 + 64 * (j))
#define XB_XGEN(j)  (2304 + 64 * (j))
#define XB_TOP      3328
#define XB_TOPGEN   3392
#define XCD_BAR_WORDS 3456
#define XB_SPIN_CAP (1u << 22)
DI unsigned xb_ld(unsigned* p)              { return __hip_atomic_load(p, __ATOMIC_RELAXED, __HIP_MEMORY_SCOPE_AGENT); }
DI unsigned xb_add(unsigned* p, unsigned v) { return __hip_atomic_fetch_add(p, v, __ATOMIC_RELAXED, __HIP_MEMORY_SCOPE_AGENT); }
DI unsigned xb_xcc_id() { return (unsigned)__builtin_amdgcn_s_getreg((3 << 11) | 20) & 0xFu; }
#define XB_SPIN(cond, bar) do { unsigned _sp = 0; while (cond) { __builtin_amdgcn_s_sleep(1); \
    if ((++_sp & 255u) == 0u) { if (xb_ld(&(bar)[XB_TMO])) break; if (_sp > XB_SPIN_CAP) { atomicAdd(&(bar)[XB_TMO], 1u); break; } } } } while (0)
DI void xcd_barrier_complete(unsigned* bar, unsigned x, unsigned& nloc, unsigned& nx) {
    const unsigned G = gridDim.x * gridDim.y * gridDim.z;
    unsigned sum, cnt, mine, sp = 0u;
    for (;;) {
        sum = 0u; cnt = 0u; mine = 0u;
#pragma unroll
        for (unsigned j = 0; j < 16; ++j) { const unsigned c = xb_ld(&bar[XB_XCNT(j)]); sum += c; cnt += (c > 0u) ? 1u : 0u; mine = (j == x) ? c : mine; }
        if (sum == G) break;
        __builtin_amdgcn_s_sleep(1);
        if ((++sp & 255u) == 0u) { if (xb_ld(&bar[XB_TMO])) break; if (sp > XB_SPIN_CAP) { atomicAdd(&bar[XB_TMO], 1u); break; } }
    }
    nloc = mine > 0u ? mine : 1u; nx = cnt > 0u ? cnt : 1u;
}
DI void xcd_barrier(unsigned* bar, volatile LAS unsigned* st) {
    asm volatile("s_waitcnt vmcnt(0)" ::: "memory");
    __syncthreads();
    if (threadIdx.x == 0) {
        __builtin_amdgcn_s_waitcnt(0);
        const unsigned x = xb_xcc_id();
        unsigned nloc = st[0], nx = st[1];
        if (nloc == 0u) { xcd_barrier_complete(bar, x, nloc, nx); st[0] = nloc; st[1] = nx; }
        const unsigned old = xb_add(&bar[XB_XSUB(x)], 1u);
        const unsigned gen = old / nloc;
        if (old + 1u == (gen + 1u) * nloc) {
            __builtin_amdgcn_fence(__ATOMIC_RELEASE, "agent");
            asm volatile("s_waitcnt vmcnt(0)" ::: "memory");
            const unsigned og = xb_add(&bar[XB_TOP], 1u);
            const unsigned tg = og / nx;
            if (og + 1u == (tg + 1u) * nx) xb_add(&bar[XB_TOPGEN], 1u);
            else XB_SPIN(xb_ld(&bar[XB_TOPGEN]) == tg, bar);
            __builtin_amdgcn_fence(__ATOMIC_ACQUIRE, "agent");
            xb_add(&bar[XB_XGEN(x)], 1u);
            asm volatile("s_waitcnt vmcnt(0)" ::: "memory");
        } else {
            XB_SPIN(xb_ld(&bar[XB_XGEN(x)]) == gen, bar);
            __builtin_amdgcn_fence(__ATOMIC_ACQUIRE, "agent");
            asm volatile("s_waitcnt vmcnt(0)" ::: "memory");
        }
    }
    __syncthreads();
}

DI void ph_win(LAS unsigned char* lds, int l, int g) {
    unsigned char* ws = arg_ws(); const size_t rb = (size_t)g * GT;
    pg8::Gemm gm{(const bf16_t*)(ws + WS_XB) + rb * D, (const bf16_t*)(ws + WS_W + (size_t)l * LW + OW_IN), GT, INW, D}; pg8::StaticOrder S; S.init(GT, INW, gridDim.x, opaque_bid());
    pg8::EpiZ E{(bf16_t*)(ws + WS_Z), (const float*)(ws + WS_SLOT) + rb * 16, (const float*)(ws + WS_ROPE), (const float*)(ws + WS_ROPE) + SEQ * 64}; pg8::gemm_phase(lds, gm, S, E);
}
DI void ph_post1(LAS unsigned char* lds, int l) {
    unsigned char* ws = arg_ws();
    pg8::Gemm gm{(const bf16_t*)(ws + WS_R), (const bf16_t*)(ws + WS_W + (size_t)l * LW + OW_RO), GT, D, D}; pg8::StaticOrder S; S.init(GT, D, gridDim.x, opaque_bid());
    pg8::EpiGate<false> E{(const bf16_t*)(ws + WS_Z) + ZC_GR, arg_in(I_BG) + l * 2048, (bf16_t*)(ws + WS_Y1), (bf16_t*)(ws + WS_MB)}; pg8::gemm_phase(lds, gm, S, E);
}
DI void ph_post2(LAS unsigned char* lds, int l) {
    unsigned char* ws = arg_ws();
    pg8::Gemm gm{(const bf16_t*)(ws + WS_DL), (const bf16_t*)(ws + WS_W + (size_t)l * LW + OW_DO), GT, D, 512}; pg8::StaticOrder S; S.init(GT, D, gridDim.x, opaque_bid());
    pg8::EpiGate<true> E{(const bf16_t*)(ws + WS_Z) + ZC_GD, arg_in(I_BG) + l * 2048 + 1024, (bf16_t*)(ws + WS_Y1), (bf16_t*)(ws + WS_MB)}; pg8::gemm_phase(lds, gm, S, E);
}
DI void ph_out(LAS unsigned char* lds, int l, int g) {
    unsigned char* ws = arg_ws(); const size_t rb = (size_t)g * GT;
    pg8::Gemm gm{(const bf16_t*)(ws + WS_MB), (const bf16_t*)(ws + WS_W + (size_t)l * LW + OW_OUT), GT, D, D}; pg8::StaticOrder S; S.init(GT, D, gridDim.x, opaque_bid());
    pg8::EpiRes E{arg_out() + rb * D, (bf16_t*)(ws + WS_XB) + rb * D, (float*)(ws + WS_SLOT) + rb * 16, 1.0f}; pg8::gemm_phase(lds, gm, S, E);
}
DI void ph_gu(LAS unsigned char* lds, int l, int half) {
    unsigned char* ws = arg_ws();
    pg8::Gemm gm{(const bf16_t*)(ws + WS_XB), (const bf16_t*)(ws + WS_W + (size_t)l * LW + (half ? OW_GU2 : OW_GU1)), NTOK, 5632, D}; pg8::StaticOrder S; S.init(NTOK, 5632, gridDim.x, opaque_bid());
    pg8::EpiSwiGLU E{(bf16_t*)(ws + WS_H), (const float*)(ws + WS_SLOT)}; pg8::gemm_phase(lds, gm, S, E);
}
DI void ph_down(LAS unsigned char* lds, int l, int half) {
    unsigned char* ws = arg_ws();
    pg8::Gemm gm{(const bf16_t*)(ws + WS_H), (const bf16_t*)(ws + WS_W + (size_t)l * LW + (half ? OW_D2 : OW_D1)), NTOK, D, FF}; pg8::StaticOrder S; S.init(NTOK, D, gridDim.x, opaque_bid());
    pg8::EpiRes E{arg_out(), (bf16_t*)(ws + WS_XB), (float*)(ws + WS_SLOT), 0.5f}; pg8::gemm_phase(lds, gm, S, E);
}

__global__ void __launch_bounds__(NTHREADS, 2) mega_fwd(Args a) {
    extern __shared__ __attribute__((aligned(16))) unsigned char lds_g[];
    LAS unsigned char* lds = (LAS unsigned char*)lds_g;
    cg::grid_group grid = cg::this_grid();
    volatile LAS unsigned* bst = (volatile LAS unsigned*)(lds + LDS_BYTES - 16);
    if (threadIdx.x < 4) bst[threadIdx.x] = 0u;
    __syncthreads();
    if (threadIdx.x == 0) (void)xb_add((unsigned*)arg_ws() + XB_XCNT(xb_xcc_id()), 1u);
#define GSYNC() xcd_barrier((unsigned*)arg_ws(), bst)
    if (PH(0)) prep_phase(lds);
    grid.sync();
#pragma unroll 1
    for (int l = 0; l < DEPTH; ++l) {
#pragma unroll 1
        for (int half = 0; half < 2; ++half) {
            if (half == 1) {
#pragma unroll 1
                for (int g = 0; g < NGRP; ++g) {
                    if (PH(1)) ph_win(lds, l, g);
                    GSYNC();
                    if (PH(2)) ret_kv_phase(l, lds_g, lds);
                    if (PH(3)) dil_attn_phase(l, lds_g, lds);
                    GSYNC();
                    if (PH(4)) scan_combine_phase(l);
                    GSYNC();
                    if (PH(5)) ret_out_phase(l, lds_g, lds);
                    GSYNC();
                    if (PH(6)) ph_post1(lds, l);
                    if (PH(7)) ph_post2(lds, l);
                    GSYNC();
                    if (PH(8)) ph_out(lds, l, g);
                }
                GSYNC();
            }
            if (PH(9)) ph_gu(lds, l, half);
            GSYNC();
            if (PH(10)) ph_down(lds, l, half);
            if (l != DEPTH - 1 || half != 1) GSYNC();
        }
    }
}

extern "C" void kernel_launch(void* const* d_in, const int* in_sizes, int n_in, void* d_out, int out_size, void* d_ws, size_t ws_size, hipStream_t stream) {
    static int grid = 0;
    if (grid == 0) {
        if (n_in != 20 || out_size != NTOK * D || ws_size < WS_H + (size_t)NTOK * FF * 2 || ws_size < WS_END) { fprintf(stderr, "kernel_launch: unexpected shapes / workspace (n_in %d out %d ws %zu)\n", n_in, out_size, ws_size); grid = -1; return; }
        int dev = 0, cus = 0, per_cu = 0;
        if (hipGetDevice(&dev) != hipSuccess || hipDeviceGetAttribute(&cus, hipDeviceAttributeMultiprocessorCount, dev) != hipSuccess) { grid = -1; return; }
        if (hipFuncSetAttribute((const void*)mega_fwd, hipFuncAttributeMaxDynamicSharedMemorySize, LDS_BYTES) != hipSuccess) { fprintf(stderr, "kernel_launch: hipFuncSetAttribute failed\n"); grid = -1; return; }
        if (hipOccupancyMaxActiveBlocksPerMultiprocessor(&per_cu, (const void*)mega_fwd, NTHREADS, LDS_BYTES) != hipSuccess || per_cu < 1) { fprintf(stderr, "kernel_launch: occupancy query failed (%d)\n", per_cu); (void)hipGetLastError(); per_cu = 1; }
        grid = cus * per_cu;
    }
    if (grid < 0) return;
    if (hipMemsetAsync(d_ws, 0, 16384, stream) != hipSuccess) { fprintf(stderr, "kernel_launch: memset failed\n"); return; }
    Args a{};
    for (int i = 0; i < 20; ++i) a.in[i] = (const float*)d_in[i];
    a.out = (float*)d_out; a.ws = (unsigned char*)d_ws;
    void* args[] = {&a};
    hipError_t e = hipLaunchCooperativeKernel((const void*)mega_fwd, dim3(grid), dim3(NTHREADS), args, LDS_BYTES, stream);
    if (e != hipSuccess) fprintf(stderr, "kernel_launch: cooperative launch failed: %s (grid %d)\n", hipGetErrorString(e), grid);
}
```
